# Optimizing an MI355X kernel written in HIP

```python
import jax, jax.numpy as jnp
from jax import lax
import numpy as np

D_MODEL = 1024
BATCH = 8
SEQ = 2048
DEPTH = 2
DEC_BATCH = 16
DEC_SEQ = 16
PAST_LEN = 1024

CHUNK = 64
MIX_WIDTH = D_MODEL
HEAD_DIM = 64
FOX_WIDTH = MIX_WIDTH // 2
FOX_HEADS = FOX_WIDTH // HEAD_DIM
SGU_WIDTH = MIX_WIDTH // 4
SGU_GROUPS = 4
SGU_GROUP_DIM = SGU_WIDTH // SGU_GROUPS
GMLP_CHUNK = 128
MEM_WIDTH = MIX_WIDTH // 4
MEM_HEADS = 4
MEM_HEAD_DIM = MEM_WIDTH // MEM_HEADS
N_MEM = 256
FFN_DIM = 2816
CONV_WIDTH = 3
Q_BLOCK = 128
RMS_EPS = 1e-6
NEG_INF = -1e30
IN_COLS = 3 * FOX_WIDTH + FOX_HEADS + 2 * SGU_WIDTH + MEM_WIDTH
SPLITS = (FOX_WIDTH, 2 * FOX_WIDTH, 3 * FOX_WIDTH, 3 * FOX_WIDTH + FOX_HEADS,
          3 * FOX_WIDTH + FOX_HEADS + 2 * SGU_WIDTH)

kernel_name = 'hybrid_fox_gmlp_memory_stream'


def rmsnorm(x, g):
    xf = x.astype(jnp.float32)
    y = xf * lax.rsqrt(jnp.mean(xf * xf, axis=-1, keepdims=True) + RMS_EPS)
    return (y * g.astype(jnp.float32)).astype(x.dtype)


def fox_attend(q, k, v, c_q, c_k, pos_q, pos_k):
    s = jnp.einsum('bqhd,bkhd->bhqk', q, k, preferred_element_type=jnp.float32) * (HEAD_DIM ** -0.5)
    s = s + jnp.swapaxes(c_q, 1, 2)[:, :, :, None] - jnp.swapaxes(c_k, 1, 2)[:, :, None, :]
    mask = pos_k[None, :] <= pos_q[:, None]
    s = jnp.where(mask[None, None], s, NEG_INF)
    p = jax.nn.softmax(s, axis=-1)
    return jnp.einsum('bhqk,bkhd->bqhd', p.astype(v.dtype), v)


def fox_prompt(q, k, v, c):
    B, S, H, Dh = q.shape
    nb = S // Q_BLOCK
    pos = jnp.arange(S)
    qb = q.reshape(B, nb, Q_BLOCK, H, Dh).transpose(1, 0, 2, 3, 4)
    cb = c.reshape(B, nb, Q_BLOCK, H).transpose(1, 0, 2, 3)
    pb = pos.reshape(nb, Q_BLOCK)
    out = lax.map(lambda blk: fox_attend(blk[0], k, v, blk[1], c, blk[2], pos), (qb, cb, pb))
    return out.transpose(1, 0, 2, 3, 4).reshape(B, S, H * Dh)


def spatial_gating(gm, w_s, b_s, g_sgu, L):
    z = jax.nn.gelu(gm)
    u, vv = jnp.split(z, 2, axis=-1)
    vv = rmsnorm(vv, g_sgu)
    B, T, _ = vv.shape
    idx = jnp.arange(GMLP_CHUNK)
    mask = (idx[None, :] // CHUNK) <= (idx[:, None] // CHUNK)
    w = jnp.where(mask[None], w_s, 0.0)[:, :L, :L]
    vc = vv.reshape(B, T // L, L, SGU_GROUPS, SGU_GROUP_DIM)
    mixed = jnp.einsum('gij,bcjgd->bcigd', w, vc) + b_s[:, :L].T[None, None, :, :, None]
    return u * mixed.reshape(B, T, SGU_WIDTH), vv


def memory_kv(mem, g_mem, w_mem_kv):
    B, N, _ = mem.shape
    kv = rmsnorm(mem, g_mem) @ w_mem_kv
    mk, mv = jnp.split(kv, 2, axis=-1)
    return (mk.reshape(B, N, MEM_HEADS, MEM_HEAD_DIM), mv.reshape(B, N, MEM_HEADS, MEM_HEAD_DIM))


def memory_attend(q, k, v):
    s = jnp.einsum('bqhd,bkhd->bhqk', q, k, preferred_element_type=jnp.float32) * (MEM_HEAD_DIM ** -0.5)
    p = jax.nn.softmax(s, axis=-1)
    return jnp.einsum('bhqk,bkhd->bqhd', p.astype(v.dtype), v)


def causal_dwconv(a_ext, w, b):
    T = a_ext.shape[1] - (CONV_WIDTH - 1)
    out = b + w[0] * a_ext[:, 0:T]
    for i in range(1, CONV_WIDTH):
        out = out + w[i] * a_ext[:, i:i + T]
    return out


def trunk_layer(x, mem_k, mem_v, hist, p):
    (g_pre_mix, w_in, b_forget, w_s, b_s, g_sgu, g_group_out, w_out, g_post_mix,
     g_pre_ffn, w_up, w_dw, b_dw, w_down, g_post_ffn) = p
    B, T, _ = x.shape
    h = rmsnorm(x, g_pre_mix)
    q, k, v, fg, gm, qm = jnp.split(h @ w_in, SPLITS, axis=-1)
    q = q.reshape(B, T, FOX_HEADS, HEAD_DIM)
    k = k.reshape(B, T, FOX_HEADS, HEAD_DIM)
    v = v.reshape(B, T, FOX_HEADS, HEAD_DIM)
    logf = jax.nn.log_sigmoid((fg + b_forget).astype(jnp.float32))
    if hist is None:
        c = jnp.cumsum(logf, axis=1)
        fox = fox_prompt(q, k, v, c)
        L = GMLP_CHUNK
        a_hist = jnp.zeros((B, CONV_WIDTH - 1, FFN_DIM), x.dtype)
    else:
        hk, hv, hlogf, a_hist = hist
        P = hk.shape[1]
        c = jnp.cumsum(jnp.concatenate([hlogf.astype(jnp.float32), logf], axis=1), axis=1)
        fox = fox_attend(q, jnp.concatenate([hk, k], axis=1), jnp.concatenate([hv, v], axis=1),
                         c[:, P:], c, P + jnp.arange(T), jnp.arange(P + T)).reshape(B, T, FOX_WIDTH)
        L = T
    sgu, v_rows = spatial_gating(gm, w_s, b_s, g_sgu, L)
    mem = memory_attend(qm.reshape(B, T, MEM_HEADS, MEM_HEAD_DIM), mem_k, mem_v).reshape(B, T, MEM_WIDTH)
    mixed = jnp.concatenate([
        rmsnorm(fox, g_group_out[:FOX_WIDTH]),
        rmsnorm(sgu, g_group_out[FOX_WIDTH:FOX_WIDTH + SGU_WIDTH]),
        rmsnorm(mem, g_group_out[FOX_WIDTH + SGU_WIDTH:])], axis=-1)
    x = x + rmsnorm(mixed @ w_out, g_post_mix)
    h2 = rmsnorm(x, g_pre_ffn)
    a, lin = jnp.split(h2 @ w_up, 2, axis=-1)
    a_ext = jnp.concatenate([a_hist.astype(a.dtype), a], axis=1)
    ffn = (jax.nn.silu(causal_dwconv(a_ext, w_dw, b_dw)) * lin) @ w_down
    x = x + rmsnorm(ffn, g_post_ffn)
    return x, (k, v, logf.astype(x.dtype), v_rows, a_ext[:, -(CONV_WIDTH - 1):])


def setup_inputs(seed: int = 0) -> dict:
    key = jax.random.key(seed)
    ks = jax.random.split(key, 32)
    nrm = lambda i, shape, s=1.0: s * jax.random.normal(ks[i], shape, jnp.float32)
    gain = lambda i, shape: 1.0 + 0.1 * jax.random.normal(ks[i], shape, jnp.float32)
    return {
        'x_prompt': nrm(0, (BATCH, SEQ, D_MODEL)),
        'x_sample': nrm(1, (DEC_BATCH, DEC_SEQ, D_MODEL)),
        'mem_prompt': nrm(2, (BATCH, N_MEM, D_MODEL)),
        'cache_fox_k': nrm(3, (DEPTH, DEC_BATCH, PAST_LEN, FOX_HEADS, HEAD_DIM)),
        'cache_fox_v': nrm(4, (DEPTH, DEC_BATCH, PAST_LEN, FOX_HEADS, HEAD_DIM)),
        'cache_fox_logf': jax.nn.log_sigmoid(3.0 + nrm(5, (DEPTH, DEC_BATCH, PAST_LEN, FOX_HEADS))),
        'cache_mem_k': nrm(6, (DEPTH, DEC_BATCH, N_MEM, MEM_HEADS, MEM_HEAD_DIM)),
        'cache_mem_v': nrm(7, (DEPTH, DEC_BATCH, N_MEM, MEM_HEADS, MEM_HEAD_DIM)),
        'cache_ffn_conv': nrm(8, (DEPTH, DEC_BATCH, CONV_WIDTH - 1, FFN_DIM)),
        'g_pre_mix': gain(9, (DEPTH, D_MODEL)),
        'w_in': nrm(10, (DEPTH, D_MODEL, IN_COLS), D_MODEL ** -0.5),
        'b_forget': 3.0 + nrm(11, (DEPTH, FOX_HEADS), 0.5),
        'w_spatial': nrm(12, (DEPTH, SGU_GROUPS, GMLP_CHUNK, GMLP_CHUNK), 0.5 * GMLP_CHUNK ** -0.5),
        'b_spatial': gain(13, (DEPTH, SGU_GROUPS, GMLP_CHUNK)),
        'g_sgu': gain(14, (DEPTH, SGU_WIDTH)),
        'g_mem': gain(15, (DEPTH, D_MODEL)),
        'w_mem_kv': nrm(16, (DEPTH, D_MODEL, 2 * MEM_WIDTH), D_MODEL ** -0.5),
        'g_group_out': gain(17, (DEPTH, MIX_WIDTH)),
        'w_out': nrm(18, (DEPTH, MIX_WIDTH, D_MODEL), MIX_WIDTH ** -0.5),
        'g_post_mix': gain(19, (DEPTH, D_MODEL)),
        'g_pre_ffn': gain(20, (DEPTH, D_MODEL)),
        'w_up': nrm(21, (DEPTH, D_MODEL, 2 * FFN_DIM), D_MODEL ** -0.5),
        'w_dwconv': nrm(22, (DEPTH, CONV_WIDTH, FFN_DIM), CONV_WIDTH ** -0.5),
        'b_dwconv': nrm(23, (DEPTH, FFN_DIM), 0.02),
        'w_down': nrm(24, (DEPTH, FFN_DIM, D_MODEL), FFN_DIM ** -0.5),
        'g_post_ffn': gain(25, (DEPTH, D_MODEL)),
    }


def reference(x_prompt, x_sample, mem_prompt, cache_fox_k, cache_fox_v, cache_fox_logf,
              cache_mem_k, cache_mem_v, cache_ffn_conv, g_pre_mix, w_in, b_forget, w_spatial,
              b_spatial, g_sgu, g_mem, w_mem_kv, g_group_out, w_out, g_post_mix, g_pre_ffn,
              w_up, w_dwconv, b_dwconv, w_down, g_post_ffn):
    yp, ys = x_prompt, x_sample
    pk_l, pv_l, plf_l, pmk_l, pmv_l, pconv_l = [], [], [], [], [], []
    sk_l, sv_l, slf_l, sgv_l, sconv_l = [], [], [], [], []
    for l in range(DEPTH):
        p = (g_pre_mix[l], w_in[l], b_forget[l], w_spatial[l], b_spatial[l], g_sgu[l],
             g_group_out[l], w_out[l], g_post_mix[l], g_pre_ffn[l], w_up[l], w_dwconv[l],
             b_dwconv[l], w_down[l], g_post_ffn[l])
        mk, mv = memory_kv(mem_prompt, g_mem[l], w_mem_kv[l])
        yp, (pk, pv, plf, _, pconv) = trunk_layer(yp, mk, mv, None, p)
        ys, (sk, sv, slf, sgv, sconv) = trunk_layer(
            ys, cache_mem_k[l], cache_mem_v[l],
            (cache_fox_k[l], cache_fox_v[l], cache_fox_logf[l], cache_ffn_conv[l]), p)
        pk_l.append(pk); pv_l.append(pv); plf_l.append(plf)
        pmk_l.append(mk); pmv_l.append(mv); pconv_l.append(pconv)
        sk_l.append(sk); sv_l.append(sv); slf_l.append(slf); sgv_l.append(sgv); sconv_l.append(sconv)
    return (yp, ys,
            jnp.stack(pk_l), jnp.stack(pv_l), jnp.stack(plf_l),
            jnp.stack(pmk_l), jnp.stack(pmv_l), jnp.stack(pconv_l),
            jnp.stack(sk_l), jnp.stack(sv_l), jnp.stack(slf_l),
            jnp.stack(sgv_l), jnp.stack(sconv_l))
```

```cpp
#include <hip/hip_runtime.h>
#include <hip/hip_cooperative_groups.h>
#include <cstdio>
#include <cstdint>
namespace cg = cooperative_groups;
#define LAS __attribute__((address_space(3)))
typedef unsigned short us;
typedef float f32x16 __attribute__((ext_vector_type(16)));
typedef short s16x4 __attribute__((ext_vector_type(4)));

constexpr int DM = 1024, NTP = 16384, NTS = 256, NT = NTP + NTS, SEQ = 2048, NBP = 8, NBS = 16, PAST = 1024;
constexpr int INC = 2312, NIN = 2304, FF = 2816, NUP = 5632, NMEMROWS = 2048;
constexpr float LOG2E = 1.4426950408889634f, C2 = 0.125f * 1.4426950408889634f, EPS = 1e-6f;

constexpr size_t O_Y = 0, O_YS = 16777216, O_PK = 17039360, O_PV = 33816576, O_PLF = 50593792, O_PMK = 50855936, O_PMV = 51904512,
                 O_PCONV = 52953088, O_SK = 53043200, O_SV = 53305344, O_SLF = 53567488, O_SGV = 53571584, O_SCONV = 53702656, O_END = 53882880;
constexpr size_t MiB = 1u << 20;
constexpr size_t WS_WIN = 0;
constexpr size_t WS_WOUT = 10 * MiB;
constexpr size_t WS_WUP = 14 * MiB;
constexpr size_t WS_WDOWN = 36 * MiB;
constexpr size_t WS_WMEM = 47 * MiB;
constexpr size_t WS_XB = 49 * MiB;
constexpr size_t WS_MEMB = 82 * MiB;
constexpr size_t WS_MKV = 86 * MiB;
constexpr size_t WS_RS = 90 * MiB;
constexpr size_t WS_RSMEM = 90 * MiB + 128 * 1024;
constexpr size_t WS_YSQ = 91 * MiB;
constexpr size_t WS_AF = 93 * MiB;
constexpr size_t WS_LF = 99 * MiB;
constexpr size_t WS_AL = 105 * MiB;
constexpr size_t WS_SA = 111 * MiB;
constexpr size_t WS_SL = 114 * MiB;
constexpr size_t WS_Y = 117 * MiB;
constexpr size_t WS_ACT = 183 * MiB;
constexpr size_t WS_QB = WS_ACT;
constexpr size_t WS_KB = WS_ACT + 17 * MiB;
constexpr size_t WS_VB = WS_ACT + 34 * MiB;
constexpr size_t WS_UB = WS_ACT + 51 * MiB;
constexpr size_t WS_ZB = WS_ACT + 60 * MiB;
constexpr size_t WS_QMB = WS_ACT + 69 * MiB;
constexpr size_t WS_CAT = WS_ACT + 78 * MiB;
constexpr size_t WS_G = WS_ACT;
constexpr size_t WS_CTL = WS_ACT + 111 * MiB;
constexpr size_t WS_END = WS_ACT + 112 * MiB;

__device__ __forceinline__ unsigned f2bf(float f) { unsigned u = __builtin_bit_cast(unsigned, f); return (u + 0x7fffu + ((u >> 16) & 1u)) >> 16; }
__device__ __forceinline__ unsigned pk2(float lo, float hi) { return f2bf(lo) | (f2bf(hi) << 16); }
__device__ __forceinline__ float bf2f(unsigned h) { return __builtin_bit_cast(float, h << 16); }
__device__ __forceinline__ float gelu_tanh(float x) { const float y = 0.7978845608028654f * (x + 0.044715f * x * x * x); return x / (1.f + __expf(-2.f * y)); }
__device__ __forceinline__ float silu_f(float x) { return x / (1.f + __expf(-x)); }
__device__ __forceinline__ float wave_sum(float v) {
#pragma unroll
    for (int o = 1; o < 64; o <<= 1) v += __shfl_xor(v, o);
    return v;
}
__device__ __forceinline__ int opq0() { int z; asm volatile("s_mov_b32 %0, 0" : "=s"(z)); return z; }
__device__ __forceinline__ int otid() { int t = threadIdx.x; asm volatile("" : "+v"(t)); return t; }
namespace pg8 {
#define PG8_LAS __attribute__((address_space(3)))
typedef unsigned short bf16_t;
typedef short bf16x8 __attribute__((ext_vector_type(8)));
typedef float f32x4 __attribute__((ext_vector_type(4)));
typedef unsigned u32x4 __attribute__((ext_vector_type(4)));
constexpr int BM = 256, BK = 64, HALF = 128, HTB = HALF * BK * 2  , STAGE_BYTES = 8 * HTB, NXCD = 8, WGM = 8;

__host__ __device__ __forceinline__ int lds_byte(int r, int c) { const int st = (r >> 4) * 2 + (c >> 5), rr = r & 15, cc = c & 31, ob = rr * 64 + cc * 2; return st * 1024 + (ob ^ (((ob >> 9) & 1) << 5)); }
__host__ __device__ __forceinline__ void stage_rc(int b, int& R, int& C) { const int st = b / 1024, sb = b % 1024, swz = sb ^ (((sb >> 9) & 1) << 5); R = (st >> 1) * 16 + swz / 64; C = (st & 1) * 32 + (swz % 64) / 2; }
__host__ __device__ __forceinline__ int perm32(int rho) { const int n = rho >> 4, i = rho & 15; return 8 * (i >> 2) + 4 * n + (i & 3); }

struct Unit { int pm, pn; };
struct Gemm { const bf16_t* A; const bf16_t* Bt; int M, N, K; };

struct StaticOrder {
    int nM, nN, nwg, G, c;
    __host__ __device__ void init(int M, int N, int G_, int c_) { nM = M / BM; nN = N / BM; nwg = nM * nN; G = G_; c = c_; }
    __host__ __device__ bool next(int i, Unit& u) const {
        const long L = (long)i * G + c; if (L >= nwg) return false;
        int wgid = (int)L; { const int q = nwg / NXCD, r = nwg % NXCD, xcd = wgid % NXCD, off = wgid / NXCD; wgid = (xcd < r ? xcd * (q + 1) : r * (q + 1) + (xcd - r) * q) + off; }
        const int nig = WGM * nN, gid = wgid / nig, fm = gid * WGM, gsz = (nM - fm) < WGM ? (nM - fm) : WGM;
        u.pm = fm + ((wgid % nig) % gsz); u.pn = (wgid % nig) / gsz; return true;
    }
    __device__ __forceinline__ void a_ready(const Unit&) const {}
    __device__ __forceinline__ void done(const Unit&) const {}
};
__device__ __forceinline__ unsigned cvt_pk_bf16(float lo, float hi) { unsigned r; asm volatile("v_cvt_pk_bf16_f32 %0, %1, %2" : "=v"(r) : "v"(lo), "v"(hi)); return r; }
struct EpiIn {
    static constexpr bool PERM = true, AFTER_DRAIN = false;
    int mode, l; unsigned char* ws; float* out;
    __device__ __forceinline__ void operator()(const f32x4 (&acc)[2][2][4][2], const Unit& u, int wr, int wc, int fr_, int fq_) const {
        int fr = fr_, fq = fq_; asm volatile("" : "+v"(fr), "+v"(fq));
        const int pn = u.pn;
        const float* rs = (const float*)(ws + (mode == 0 ? WS_RS : WS_RSMEM));
        bf16_t* const QB = (bf16_t*)(ws + WS_QB); bf16_t* const KB = (bf16_t*)(ws + WS_KB); bf16_t* const VB = (bf16_t*)(ws + WS_VB); bf16_t* const UB = (bf16_t*)(ws + WS_UB);
        bf16_t* const ZB = (bf16_t*)(ws + WS_ZB); bf16_t* const QMB = (bf16_t*)(ws + WS_QMB); bf16_t* const MKV = (bf16_t*)(ws + WS_MKV) + (size_t)l * NMEMROWS * 512;
        float* const oKp = out + O_PK + (size_t)l * NTP * 512; float* const oVp = out + O_PV + (size_t)l * NTP * 512; float* const oKs = out + O_SK + (size_t)l * NTS * 512; float* const oVs = out + O_SV + (size_t)l * NTS * 512;
        float* const oMK = out + O_PMK + (size_t)l * NMEMROWS * 256; float* const oMV = out + O_PMV + (size_t)l * NMEMROWS * 256;
        bf16_t* bdst; int bp; int bc; float mult = 1.f; int act = 0; float* fP = nullptr; float* fS = nullptr; int fp_ = 0, fc = 0;
        if (mode == 0) {
            if (pn < 2) { bdst = QB; bp = 512; bc = pn * 256; mult = C2; }
            else if (pn < 4) { bdst = KB; bp = 512; bc = (pn - 2) * 256; fP = oKp; fS = oKs; fp_ = 512; fc = bc; }
            else if (pn < 6) { bdst = VB; bp = 512; bc = (pn - 4) * 256; fP = oVp; fS = oVs; fp_ = 512; fc = bc; }
            else if (pn == 6) { bdst = UB; bp = 256; bc = 0; act = 1; }
            else if (pn == 7) { bdst = ZB; bp = 256; bc = 0; act = 1; }
            else { bdst = QMB; bp = 256; bc = 0; mult = C2; }
        } else { bdst = MKV; bp = 512; bc = pn * 256; fP = pn ? oMV : oMK; fS = fP; fp_ = 256; fc = 0; }
#pragma unroll
        for (int ai = 0; ai < 2; ++ai)
#pragma unroll
            for (int m = 0; m < 4; ++m) {
                const int row = u.pm * BM + ai * HALF + wr * 64 + m * 16 + fr;
                const float s = rs[row] * mult;
                float* frow = nullptr;
                if (fP) frow = (mode == 0 && row >= NTP) ? fS + (size_t)(row - NTP) * fp_ + fc : fP + (size_t)row * fp_ + fc;
#pragma unroll
                for (int bj = 0; bj < 2; ++bj) {
                    const int lc = bj * HALF + wc * 32 + 8 * fq;
                    f32x4 v0 = acc[ai][bj][m][0] * s, v1 = acc[ai][bj][m][1] * s;
                    if (act) { v0 = (f32x4){gelu_tanh(v0[0]), gelu_tanh(v0[1]), gelu_tanh(v0[2]), gelu_tanh(v0[3])}; v1 = (f32x4){gelu_tanh(v1[0]), gelu_tanh(v1[1]), gelu_tanh(v1[2]), gelu_tanh(v1[3])}; }
                    if (frow) { *(f32x4*)(frow + lc) = v0; *(f32x4*)(frow + lc + 4) = v1; }
                    u32x4 w; w.x = cvt_pk_bf16(v0[0], v0[1]); w.y = cvt_pk_bf16(v0[2], v0[3]); w.z = cvt_pk_bf16(v1[0], v1[1]); w.w = cvt_pk_bf16(v1[2], v1[3]);
                    *(u32x4*)(bdst + (size_t)row * bp + bc + lc) = w;
                }
            }
    }
};
struct EpiY {
    static constexpr bool PERM = true, AFTER_DRAIN = false;
    unsigned char* ws;
    __device__ __forceinline__ void operator()(const f32x4 (&acc)[2][2][4][2], const Unit& u, int wr, int wc, int fr_, int fq_) const {
        int fr = fr_, fq = fq_; asm volatile("" : "+v"(fr), "+v"(fq));
        float* const Y = (float*)(ws + WS_Y); float* const YSQ = (float*)(ws + WS_YSQ);
#pragma unroll
        for (int ai = 0; ai < 2; ++ai)
#pragma unroll
            for (int m = 0; m < 4; ++m) {
                const int row = u.pm * BM + ai * HALF + wr * 64 + m * 16 + fr;
                float ss = 0.f;
#pragma unroll
                for (int bj = 0; bj < 2; ++bj) {
                    const int c = u.pn * BM + bj * HALF + wc * 32 + 8 * fq;
                    const f32x4 v0 = acc[ai][bj][m][0], v1 = acc[ai][bj][m][1];
                    *(f32x4*)(Y + (size_t)row * DM + c) = v0; *(f32x4*)(Y + (size_t)row * DM + c + 4) = v1;
                    ss += (v0[0] * v0[0] + v0[1] * v0[1]) + (v0[2] * v0[2] + v0[3] * v0[3]) + (v1[0] * v1[0] + v1[1] * v1[1]) + (v1[2] * v1[2] + v1[3] * v1[3]);
                }
                ss += __shfl_xor(ss, 16); ss += __shfl_xor(ss, 32);
                if (fq == 0) YSQ[(size_t)row * 16 + u.pn * 4 + wc] = ss;
            }
    }
};
struct EpiUp {
    static constexpr bool PERM = true, AFTER_DRAIN = false;
    unsigned char* ws; const float* wdw; const float* bdw;
    __device__ __forceinline__ void operator()(const f32x4 (&acc)[2][2][4][2], const Unit& u, int wr, int wc, int fr_, int fq_) const {
        int fr = fr_, fq = fq_; asm volatile("" : "+v"(fr), "+v"(fq));
        const int f0 = u.pn * 128 + wc * 32 + 8 * fq;
        const float* rs = (const float*)(ws + WS_RS); bf16_t* const G = (bf16_t*)(ws + WS_G);
        float* const AF = (float*)(ws + WS_AF); float* const LF = (float*)(ws + WS_LF); float* const AL = (float*)(ws + WS_AL); float* const SA = (float*)(ws + WS_SA); float* const SL = (float*)(ws + WS_SL);
        const int lane = fq * 16 + fr;
        if (u.pm == NTP / BM) {
#pragma unroll
            for (int ai = 0; ai < 2; ++ai)
#pragma unroll
                for (int m = 0; m < 4; ++m) {
                    const int lr = ai * HALF + wr * 64 + m * 16 + fr; const float s = rs[NTP + lr];
                    *(f32x4*)(SA + (size_t)lr * FF + f0) = acc[ai][0][m][0] * s; *(f32x4*)(SA + (size_t)lr * FF + f0 + 4) = acc[ai][0][m][1] * s;
                    *(f32x4*)(SL + (size_t)lr * FF + f0) = acc[ai][1][m][0] * s; *(f32x4*)(SL + (size_t)lr * FF + f0 + 4) = acc[ai][1][m][1] * s;
                }
            return;
        }
        const int src1 = (lane & 48) | ((fr - 1) & 15), src2 = (lane & 48) | ((fr - 2) & 15);
#pragma unroll
        for (int n = 0; n < 2; ++n) {
            const int fn = f0 + 4 * n;
            const f32x4 w0 = *(const f32x4*)(wdw + fn), w1 = *(const f32x4*)(wdw + FF + fn), w2 = *(const f32x4*)(wdw + 2 * FF + fn), bb = *(const f32x4*)(bdw + fn);
#pragma unroll
            for (int ai = 0; ai < 2; ++ai) {
                const int strip = u.pm * 4 + ai * 2 + wr;
                f32x4 ap = {0.f, 0.f, 0.f, 0.f};
#pragma unroll
                for (int m = 0; m < 4; ++m) {
                    const int row = u.pm * BM + ai * HALF + wr * 64 + m * 16 + fr; const float s = rs[row];
                    const f32x4 a = acc[ai][0][m][n] * s, li = acc[ai][1][m][n] * s; f32x4 gv;
#pragma unroll
                    for (int e = 0; e < 4; ++e) {
                        const float s1 = (fr == 15) ? ap[e] : a[e], s2 = (fr >= 14) ? ap[e] : a[e];
                        const float a1 = __shfl(s1, src1), a0 = __shfl(s2, src2);
                        gv[e] = silu_f(bb[e] + w0[e] * a0 + w1[e] * a1 + w2[e] * a[e]) * li[e];
                    }
                    if (m == 0 && fr < 2) {
                        *(f32x4*)(AF + ((size_t)strip * 2 + fr) * FF + fn) = a; *(f32x4*)(LF + ((size_t)strip * 2 + fr) * FF + fn) = li;
                    } else {
                        unsigned long long w = (unsigned long long)cvt_pk_bf16(gv[0], gv[1]) | ((unsigned long long)cvt_pk_bf16(gv[2], gv[3]) << 32);
                        *(unsigned long long*)(G + (size_t)row * FF + fn) = w;
                    }
                    if (m == 3 && fr >= 14) *(f32x4*)(AL + ((size_t)strip * 2 + (fr - 14)) * FF + fn) = a;
                    ap = a;
                    __builtin_amdgcn_sched_barrier(0);
                }
            }
        }
    }
};
template <class Epi, class Sched, bool ALIGN_EPI = false, bool SP2 = false>
__device__ __forceinline__ void gemm_phase(PG8_LAS unsigned char* lds, const Gemm g, const Sched& S, const Epi& E) {
    const int tid = otid(), wid = __builtin_amdgcn_readfirstlane(tid >> 6), lane = tid & 63, wr = wid >> 2, wc = wid & 3, fr = lane & 15, fq = lane >> 4;
    const int K = g.K, nt = K / BK;
    unsigned voffA[2], voffB[2];
#pragma unroll
    for (int i = 0; i < 2; ++i) { int R, C; stage_rc(tid * 16 + i * 8192, R, C); const int Rb = Epi::PERM ? ((R & ~31) + perm32(R & 31)) : R;
        voffA[i] = (unsigned)(R * K + C) * 2u; voffB[i] = (unsigned)(Rb * K + C) * 2u; }
    const size_t kstep = (size_t)(BK * 2);
    const size_t hstep = (size_t)HALF * K * 2;
    const size_t tstep = 2 * hstep;
    const unsigned ldsw = (unsigned)wid * 1024u;
    const int aoff = lds_byte(wr * 64 + fr, fq * 8), boff = lds_byte(wc * 32 + fr, fq * 8);
#define PG8_SA(b, h) (((b) * 2 + (h)) * HTB)
#define PG8_SB(b, h) ((4 + (b) * 2 + (h)) * HTB)
#define PG8_STAGE(bufoff, gbase, voff) do { _Pragma("unroll") for (int _i = 0; _i < 2; ++_i) \
        __builtin_amdgcn_global_load_lds((const unsigned*)((const char*)(gbase) + (voff)[_i]), (PG8_LAS unsigned*)(lds + (bufoff) + ldsw + _i * 8192), 16, 0, 0); } while (0)
#define PG8_LDA(dst, b, h) do { _Pragma("unroll") for (int m = 0; m < 4; ++m) _Pragma("unroll") for (int k = 0; k < 2; ++k) dst[m][k] = *(const PG8_LAS bf16x8*)(lds + PG8_SA(b, h) + aoff + m * 2048 + k * 1024); } while (0)
#define PG8_LDB(dst, b, h) do { _Pragma("unroll") for (int n = 0; n < 2; ++n) _Pragma("unroll") for (int k = 0; k < 2; ++k) dst[n][k] = *(const PG8_LAS bf16x8*)(lds + PG8_SB(b, h) + boff + n * 2048 + k * 1024); } while (0)
#define PG8_MMA(ai, bj, At, Bt) do { __builtin_amdgcn_s_setprio(1); _Pragma("unroll") for (int m = 0; m < 4; ++m) _Pragma("unroll") for (int n = 0; n < 2; ++n) _Pragma("unroll") for (int k = 0; k < 2; ++k) \
        acc[ai][bj][m][n] = __builtin_amdgcn_mfma_f32_16x16x32_bf16(Bt[n][k], At[m][k], acc[ai][bj][m][n], 0, 0, 0); __builtin_amdgcn_s_setprio(0); } while (0)
#define PG8_WAIT_V(n) asm volatile("s_waitcnt vmcnt(" #n ")" ::: "memory")
#define PG8_WAIT_L(n) asm volatile("s_waitcnt lgkmcnt(" #n ")" ::: "memory")
#define PG8_BAR __builtin_amdgcn_s_barrier()
#define PG8_SCHED __builtin_amdgcn_sched_barrier(0)
    Unit cur, nxt; int ui = 0;
    if (!S.next(0, cur)) return;
    f32x4 acc[2][2][4][2];
#pragma unroll
    for (int a = 0; a < 2; ++a)
#pragma unroll
        for (int b = 0; b < 2; ++b)
#pragma unroll
            for (int m = 0; m < 4; ++m)
#pragma unroll
                for (int n = 0; n < 2; ++n) acc[a][b][m][n] = (f32x4){0.f, 0.f, 0.f, 0.f};
    bf16x8 At[4][2], B0[2][2], B1[2][2];
    const char* cA = (const char*)g.A + (size_t)cur.pm * tstep; const char* cB = (const char*)g.Bt + (size_t)cur.pn * tstep;
    S.a_ready(cur);
    if constexpr (SP2) {
        PG8_STAGE(PG8_SB(0, 0), cB, voffB); PG8_STAGE(PG8_SB(0, 1), cB + hstep, voffB); PG8_STAGE(PG8_SA(0, 0), cA, voffA); PG8_STAGE(PG8_SA(0, 1), cA + hstep, voffA);
        if (wr == 1) PG8_BAR;
        PG8_WAIT_V(2); PG8_BAR;
        PG8_STAGE(PG8_SB(1, 0), cB + kstep, voffB); PG8_STAGE(PG8_SA(1, 0), cA + kstep, voffA); PG8_STAGE(PG8_SB(1, 1), cB + hstep + kstep, voffB);
        PG8_WAIT_V(6); PG8_BAR;
    } else {
        PG8_STAGE(PG8_SB(0, 0), cB, voffB); PG8_STAGE(PG8_SA(0, 0), cA, voffA); PG8_STAGE(PG8_SB(0, 1), cB + hstep, voffB); PG8_STAGE(PG8_SA(0, 1), cA + hstep, voffA);
        if (wr == 1) PG8_BAR;
        PG8_WAIT_V(4); PG8_BAR;
        PG8_STAGE(PG8_SB(1, 0), cB + kstep, voffB); PG8_STAGE(PG8_SA(1, 0), cA + kstep, voffA); PG8_STAGE(PG8_SB(1, 1), cB + hstep + kstep, voffB);
        PG8_WAIT_V(6); PG8_BAR;
    }
    for (;;) {
        const bool has_next = S.next(ui + 1, nxt);
        const char* nA = has_next ? (const char*)g.A + (size_t)nxt.pm * tstep : cA; const char* nB = has_next ? (const char*)g.Bt + (size_t)nxt.pn * tstep : cB;
        for (int t = 0; t < nt; t += 2) {
            const bool last = (t == nt - 2);
            const char* a1 = cA + (size_t)(t + 1) * kstep;
            const char* a2 = last ? nA : cA + (size_t)(t + 2) * kstep; const char* b2 = last ? nB : cB + (size_t)(t + 2) * kstep;
            const char* a3 = a2 + kstep; const char* b3 = b2 + kstep;
            if (last && has_next) S.a_ready(nxt);
            if constexpr (SP2) {
            PG8_LDB(B0, 0, 0); PG8_LDB(B1, 0, 1); PG8_SCHED; PG8_LDA(At, 0, 0); PG8_STAGE(PG8_SA(1, 1), a1 + hstep, voffA);
            PG8_WAIT_V(8); PG8_WAIT_L(0); PG8_BAR; PG8_MMA(0, 0, At, B0); PG8_MMA(0, 1, At, B1); PG8_BAR; PG8_SCHED;
            PG8_LDA(At, 0, 1); PG8_STAGE(PG8_SB(0, 0), b2, voffB); PG8_STAGE(PG8_SB(0, 1), b2 + hstep, voffB); PG8_STAGE(PG8_SA(0, 0), a2, voffA);
            PG8_WAIT_V(8); PG8_WAIT_L(0); PG8_BAR; PG8_MMA(1, 0, At, B0); PG8_MMA(1, 1, At, B1); PG8_BAR; PG8_SCHED;
            PG8_LDB(B0, 1, 0); PG8_LDB(B1, 1, 1); PG8_SCHED; PG8_LDA(At, 1, 0); PG8_STAGE(PG8_SA(0, 1), a2 + hstep, voffA);
            PG8_WAIT_V(8); PG8_WAIT_L(0); PG8_BAR; PG8_MMA(0, 0, At, B0); PG8_MMA(0, 1, At, B1); PG8_BAR; PG8_SCHED;
            PG8_LDA(At, 1, 1); PG8_STAGE(PG8_SB(1, 0), b3, voffB); PG8_STAGE(PG8_SB(1, 1), b3 + hstep, voffB); PG8_STAGE(PG8_SA(1, 0), a3, voffA);
            PG8_WAIT_V(8); PG8_WAIT_L(0); PG8_BAR; PG8_MMA(1, 0, At, B0); PG8_MMA(1, 1, At, B1); PG8_BAR; PG8_SCHED;
            } else {
            PG8_LDB(B0, 0, 0); PG8_SCHED; PG8_LDA(At, 0, 0); PG8_STAGE(PG8_SA(1, 1), a1 + hstep, voffA);
            PG8_WAIT_L(8); PG8_BAR; PG8_WAIT_L(0); PG8_MMA(0, 0, At, B0); PG8_BAR; PG8_SCHED;
            PG8_LDB(B1, 0, 1); PG8_STAGE(PG8_SB(0, 0), b2, voffB);
            PG8_BAR; PG8_WAIT_L(0); PG8_MMA(0, 1, At, B1); PG8_BAR;
            PG8_LDA(At, 0, 1); PG8_STAGE(PG8_SA(0, 0), a2, voffA);
            PG8_BAR; PG8_WAIT_L(0); PG8_MMA(1, 0, At, B0); PG8_BAR; PG8_SCHED;
            PG8_STAGE(PG8_SB(0, 1), b2 + hstep, voffB);
            PG8_WAIT_V(6); PG8_BAR; PG8_MMA(1, 1, At, B1); PG8_BAR;
            PG8_LDB(B0, 1, 0); PG8_SCHED; PG8_LDA(At, 1, 0); PG8_STAGE(PG8_SA(0, 1), a2 + hstep, voffA);
            PG8_WAIT_L(8); PG8_BAR; PG8_WAIT_L(0); PG8_MMA(0, 0, At, B0); PG8_BAR; PG8_SCHED;
            PG8_LDB(B1, 1, 1); PG8_STAGE(PG8_SB(1, 0), b3, voffB);
            PG8_BAR; PG8_WAIT_L(0); PG8_MMA(0, 1, At, B1); PG8_BAR;
            PG8_LDA(At, 1, 1); PG8_STAGE(PG8_SA(1, 0), a3, voffA);
            PG8_BAR; PG8_WAIT_L(0); PG8_MMA(1, 0, At, B0); PG8_BAR; PG8_SCHED;
            PG8_STAGE(PG8_SB(1, 1), b3 + hstep, voffB);
            PG8_WAIT_V(6); PG8_BAR; PG8_MMA(1, 1, At, B1); PG8_BAR;
            }
        }
        if constexpr (ALIGN_EPI) { if (wr == 0) PG8_BAR; }
        if constexpr (!Epi::AFTER_DRAIN) { E(acc, cur, wr, wc, fr, fq); S.done(cur); }
        if (!has_next) break;
#pragma unroll
        for (int a = 0; a < 2; ++a)
#pragma unroll
            for (int b = 0; b < 2; ++b)
#pragma unroll
                for (int m = 0; m < 4; ++m)
#pragma unroll
                    for (int n = 0; n < 2; ++n) acc[a][b][m][n] = (f32x4){0.f, 0.f, 0.f, 0.f};
        cur = nxt; cA = nA; cB = nB; ++ui;
        if constexpr (ALIGN_EPI) { if (wr == 1) PG8_BAR; }
    }
    PG8_WAIT_V(0);
    if constexpr (!ALIGN_EPI) { if (wr == 0) PG8_BAR; }
    PG8_BAR;
    if constexpr (Epi::AFTER_DRAIN) { E.fused(acc, cur, wr, wc, fr, fq, lds, wid, lane); S.done(cur); }
#undef PG8_SA
#undef PG8_SB
#undef PG8_STAGE
#undef PG8_LDA
#undef PG8_LDB
#undef PG8_MMA
#undef PG8_WAIT_V
#undef PG8_WAIT_L
#undef PG8_BAR
#undef PG8_SCHED
}
}
using pg8::bf16x8; using pg8::f32x4; using pg8::u32x4;
struct P {
    const float* in[26]; float* out; unsigned char* ws; int ph_lo, ph_hi, coop, pad;
};
#define INP(i) (p.in[(i) + opq0()])
#define WSB (p.ws + opq0())
#define OUTB (p.out + opq0())
#define MFMA32(a, b, c) __builtin_amdgcn_mfma_f32_32x32x16_bf16(a, b, c, 0, 0, 0)
#define MFMA16(a, b, c) __builtin_amdgcn_mfma_f32_16x16x32_bf16(a, b, c, 0, 0, 0)
typedef short v4i16_t __attribute__((ext_vector_type(4)));
__device__ __forceinline__ s16x4 trr(LAS const unsigned char* p) { return __builtin_bit_cast(s16x4, __builtin_amdgcn_ds_read_tr16_b64_v4i16((LAS v4i16_t*)p)); }

__device__ __forceinline__ void prep_tile(const float* src, int srcN, int K, const float* gain, us* dst, int kt, int n0dst, int n0src, LAS float* tile) {
    const int tid = otid();
#pragma unroll
    for (int i = 0; i < 8; ++i) { const int k = i * 8 + (tid >> 6), n = tid & 63; float v = src[(size_t)(kt * 64 + k) * srcN + n0src + n]; if (gain) v *= gain[kt * 64 + k]; tile[k * 65 + n] = v; }
    __syncthreads();
    const int n = tid >> 3, k8 = (tid & 7) * 8;
    u32x4 o; o.x = pk2(tile[(k8 + 0) * 65 + n], tile[(k8 + 1) * 65 + n]); o.y = pk2(tile[(k8 + 2) * 65 + n], tile[(k8 + 3) * 65 + n]);
    o.z = pk2(tile[(k8 + 4) * 65 + n], tile[(k8 + 5) * 65 + n]); o.w = pk2(tile[(k8 + 6) * 65 + n], tile[(k8 + 7) * 65 + n]);
    *(u32x4*)(dst + (size_t)(n0dst + n) * K + kt * 64 + k8) = o;
    __syncthreads();
}
__device__ __forceinline__ void prep_phase(const P& p, LAS unsigned char* lds) {
    LAS float* tile = (LAS float*)lds;
    constexpr int I_IN = 16 * 36, I_OUT = 16 * 16, I_UP = 16 * 88, I_DN = 44 * 16, I_MEM = 16 * 8, I_L = I_IN + I_OUT + I_UP + I_DN + I_MEM;
    for (int it = blockIdx.x; it < 2 * I_L; it += gridDim.x) {
        const int l = it / I_L; int r = it % I_L;
        if (r < I_IN) { const int kt = r / 36, nt = r % 36, nd = nt * 64; prep_tile(INP(10) + (size_t)l * DM * INC, INC, DM, INP(9) + l * DM, (us*)(WSB + WS_WIN) + (size_t)l * NIN * DM, kt, nd, nd < 1536 ? nd : nd + 8, tile); continue; } r -= I_IN;
        if (r < I_OUT) { const int kt = r / 16, nt = r % 16; prep_tile(INP(18) + (size_t)l * DM * DM, DM, DM, nullptr, (us*)(WSB + WS_WOUT) + (size_t)l * DM * DM, kt, nt * 64, nt * 64, tile); continue; } r -= I_OUT;
        if (r < I_UP) { const int kt = r / 88, nt = r % 88, nd = nt * 64, j = nd >> 8, w = nd & 255; prep_tile(INP(21) + (size_t)l * DM * NUP, NUP, DM, INP(20) + l * DM, (us*)(WSB + WS_WUP) + (size_t)l * NUP * DM, kt, nd, (w >> 7) * FF + 128 * j + (w & 127), tile); continue; } r -= I_UP;
        if (r < I_DN) { const int kt = r / 16, nt = r % 16; prep_tile(INP(24) + (size_t)l * FF * DM, DM, FF, nullptr, (us*)(WSB + WS_WDOWN) + (size_t)l * DM * FF, kt, nt * 64, nt * 64, tile); continue; } r -= I_DN;
        { const int kt = r / 8, nt = r % 8; prep_tile(INP(16) + (size_t)l * DM * 512, 512, DM, INP(15) + l * DM, (us*)(WSB + WS_WMEM) + (size_t)l * 512 * DM, kt, nt * 64, nt * 64, tile); }
    }
}

template <bool HAS_Y, bool DO_FG, bool WRITE_B>
__device__ __forceinline__ void row_pass(const float* xP, const float* xS, int nrows, float* xdst, const float* Y, const float* YSQ, const float* gpost,
                                         us* XB, float* RS, const float* win_l, const float* gpre, const float* bfg, float* lfP, float* lfS) {
    const int tid_ = otid(), lane = tid_ & 63, wid = tid_ >> 6;
    for (int row = blockIdx.x * 8 + wid; row < nrows; row += gridDim.x * 8) {
        const float* xr = (row < NTP) ? xP + (size_t)row * DM : xS + (size_t)(row - NTP) * DM;
        f32x4 v[4];
#pragma unroll
        for (int j = 0; j < 4; ++j) v[j] = *(const f32x4*)(xr + 4 * lane + 256 * j);
        if (HAS_Y) {
            const f32x4* q = (const f32x4*)(YSQ + (size_t)row * 16); const f32x4 a = q[0], b = q[1], c = q[2], d = q[3];
            const float ss = ((a[0] + a[1]) + (a[2] + a[3])) + ((b[0] + b[1]) + (b[2] + b[3])) + ((c[0] + c[1]) + (c[2] + c[3])) + ((d[0] + d[1]) + (d[2] + d[3]));
            const float ry = rsqrtf(ss * (1.f / DM) + EPS);
#pragma unroll
            for (int j = 0; j < 4; ++j) { const f32x4 y = *(const f32x4*)(Y + (size_t)row * DM + 4 * lane + 256 * j); const f32x4 g = *(const f32x4*)(gpost + 4 * lane + 256 * j); v[j] = v[j] + y * ry * g; }
        }
        if (xdst) {
#pragma unroll
            for (int j = 0; j < 4; ++j) *(f32x4*)(xdst + (size_t)row * DM + 4 * lane + 256 * j) = v[j];
        }
        if (WRITE_B) {
            float s = 0.f;
#pragma unroll
            for (int j = 0; j < 4; ++j) s += (v[j][0] * v[j][0] + v[j][1] * v[j][1]) + (v[j][2] * v[j][2] + v[j][3] * v[j][3]);
            const float rs = rsqrtf(wave_sum(s) * (1.f / DM) + EPS);
            if (lane == 0) RS[row] = rs;
#pragma unroll
            for (int j = 0; j < 4; ++j) { unsigned long long o = (unsigned long long)pk2(v[j][0], v[j][1]) | ((unsigned long long)pk2(v[j][2], v[j][3]) << 32); *(unsigned long long*)(XB + (size_t)row * DM + 4 * lane + 256 * j) = o; }
            if (DO_FG) {
                float f[8];
#pragma unroll
                for (int h = 0; h < 8; ++h) f[h] = 0.f;
#pragma unroll
                for (int j = 0; j < 4; ++j) { const f32x4 g = *(const f32x4*)(gpre + 4 * lane + 256 * j);
#pragma unroll
                    for (int e = 0; e < 4; ++e) { const int k = 4 * lane + 256 * j + e; const float xg = v[j][e] * g[e];
                        const f32x4 wa = *(const f32x4*)(win_l + (size_t)k * INC + 1536), wb = *(const f32x4*)(win_l + (size_t)k * INC + 1540);
                        f[0] += xg * wa[0]; f[1] += xg * wa[1]; f[2] += xg * wa[2]; f[3] += xg * wa[3]; f[4] += xg * wb[0]; f[5] += xg * wb[1]; f[6] += xg * wb[2]; f[7] += xg * wb[3]; } }
#pragma unroll
                for (int h = 0; h < 8; ++h) f[h] = wave_sum(f[h]);
                if (lane < 8) {
                    float z = 0.f;
#pragma unroll
                    for (int h = 0; h < 8; ++h) if (lane == h) z = f[h];
                    z = z * rs + bfg[lane];
                    const float lf = fminf(z, 0.f) - log1pf(__expf(-fabsf(z)));
                    if (row < NTP) lfP[(size_t)row * 8 + lane] = lf; else lfS[(size_t)(row - NTP) * 8 + lane] = lf;
                }
            }
        }
    }
}

constexpr int KPB = 144, VPB = 192, FL_V0 = 64 * KPB, FL_BUF = 64 * KPB + 64 * VPB, FL_BIAS = 2 * FL_BUF, FL_MISC = FL_BIAS + 2048 * 4;
__device__ __forceinline__ void flash_unit(LAS unsigned char* lds, const us* Q, int qp, const us* K, int kp, const us* V, int vp, us* O, int op, int ntiles, int band, bool use_bias) {
    const int tid = otid(), lane = tid & 63, wid = tid >> 6, r32 = lane & 31, hi = lane >> 5;
    bf16x8 qf[4];
#pragma unroll
    for (int d0 = 0; d0 < 4; ++d0) qf[d0] = *(const bf16x8*)(Q + (size_t)(wid * 32 + r32) * qp + d0 * 16 + hi * 8);
    const int srow = tid >> 3, sch = tid & 7;
    const us* kg = K + (size_t)srow * kp + sch * 8; const us* vg = V + (size_t)srow * vp + sch * 8;
    u32x4 kreg = *(const u32x4*)kg, vreg = *(const u32x4*)vg;
    *(LAS u32x4*)(lds + srow * KPB + sch * 16) = kreg; *(LAS u32x4*)(lds + FL_V0 + srow * VPB + sch * 16) = vreg;
    __syncthreads();
    f32x16 o0 = {}, o1 = {}; float mrun = -1e30f, lrun = 0.f;
    const int qrel = wid * 32 + r32;
    LAS const float* bias = (LAS const float*)(lds + FL_BIAS);
    for (int t = 0; t < ntiles; ++t) {
        const int cur = (t & 1) * FL_BUF, nxt = FL_BUF - cur;
        if (t + 1 < ntiles) { kreg = *(const u32x4*)(kg + (size_t)(t + 1) * 64 * kp); vreg = *(const u32x4*)(vg + (size_t)(t + 1) * 64 * vp); }
        const int jb = band ? t - (ntiles - band) : -1;
        const bool skip = (jb >= 0) && (64 * jb > wid * 32 + 31);
        if (!skip) {
            f32x16 p0 = {}, p1 = {};
            LAS const unsigned char* kb = lds + cur + r32 * KPB + hi * 16;
#pragma unroll
            for (int d0 = 0; d0 < 4; ++d0) {
                const bf16x8 a0 = *(LAS const bf16x8*)(kb + d0 * 32), a1 = *(LAS const bf16x8*)(kb + 32 * KPB + d0 * 32);
                p0 = MFMA32(a0, qf[d0], p0); p1 = MFMA32(a1, qf[d0], p1);
            }
            if (use_bias) {
                LAS const float* bp = bias + 64 * t + 4 * hi;
#pragma unroll
                for (int g = 0; g < 4; ++g) { const f32x4 b0 = *(LAS const f32x4*)(bp + 8 * g), b1 = *(LAS const f32x4*)(bp + 32 + 8 * g);
#pragma unroll
                    for (int i = 0; i < 4; ++i) { p0[4 * g + i] -= b0[i]; p1[4 * g + i] -= b1[i]; } }
            }
            if (jb >= 0) {
                const int qb4 = qrel - 64 * jb - 4 * hi; const int NEGB = __builtin_bit_cast(int, -1e30f);
#pragma unroll
                for (int r = 0; r < 16; ++r) { const int t0 = qb4 - ((r & 3) + 8 * (r >> 2)), m0 = t0 >> 31, m1 = (t0 - 32) >> 31;
                    const float x0 = p0[r], x1 = p1[r]; p0[r] = __int_as_float((__float_as_int(x0) & ~m0) | (NEGB & m0)); p1[r] = __int_as_float((__float_as_int(x1) & ~m1) | (NEGB & m1)); }
            }
            float mx = fmaxf(p0[0], p1[0]);
#pragma unroll
            for (int r = 1; r < 16; ++r) mx = fmaxf(mx, fmaxf(p0[r], p1[r]));
            mx = fmaxf(mx, __shfl_xor(mx, 32));
            const float mn = fmaxf(mrun, mx), alpha = __builtin_amdgcn_exp2f(mrun - mn); mrun = mn;
            lrun *= alpha; o0 = o0 * alpha; o1 = o1 * alpha;
            float ls = 0.f;
#pragma unroll
            for (int r = 0; r < 16; ++r) { p0[r] = __builtin_amdgcn_exp2f(p0[r] - mn); p1[r] = __builtin_amdgcn_exp2f(p1[r] - mn); ls += p0[r] + p1[r]; }
            lrun += ls;
            u32x4 pw[4];
#pragma unroll
            for (int s = 0; s < 2; ++s) {
                pw[s] = (u32x4){pg8::cvt_pk_bf16(p0[8 * s], p0[8 * s + 1]), pg8::cvt_pk_bf16(p0[8 * s + 2], p0[8 * s + 3]), pg8::cvt_pk_bf16(p0[8 * s + 4], p0[8 * s + 5]), pg8::cvt_pk_bf16(p0[8 * s + 6], p0[8 * s + 7])};
                pw[2 + s] = (u32x4){pg8::cvt_pk_bf16(p1[8 * s], p1[8 * s + 1]), pg8::cvt_pk_bf16(p1[8 * s + 2], p1[8 * s + 3]), pg8::cvt_pk_bf16(p1[8 * s + 4], p1[8 * s + 5]), pg8::cvt_pk_bf16(p1[8 * s + 6], p1[8 * s + 7])};
            }
            LAS const unsigned char* vb = lds + cur + FL_V0 + (4 * hi + ((lane & 15) >> 2)) * VPB + (((lane >> 4) & 1) * 16 + (lane & 3) * 4) * 2;
#pragma unroll
            for (int ks = 0; ks < 4; ++ks) {
                const s16x4 l0 = trr(vb + (16 * ks) * VPB), h0 = trr(vb + (16 * ks + 8) * VPB), l1 = trr(vb + (16 * ks) * VPB + 64), h1 = trr(vb + (16 * ks + 8) * VPB + 64);
                const bf16x8 a0 = (bf16x8){l0[0], l0[1], l0[2], l0[3], h0[0], h0[1], h0[2], h0[3]}, a1 = (bf16x8){l1[0], l1[1], l1[2], l1[3], h1[0], h1[1], h1[2], h1[3]};
                const bf16x8 pf = __builtin_bit_cast(bf16x8, pw[ks]);
                o0 = MFMA32(a0, pf, o0); o1 = MFMA32(a1, pf, o1);
            }
        }
        if (t + 1 < ntiles) { *(LAS u32x4*)(lds + nxt + srow * KPB + sch * 16) = kreg; *(LAS u32x4*)(lds + nxt + FL_V0 + srow * VPB + sch * 16) = vreg; }
        __syncthreads();
    }
    lrun += __shfl_xor(lrun, 32);
    const float inv = 1.f / lrun;
    us* orow = O + (size_t)(wid * 32 + r32) * op;
#pragma unroll
    for (int g = 0; g < 4; ++g) {
        const int d0 = 8 * g + 4 * hi;
        unsigned long long w0 = (unsigned long long)pk2(o0[4 * g] * inv, o0[4 * g + 1] * inv) | ((unsigned long long)pk2(o0[4 * g + 2] * inv, o0[4 * g + 3] * inv) << 32);
        unsigned long long w1 = (unsigned long long)pk2(o1[4 * g] * inv, o1[4 * g + 1] * inv) | ((unsigned long long)pk2(o1[4 * g + 2] * inv, o1[4 * g + 3] * inv) << 32);
        *(unsigned long long*)(orow + d0) = w0; *(unsigned long long*)(orow + 32 + d0) = w1;
    }
}
template <class F> __device__ __forceinline__ void block_cumsum(LAS float* dst, LAS float* wtot, int n, F f) {
    const int tid = otid(), lane = tid & 63, wid = tid >> 6;
    float a[4];
#pragma unroll
    for (int i = 0; i < 4; ++i) { const int j = 4 * tid + i; a[i] = (j < n) ? f(j) : 0.f; }
    const float s = (a[0] + a[1]) + (a[2] + a[3]);
    float sc = s;
#pragma unroll
    for (int o = 1; o < 64; o <<= 1) { const float t = __shfl_up(sc, o); if (lane >= o) sc += t; }
    if (lane == 63) wtot[wid] = sc;
    __syncthreads();
    float off = 0.f;
    for (int w = 0; w < wid; ++w) off += wtot[w];
    float c = off + sc - s;
#pragma unroll
    for (int i = 0; i < 4; ++i) { c += a[i]; const int j = 4 * tid + i; if (j < 2048) dst[j] = c * LOG2E; }
    __syncthreads();
}
constexpr int ZPB = 576, WPB = 272, SG_W = 128 * ZPB, SG_RS = SG_W + 128 * WPB;
__device__ __forceinline__ void sgu_unit(LAS unsigned char* lds, int R0, const us* ZB, const us* UB, us* CAT, const float* ws_l, const float* bs_l, const float* gs_l) {
    const int tid = otid(), lane = tid & 63, wid = tid >> 6, r32 = lane & 31, hi = lane >> 5;
#pragma unroll
    for (int i = 0; i < 8; ++i) { const int idx = tid + 512 * i, row = idx >> 5, ch = idx & 31; *(LAS u32x4*)(lds + row * ZPB + ch * 16) = *(const u32x4*)(ZB + (size_t)(R0 + row) * 256 + ch * 8); }
    __syncthreads();
    { const int row = tid >> 2, q = tid & 3; float ss = 0.f;
#pragma unroll
      for (int i = 0; i < 8; ++i) { const u32x4 w = *(LAS const u32x4*)(lds + row * ZPB + q * 128 + i * 16);
#pragma unroll
          for (int e = 0; e < 4; ++e) { const float a = bf2f(w[e] & 0xffffu), b = bf2f(w[e] >> 16); ss += a * a + b * b; } }
      ss += __shfl_xor(ss, 1); ss += __shfl_xor(ss, 2);
      if (q == 0) ((LAS float*)(lds + SG_RS))[row] = rsqrtf(ss * (1.f / 256.f) + EPS); }
    __syncthreads();
    LAS const float* rsz = (LAS const float*)(lds + SG_RS);
#pragma unroll 1
    for (int g = 0; g < 4; ++g) {
#pragma unroll
        for (int i = 0; i < 4; ++i) { const int idx = tid + 512 * i, row = idx >> 4, ch = idx & 15;
            const float* wp = ws_l + (size_t)g * 16384 + row * 128 + ch * 8; f32x4 a = *(const f32x4*)wp, b = *(const f32x4*)(wp + 4);
            const bool z = (ch >= 8) && (row < 64);
            u32x4 o;
            if (z) o = (u32x4){0u, 0u, 0u, 0u};
            else { const int j0 = ch * 8; o.x = pk2(a[0] * rsz[j0], a[1] * rsz[j0 + 1]); o.y = pk2(a[2] * rsz[j0 + 2], a[3] * rsz[j0 + 3]); o.z = pk2(b[0] * rsz[j0 + 4], b[1] * rsz[j0 + 5]); o.w = pk2(b[2] * rsz[j0 + 6], b[3] * rsz[j0 + 7]); }
            *(LAS u32x4*)(lds + SG_W + row * WPB + ch * 16) = o; }
        __syncthreads();
        const int ib = wid & 3, chh = wid >> 2, cbase = g * 64 + 32 * chh;
        f32x16 acc = {};
        LAS const unsigned char* ap = lds + SG_W + (32 * ib + r32) * WPB + hi * 16;
        LAS const unsigned char* bp = lds + (8 * hi + ((lane & 15) >> 2)) * ZPB + (cbase + 16 * ((lane >> 4) & 1) + 4 * (lane & 3)) * 2;
#pragma unroll
        for (int ks = 0; ks < 8; ++ks) {
            const bf16x8 a = *(LAS const bf16x8*)(ap + ks * 32);
            const s16x4 l0 = trr(bp + (16 * ks) * ZPB), h0 = trr(bp + (16 * ks + 4) * ZPB);
            const bf16x8 b = (bf16x8){l0[0], l0[1], l0[2], l0[3], h0[0], h0[1], h0[2], h0[3]};
            acc = MFMA32(a, b, acc);
        }
        const int c = cbase + r32; const float gs = gs_l[c];
#pragma unroll
        for (int r = 0; r < 16; ++r) { const int i = 32 * ib + (r & 3) + 8 * (r >> 2) + 4 * hi;
            const float mixed = gs * acc[r] + bs_l[g * 128 + i]; const float u = bf2f(UB[(size_t)(R0 + i) * 256 + c]);
            CAT[(size_t)(R0 + i) * DM + 512 + c] = (us)f2bf(u * mixed); }
        __syncthreads();
    }
}
__device__ __forceinline__ void sgu_sample_unit(LAS unsigned char* lds, int b, const us* ZB, const us* UB, us* CAT, const float* ws_l, const float* bs_l, const float* gs_l, float* outv) {
    const int tid = otid(), R0 = NTP + 16 * b;
    LAS float* z = (LAS float*)lds; LAS float* rsz = z + 16 * 256;
    for (int i = tid; i < 4096; i += 512) z[i] = bf2f(ZB[(size_t)R0 * 256 + i]);
    __syncthreads();
    { const int row = tid >> 5, q = tid & 31; float ss = 0.f;
      for (int i = 0; i < 8; ++i) { const float a = z[row * 256 + q + 32 * i]; ss += a * a; }
      ss += __shfl_xor(ss, 1); ss += __shfl_xor(ss, 2); ss += __shfl_xor(ss, 4); ss += __shfl_xor(ss, 8); ss += __shfl_xor(ss, 16);
      if (q == 0) rsz[row] = rsqrtf(ss * (1.f / 256.f) + EPS); }
    __syncthreads();
    for (int o = tid; o < 4096; o += 512) {
        const int i = o >> 8, c = o & 255, g = c >> 6; const float gs = gs_l[c];
        float acc = 0.f;
#pragma unroll
        for (int j = 0; j < 16; ++j) acc += ws_l[(size_t)g * 16384 + i * 128 + j] * rsz[j] * z[j * 256 + c];
        const float mixed = gs * acc + bs_l[g * 128 + i]; const float u = bf2f(UB[(size_t)(R0 + i) * 256 + c]);
        CAT[(size_t)(R0 + i) * DM + 512 + c] = (us)f2bf(u * mixed);
        outv[(size_t)(16 * b + i) * 256 + c] = z[i * 256 + c] * rsz[i] * gs;
    }
    __syncthreads();
}
constexpr int SA_SC = 4096, SA_SCP = 1088, SA_BIAS = SA_SC + 16 * SA_SCP * 4, SA_MISC = SA_BIAS + 2048 * 4;
__device__ __forceinline__ void small_attn(LAS unsigned char* lds, const us* Q, int qp, const float* Kc, const float* Vc, int cp, int ncache, const float* Kn, const float* Vn, int np, int nnew,
                                           const float* lfc, const float* lfn, bool fox, us* O, int op) {
    const int tid = otid(), lane = tid & 63, wid = tid >> 6;
    const int nk = ncache + nnew, nkb = (nk + 15) >> 4;
    LAS float* SC = (LAS float*)(lds + SA_SC); LAS float* bias = (LAS float*)(lds + SA_BIAS); LAS float* misc = (LAS float*)(lds + SA_MISC);
    if (tid < 128) { const int row = tid >> 3, ch = tid & 7; *(LAS u32x4*)(lds + row * 144 + ch * 16) = *(const u32x4*)(Q + (size_t)row * qp + ch * 8); }
    if (fox) block_cumsum(bias, misc, nk, [&](int j) { return j < ncache ? lfc[(size_t)j * 8] : lfn[(size_t)(j - ncache) * 8]; });
    else __syncthreads();
    { const int kl = lane & 15, kq = lane >> 4;
      for (int kb = wid; kb < nkb; kb += 8) {
        const int key = kb * 16 + kl; const bool valid = key < nk; const int kk = valid ? key : 0;
        const float* src = (kk < ncache) ? Kc + (size_t)kk * cp : Kn + (size_t)(kk - ncache) * np;
        f32x4 acc = {0.f, 0.f, 0.f, 0.f};
#pragma unroll
        for (int s = 0; s < 2; ++s) {
            const f32x4 x0 = *(const f32x4*)(src + 32 * s + 8 * kq), x1 = *(const f32x4*)(src + 32 * s + 8 * kq + 4);
            const u32x4 bw = (u32x4){pk2(x0[0], x0[1]), pk2(x0[2], x0[3]), pk2(x1[0], x1[1]), pk2(x1[2], x1[3])};
            const bf16x8 a = *(LAS const bf16x8*)(lds + kl * 144 + (32 * s + 8 * kq) * 2);
            acc = MFMA16(a, __builtin_bit_cast(bf16x8, bw), acc);
        }
        const float bj = fox ? bias[key] : 0.f;
#pragma unroll
        for (int r = 0; r < 4; ++r) { const int qrow = 4 * kq + r; float sv = acc[r] - bj; if (!valid || (fox && key > ncache + qrow)) sv = -1e30f; SC[qrow * SA_SCP + key] = sv; }
      } }
    __syncthreads();
#pragma unroll
    for (int rr = 0; rr < 2; ++rr) { const int row = 2 * wid + rr; float mx = -1e30f;
        for (int j = lane; j < nkb * 16; j += 64) mx = fmaxf(mx, SC[row * SA_SCP + j]);
#pragma unroll
        for (int o = 1; o < 64; o <<= 1) mx = fmaxf(mx, __shfl_xor(mx, o));
        float sum = 0.f;
        for (int j = lane; j < nkb * 16; j += 64) { const float e = __builtin_amdgcn_exp2f(SC[row * SA_SCP + j] - mx); SC[row * SA_SCP + j] = e; sum += e; }
        sum = wave_sum(sum);
        if (lane == 0) misc[16 + row] = 1.f / sum; }
    __syncthreads();
    { const int d = lane; float a0 = 0.f, a1 = 0.f; LAS const float* s0 = SC + (2 * wid) * SA_SCP; LAS const float* s1 = s0 + SA_SCP;
#pragma unroll 8
      for (int j = 0; j < ncache; ++j) { const float v = Vc[(size_t)j * cp + d]; a0 += s0[j] * v; a1 += s1[j] * v; }
      for (int j = 0; j < nnew; ++j) { const float v = Vn[(size_t)j * np + d]; a0 += s0[ncache + j] * v; a1 += s1[ncache + j] * v; }
      O[(size_t)(2 * wid) * op + d] = (us)f2bf(a0 * misc[16 + 2 * wid]); O[(size_t)(2 * wid + 1) * op + d] = (us)f2bf(a1 * misc[17 + 2 * wid]); }
    __syncthreads();
}
#ifdef DBG_FOX
__device__ __forceinline__ void dbg_fox(const P& p, int l) {
    const us* QBp = (const us*)(WSB + WS_QB); const us* KBp = (const us*)(WSB + WS_KB); const us* VBp = (const us*)(WSB + WS_VB); us* CATp = (us*)(WSB + WS_CAT);
    const float* lf = OUTB + O_PLF + (size_t)l * NTP * 8;
    for (int id = blockIdx.x * 512 + otid(); id < 131072; id += gridDim.x * 512) {
        const int q = id & 2047, bh = id >> 11, b = bh >> 3, h = bh & 7;
        if ((FQM >> (q >> 8)) & 1) continue;
        float qv[64], o[64];
#pragma unroll
        for (int c8 = 0; c8 < 8; ++c8) { const u32x4 w = *(const u32x4*)(QBp + ((size_t)b * SEQ + q) * 512 + h * 64 + c8 * 8);
#pragma unroll
            for (int e = 0; e < 4; ++e) { qv[c8 * 8 + 2 * e] = bf2f(w[e] & 0xffffu); qv[c8 * 8 + 2 * e + 1] = bf2f(w[e] >> 16); } }
#pragma unroll
        for (int d = 0; d < 64; ++d) o[d] = 0.f;
        float m = -1e30f, ls = 0.f, c = 0.f;
        for (int j = 0; j <= q; ++j) {
            c += lf[((size_t)b * SEQ + j) * 8 + h] * LOG2E;
            const us* kr = KBp + ((size_t)b * SEQ + j) * 512 + h * 64; const us* vr = VBp + ((size_t)b * SEQ + j) * 512 + h * 64;
            float s = 0.f;
#pragma unroll
            for (int c8 = 0; c8 < 8; ++c8) { const u32x4 w = *(const u32x4*)(kr + c8 * 8);
#pragma unroll
                for (int e = 0; e < 4; ++e) { s += qv[c8 * 8 + 2 * e] * bf2f(w[e] & 0xffffu) + qv[c8 * 8 + 2 * e + 1] * bf2f(w[e] >> 16); } }
            s -= c;
            const float mn = fmaxf(m, s), al = __builtin_amdgcn_exp2f(m - mn), pj = __builtin_amdgcn_exp2f(s - mn); m = mn; ls = ls * al + pj;
#pragma unroll
            for (int c8 = 0; c8 < 8; ++c8) { const u32x4 w = *(const u32x4*)(vr + c8 * 8);
#pragma unroll
                for (int e = 0; e < 4; ++e) { o[c8 * 8 + 2 * e] = o[c8 * 8 + 2 * e] * al + pj * bf2f(w[e] & 0xffffu); o[c8 * 8 + 2 * e + 1] = o[c8 * 8 + 2 * e + 1] * al + pj * bf2f(w[e] >> 16); } }
        }
        const float inv = 1.f / ls;
#pragma unroll
        for (int c8 = 0; c8 < 8; ++c8) { u32x4 w;
#pragma unroll
            for (int e = 0; e < 4; ++e) w[e] = pk2(o[c8 * 8 + 2 * e] * inv, o[c8 * 8 + 2 * e + 1] * inv);
            *(u32x4*)(CATp + ((size_t)b * SEQ + q) * DM + h * 64 + c8 * 8) = w; }
    }
}
#endif
__device__ __forceinline__ void attn_phase(const P& p, LAS unsigned char* lds, int l) {
    const int G = gridDim.x, bx = blockIdx.x, vcu = (G % 8 == 0) ? (bx % 8) * (G / 8) + bx / 8 : bx;
#define A_QB ((const us*)(WSB + WS_QB))
#define A_KB ((const us*)(WSB + WS_KB))
#define A_VB ((const us*)(WSB + WS_VB))
#define A_UB ((const us*)(WSB + WS_UB))
#define A_ZB ((const us*)(WSB + WS_ZB))
#define A_QMB ((const us*)(WSB + WS_QMB))
#define A_MKV ((const us*)(WSB + WS_MKV) + (size_t)l * NMEMROWS * 512)
#define A_CAT ((us*)(WSB + WS_CAT))
#define A_WS (INP(12) + (size_t)l * 4 * 16384)
#define A_BS (INP(13) + (size_t)l * 512)
#define A_GS (INP(14) + (size_t)l * 256)
#ifdef DBG_FOX
    dbg_fox(p, l);
#endif
    for (int v = vcu; v < 256; v += G) {
        const int bh = v >> 2, s = v & 3, b = bh >> 3, h = bh & 7;
#pragma unroll 1
        for (int k = 0; k < 2; ++k) { const int qb = k ? 7 - s : s;
#ifdef DBG_FOX
            if (!((FQM >> qb) & 1)) continue;
#endif
            const float* lfP = OUTB + O_PLF + (size_t)l * NTP * 8 + (size_t)b * SEQ * 8 + h;
            block_cumsum((LAS float*)(lds + FL_BIAS), (LAS float*)(lds + FL_MISC), 256 * (qb + 1), [&](int j) { return lfP[(size_t)j * 8]; });
            flash_unit(lds, A_QB + ((size_t)b * SEQ + qb * 256) * 512 + h * 64, 512, A_KB + (size_t)b * SEQ * 512 + h * 64, 512, A_VB + (size_t)b * SEQ * 512 + h * 64, 512,
                       A_CAT + ((size_t)b * SEQ + qb * 256) * DM + h * 64, DM, 4 * (qb + 1), 4, true); }
    }
    for (int v = vcu; v < 256; v += G) { const int bh = v >> 3, qb = v & 7, b = bh >> 2, h = bh & 3; const us* mkv = A_MKV + (size_t)b * 256 * 512 + h * 64;
        flash_unit(lds, A_QMB + ((size_t)b * SEQ + qb * 256) * 256 + h * 64, 256, mkv, 512, mkv + 256, 512,
                   A_CAT + ((size_t)b * SEQ + qb * 256) * DM + 768 + h * 64, DM, 4, 0, false); }
    for (int v = G - 1 - vcu; v < 128; v += G) sgu_unit(lds, v * 128, A_ZB, A_UB, A_CAT, A_WS, A_BS, A_GS);
    for (int v = vcu; v < 128; v += G) { const int b = v >> 3, h = v & 7; const size_t co = ((size_t)(l * NBS + b) * PAST) * 512 + h * 64, no = ((size_t)l * NTS + 16 * b) * 512 + h * 64;
        small_attn(lds, A_QB + (size_t)(NTP + 16 * b) * 512 + h * 64, 512, INP(3) + co, INP(4) + co, 512, PAST, OUTB + O_SK + no, OUTB + O_SV + no, 512, 16,
                   INP(5) + ((size_t)(l * NBS + b) * PAST) * 8 + h, OUTB + O_SLF + (size_t)l * NTS * 8 + (size_t)(16 * b) * 8 + h, true, A_CAT + (size_t)(NTP + 16 * b) * DM + h * 64, DM); }
    for (int v = G - 1 - vcu; v < 64; v += G) { const int b = v >> 2, h = v & 3; const size_t co = ((size_t)(l * NBS + b) * 256) * 256 + h * 64;
        small_attn(lds, A_QMB + (size_t)(NTP + 16 * b) * 256 + h * 64, 256, INP(6) + co, INP(7) + co, 256, 256,
                   nullptr, nullptr, 0, 0, nullptr, nullptr, false, A_CAT + (size_t)(NTP + 16 * b) * DM + 768 + h * 64, DM); }
    for (int v = vcu - 128; v >= 0 && v < 16; v += G) sgu_sample_unit(lds, v, A_ZB, A_UB, A_CAT, A_WS, A_BS, A_GS, OUTB + O_SGV + (size_t)l * NTS * 256);
}
__device__ __forceinline__ void gnorm_phase(const P& p, int l) {
    const int tid_ = otid(), lane = tid_ & 63, wid = tid_ >> 6; us* CAT = (us*)(WSB + WS_CAT); const float* gg = INP(17) + (size_t)l * DM;
    for (int row = blockIdx.x * 8 + wid; row < NT; row += gridDim.x * 8) {
        u32x4* rp = (u32x4*)(CAT + (size_t)row * DM + 16 * lane); const u32x4 w0 = rp[0], w1 = rp[1];
        float v[16];
#pragma unroll
        for (int e = 0; e < 4; ++e) { v[2 * e] = bf2f(w0[e] & 0xffffu); v[2 * e + 1] = bf2f(w0[e] >> 16); v[8 + 2 * e] = bf2f(w1[e] & 0xffffu); v[8 + 2 * e + 1] = bf2f(w1[e] >> 16); }
        float ss = 0.f;
#pragma unroll
        for (int e = 0; e < 16; ++e) ss += v[e] * v[e];
        ss += __shfl_xor(ss, 1); ss += __shfl_xor(ss, 2); ss += __shfl_xor(ss, 4); ss += __shfl_xor(ss, 8);
        const float s16 = __shfl_xor(ss, 16); float wdt = 256.f; if (lane < 32) { ss += s16; wdt = 512.f; }
        const float r = rsqrtf(ss / wdt + EPS);
        const f32x4 g0 = *(const f32x4*)(gg + 16 * lane), g1 = *(const f32x4*)(gg + 16 * lane + 4), g2 = *(const f32x4*)(gg + 16 * lane + 8), g3 = *(const f32x4*)(gg + 16 * lane + 12);
        u32x4 o0, o1;
        o0.x = pk2(v[0] * r * g0[0], v[1] * r * g0[1]); o0.y = pk2(v[2] * r * g0[2], v[3] * r * g0[3]); o0.z = pk2(v[4] * r * g1[0], v[5] * r * g1[1]); o0.w = pk2(v[6] * r * g1[2], v[7] * r * g1[3]);
        o1.x = pk2(v[8] * r * g2[0], v[9] * r * g2[1]); o1.y = pk2(v[10] * r * g2[2], v[11] * r * g2[3]); o1.z = pk2(v[12] * r * g3[0], v[13] * r * g3[1]); o1.w = pk2(v[14] * r * g3[2], v[15] * r * g3[3]);
        rp[0] = o0; rp[1] = o1;
    }
}
__device__ __forceinline__ void fixup_phase(const P& p, int l) {
    const float* wdw = INP(22) + (size_t)l * 3 * FF; const float* bdw = INP(23) + (size_t)l * FF;
    const float* AF = (const float*)(WSB + WS_AF); const float* LF = (const float*)(WSB + WS_LF); const float* AL = (const float*)(WSB + WS_AL);
    const float* SA = (const float*)(WSB + WS_SA); const float* SL = (const float*)(WSB + WS_SL); us* G = (us*)(WSB + WS_G);
    const int gt = blockIdx.x * 512 + otid(), gn = gridDim.x * 512;
    for (int i = gt; i < 256 * 2 * FF; i += gn) { const int f = i % FF, sr = i / FF, rr = sr & 1, s = sr >> 1;
        const bool first = (s & 31) == 0;
        const float l0 = first ? 0.f : AL[((size_t)(s - 1) * 2) * FF + f], l1 = first ? 0.f : AL[((size_t)(s - 1) * 2 + 1) * FF + f];
        const float a2 = AF[(size_t)sr * FF + f], a1 = rr ? AF[((size_t)s * 2) * FF + f] : l1, a0 = rr ? l1 : l0;
        const float g = silu_f(bdw[f] + wdw[f] * a0 + wdw[FF + f] * a1 + wdw[2 * FF + f] * a2) * LF[(size_t)sr * FF + f];
        G[((size_t)s * 64 + rr) * FF + f] = (us)f2bf(g); }
    const float* hist = INP(8) + (size_t)l * NBS * 2 * FF;
    for (int i = gt; i < NTS * FF; i += gn) { const int f = i % FF, r = i / FF, b = r >> 4, t = r & 15;
        const float a2 = SA[(size_t)r * FF + f];
        const float a1 = (t >= 1) ? SA[(size_t)(r - 1) * FF + f] : hist[((size_t)b * 2 + 1) * FF + f];
        const float a0 = (t >= 2) ? SA[(size_t)(r - 2) * FF + f] : hist[((size_t)b * 2 + t) * FF + f];
        const float g = silu_f(bdw[f] + wdw[f] * a0 + wdw[FF + f] * a1 + wdw[2 * FF + f] * a2) * SL[(size_t)r * FF + f];
        G[((size_t)NTP + r) * FF + f] = (us)f2bf(g); }
    float* oc = OUTB + O_PCONV + (size_t)l * NBP * 2 * FF;
    for (int i = gt; i < NBP * 2 * FF; i += gn) { const int f = i % FF, br = i / FF, b = br >> 1, rr = br & 1; oc[i] = AL[((size_t)(32 * b + 31) * 2 + rr) * FF + f]; }
    float* os = OUTB + O_SCONV + (size_t)l * NBS * 2 * FF;
    for (int i = gt; i < NBS * 2 * FF; i += gn) { const int f = i % FF, br = i / FF, b = br >> 1, rr = br & 1; os[i] = SA[((size_t)b * 16 + 14 + rr) * FF + f]; }
}
__device__ __forceinline__ void small_gemm(LAS unsigned char* lds, const us* A  , const us* Bt, int K, float* Y, float* YSQ) {
    const int tid = otid(), lane = tid & 63, wid = tid >> 6, cg4 = wid & 3, kh = wid >> 2, rl = lane & 15, kq = lane >> 4;
    LAS float* xch = (LAS float*)lds;
    for (int it = blockIdx.x; it < 256; it += gridDim.x) {
        const int rb = it >> 4, cb = it & 15;
        const us* ap = A + (size_t)(rb * 16 + rl) * K + kh * (K / 2) + 8 * kq; const us* bp = Bt + (size_t)(cb * 64 + cg4 * 16 + rl) * K + kh * (K / 2) + 8 * kq;
        f32x4 acc = {0.f, 0.f, 0.f, 0.f};
#pragma unroll 4
        for (int k = 0; k < K / 2; k += 32) acc = MFMA16(*(const bf16x8*)(ap + k), *(const bf16x8*)(bp + k), acc);
        if (kh == 1) *(LAS f32x4*)(xch + (cg4 * 64 + lane) * 4) = acc;
        __syncthreads();
        if (kh == 0) {
            acc = acc + *(LAS const f32x4*)(xch + (cg4 * 64 + lane) * 4);
            const int col = cb * 64 + cg4 * 16 + rl;
#pragma unroll
            for (int r = 0; r < 4; ++r) { const int row = rb * 16 + 4 * kq + r; Y[(size_t)row * DM + col] = acc[r];
                float ss = acc[r] * acc[r]; ss += __shfl_xor(ss, 1); ss += __shfl_xor(ss, 2); ss += __shfl_xor(ss, 4); ss += __shfl_xor(ss, 8);
                if (rl == 0) xch[1024 + cg4 * 16 + 4 * kq + r] = ss; }
        }
        __syncthreads();
        if (tid < 16) YSQ[(size_t)(rb * 16 + tid) * 16 + cb] = (xch[1024 + tid] + xch[1024 + 16 + tid]) + (xch[1024 + 32 + tid] + xch[1024 + 48 + tid]);
        __syncthreads();
    }
}
constexpr int LDS_BYTES = 147456;
constexpr int NPHASE = 19;
__device__ __forceinline__ void gbar(unsigned* ctr, unsigned target) {
    __threadfence();
    __syncthreads();
    if (threadIdx.x == 0) {
        __hip_atomic_fetch_add(ctr, 1u, __ATOMIC_RELEASE, __HIP_MEMORY_SCOPE_AGENT);
        while (__hip_atomic_load(ctr, __ATOMIC_ACQUIRE, __HIP_MEMORY_SCOPE_AGENT) < target) __builtin_amdgcn_s_sleep(2);
    }
    __syncthreads();
    __threadfence();
}
__global__ void __launch_bounds__(512, 2) mega(P p) {
    extern __shared__ __attribute__((aligned(16))) unsigned char lds_raw[];
    LAS unsigned char* lds = (LAS unsigned char*)lds_raw;
    if (p.coop) { cg::grid_group grid = cg::this_grid(); grid.sync(); }
    unsigned nbar = 0;
#define XB ((us*)(WSB + WS_XB))
#define RS ((float*)(WSB + WS_RS))
#define X (OUTB + O_Y)
#define Y ((float*)(WSB + WS_Y))
#define YSQ ((float*)(WSB + WS_YSQ))
    for (int ph = p.ph_lo; ph < p.ph_hi; ++ph) {
        if (ph == 0) {
            prep_phase(p, lds);
            row_pass<false, true, true>(INP(0), INP(1), NT, nullptr, nullptr, nullptr, nullptr, XB, RS, INP(10), INP(9), INP(11), OUTB + O_PLF, OUTB + O_SLF);
            row_pass<false, false, true>(INP(2), INP(2), NMEMROWS, nullptr, nullptr, nullptr, nullptr, (us*)(WSB + WS_MEMB), (float*)(WSB + WS_RSMEM), nullptr, nullptr, nullptr, nullptr, nullptr);
        } else {
            const int l = (ph - 1) / 9, s = (ph - 1) % 9;
            if (s == 0) {
                { pg8::Gemm g{XB, (const us*)(WSB + WS_WIN) + (size_t)l * NIN * DM, NT, NIN, DM}; pg8::StaticOrder S; S.init(NT, NIN, gridDim.x, blockIdx.x);
                  pg8::EpiIn E{0, l, WSB, OUTB};
                  pg8::gemm_phase<pg8::EpiIn, pg8::StaticOrder, true, true>(lds, g, S, E); }
                if (l == 0) {
#pragma unroll 1
                    for (int ll = 0; ll < 2; ++ll) {
                        pg8::Gemm g{(const us*)(WSB + WS_MEMB), (const us*)(WSB + WS_WMEM) + (size_t)ll * 512 * DM, NMEMROWS, 512, DM}; pg8::StaticOrder S; S.init(NMEMROWS, 512, gridDim.x, (blockIdx.x + 80 + 16 * ll) % gridDim.x);
                        pg8::EpiIn E{1, ll, WSB, OUTB};
                        pg8::gemm_phase<pg8::EpiIn, pg8::StaticOrder, true, true>(lds, g, S, E); }
                }
            } else if (s == 1) { attn_phase(p, lds, l);
            } else if (s == 2) { gnorm_phase(p, l);
            } else if (s == 3 || s == 7) {
                const us* A = (s == 3) ? (const us*)(WSB + WS_CAT) : (const us*)(WSB + WS_G); const int K = (s == 3) ? DM : FF;
                const us* Bt = (s == 3) ? (const us*)(WSB + WS_WOUT) + (size_t)l * DM * DM : (const us*)(WSB + WS_WDOWN) + (size_t)l * DM * FF;
                { pg8::Gemm g{A, Bt, NTP, DM, K}; pg8::StaticOrder S; S.init(NTP, DM, gridDim.x, blockIdx.x); pg8::EpiY E{WSB};
                  pg8::gemm_phase<pg8::EpiY, pg8::StaticOrder, true, true>(lds, g, S, E); }
                small_gemm(lds, A + (size_t)NTP * K, Bt, K, Y + (size_t)NTP * DM, YSQ + (size_t)NTP * 16);
            } else if (s == 4) {
                const float* xp = (l == 0) ? INP(0) : X; const float* xs = (l == 0) ? INP(1) : X + (size_t)NTP * DM;
                row_pass<true, false, true>(xp, xs, NT, X, Y, YSQ, INP(19) + (size_t)l * DM, XB, RS, nullptr, nullptr, nullptr, nullptr, nullptr);
            } else if (s == 5) {
                pg8::Gemm g{XB, (const us*)(WSB + WS_WUP) + (size_t)l * NUP * DM, NT, NUP, DM}; pg8::StaticOrder S; S.init(NT, NUP, gridDim.x, blockIdx.x);
                pg8::EpiUp E{WSB, INP(22) + (size_t)l * 3 * FF, INP(23) + (size_t)l * FF};
                pg8::gemm_phase<pg8::EpiUp, pg8::StaticOrder, true, true>(lds, g, S, E);
            } else if (s == 6) { fixup_phase(p, l);
            } else {
                if (l == 0) row_pass<true, true, true>(X, X + (size_t)NTP * DM, NT, X, Y, YSQ, INP(25), XB, RS, INP(10) + (size_t)DM * INC, INP(9) + DM, INP(11) + 8, OUTB + O_PLF + (size_t)NTP * 8, OUTB + O_SLF + (size_t)NTS * 8);
                else row_pass<true, false, false>(X, X + (size_t)NTP * DM, NT, X, Y, YSQ, INP(25) + DM, nullptr, nullptr, nullptr, nullptr, nullptr, nullptr, nullptr);
            }
        }
        if (p.coop && ph + 1 < p.ph_hi) { ++nbar; gbar((unsigned*)(WSB + WS_CTL), nbar * gridDim.x); }
    }
}

#undef XB
#undef RS
#undef X
#undef Y
#undef YSQ
extern "C" void kernel_launch(void* const* d_in, const int* in_sizes, int n_in, void* d_out, int out_size, void* d_ws, size_t ws_size, hipStream_t stream) {
    static int grid = 0;
    if (grid == 0) {
        if (n_in != 26 || out_size != (int)O_END || ws_size < WS_END) { fprintf(stderr, "kernel_launch: unexpected sizes n_in %d out %d ws %zu (need %zu)\n", n_in, out_size, ws_size, (size_t)WS_END); grid = -1; return; }
        int dev = 0, cus = 0, per_cu = 0;
        (void)hipGetDevice(&dev); (void)hipDeviceGetAttribute(&cus, hipDeviceAttributeMultiprocessorCount, dev);
        if (hipFuncSetAttribute((const void*)mega, hipFuncAttributeMaxDynamicSharedMemorySize, LDS_BYTES) != hipSuccess) { fprintf(stderr, "kernel_launch: hipFuncSetAttribute failed\n"); grid = -1; return; }
        (void)hipOccupancyMaxActiveBlocksPerMultiprocessor(&per_cu, (const void*)mega, 512, LDS_BYTES);
        (void)hipGetLastError();
        if (per_cu < 1) fprintf(stderr, "kernel_launch: occupancy query says %d blocks per CU\n", per_cu);
        grid = cus > 0 ? cus : 256;
    }
    if (grid < 0) return;
    if (hipMemsetAsync((char*)d_ws + WS_CTL, 0, 256, stream) != hipSuccess) { fprintf(stderr, "kernel_launch: memset failed\n"); return; }
    P p{};
    for (int i = 0; i < 26; ++i) p.in[i] = (const float*)d_in[i];
    p.out = (float*)d_out; p.ws = (unsigned char*)d_ws; p.pad = 0;
#ifndef MK_MULTI
    p.ph_lo = 0; p.ph_hi = NPHASE; p.coop = 1;
    void* args[] = {&p};
    hipError_t e = hipLaunchCooperativeKernel((void*)mega, dim3(grid), dim3(512), args, LDS_BYTES, stream);
    if (e != hipSuccess) fprintf(stderr, "kernel_launch: cooperative launch failed: %s (grid %d)\n", hipGetErrorString(e), grid);
#else
    for (int ph = 0; ph < NPHASE; ++ph) { p.ph_lo = ph; p.ph_hi = ph + 1; p.coop = 0; hipLaunchKernelGGL(mega, dim3(grid), dim3(512), LDS_BYTES, stream, p); }
#endif
}
```

```cpp
#include <hip/hip_runtime.h>
#include <hip/hip_cooperative_groups.h>
#include <cstdio>
#include <cstdint>
namespace cg = cooperative_groups;
#define LAS __attribute__((address_space(3)))
typedef unsigned short us;
typedef float f32x16 __attribute__((ext_vector_type(16)));
typedef short s16x4 __attribute__((ext_vector_type(4)));

constexpr int DM = 1024, NTP = 16384, NTS = 256, NT = NTP + NTS, SEQ = 2048, NBP = 8, NBS = 16, PAST = 1024;
constexpr int INC = 2312, NIN = 2304, FF = 2816, NUP = 5632, NMEMROWS = 2048;
constexpr float LOG2E = 1.4426950408889634f, C2 = 0.125f * 1.4426950408889634f, EPS = 1e-6f;

constexpr size_t O_Y = 0, O_YS = 16777216, O_PK = 17039360, O_PV = 33816576, O_PLF = 50593792, O_PMK = 50855936, O_PMV = 51904512,
                 O_PCONV = 52953088, O_SK = 53043200, O_SV = 53305344, O_SLF = 53567488, O_SGV = 53571584, O_SCONV = 53702656, O_END = 53882880;
constexpr size_t MiB = 1u << 20;
constexpr size_t WS_WIN = 0;
constexpr size_t WS_WOUT = 10 * MiB;
constexpr size_t WS_WUP = 14 * MiB;
constexpr size_t WS_WDOWN = 36 * MiB;
constexpr size_t WS_WMEM = 47 * MiB;
constexpr size_t WS_XB = 49 * MiB;
constexpr size_t WS_MEMB = 82 * MiB;
constexpr size_t WS_MKV = 86 * MiB;
constexpr size_t WS_RS = 90 * MiB;
constexpr size_t WS_RSMEM = 90 * MiB + 128 * 1024;
constexpr size_t WS_YSQ = 91 * MiB;
constexpr size_t WS_AF = 93 * MiB;
constexpr size_t WS_LF = 99 * MiB;
constexpr size_t WS_AL = 105 * MiB;
constexpr size_t WS_SA = 111 * MiB;
constexpr size_t WS_SL = 114 * MiB;
constexpr size_t WS_Y = 117 * MiB;
constexpr size_t WS_ACT = 183 * MiB;
constexpr size_t WS_QB = WS_ACT;
constexpr size_t WS_KB = WS_ACT + 17 * MiB;
constexpr size_t WS_VB = WS_ACT + 34 * MiB;
constexpr size_t WS_UB = WS_ACT + 51 * MiB;
constexpr size_t WS_ZB = WS_ACT + 60 * MiB;
constexpr size_t WS_QMB = WS_ACT + 69 * MiB;
constexpr size_t WS_CAT = WS_ACT + 78 * MiB;
constexpr size_t WS_G = WS_ACT;
constexpr size_t WS_CTL = WS_ACT + 111 * MiB;
constexpr size_t WS_END = WS_ACT + 112 * MiB;

__device__ __forceinline__ unsigned f2bf(float f) { unsigned u = __builtin_bit_cast(unsigned, f); return (u + 0x7fffu + ((u >> 16) & 1u)) >> 16; }
__device__ __forceinline__ unsigned pk2(float lo, float hi) { return f2bf(lo) | (f2bf(hi) << 16); }
__device__ __forceinline__ float bf2f(unsigned h) { return __builtin_bit_cast(float, h << 16); }
__device__ __forceinline__ float gelu_tanh(float x) { const float y = 0.7978845608028654f * (x + 0.044715f * x * x * x); return x / (1.f + __expf(-2.f * y)); }
__device__ __forceinline__ float silu_f(float x) { return x / (1.f + __expf(-x)); }
__device__ __forceinline__ float wave_sum(float v) {
#pragma unroll
    for (int o = 1; o < 64; o <<= 1) v += __shfl_xor(v, o);
    return v;
}
__device__ __forceinline__ int opq0() { int z; asm volatile("s_mov_b32 %0, 0" : "=s"(z)); return z; }
__device__ __forceinline__ int otid() { int t = threadIdx.x; asm volatile("" : "+v"(t)); return t; }
namespace pg8 {
#define PG8_LAS __attribute__((address_space(3)))
typedef unsigned short bf16_t;
typedef short bf16x8 __attribute__((ext_vector_type(8)));
typedef float f32x4 __attribute__((ext_vector_type(4)));
typedef unsigned u32x4 __attribute__((ext_vector_type(4)));
constexpr int BM = 256, BK = 64, HALF = 128, HTB = HALF * BK * 2  , STAGE_BYTES = 8 * HTB, NXCD = 8, WGM = 8;

__host__ __device__ __forceinline__ int lds_byte(int r, int c) { const int st = (r >> 4) * 2 + (c >> 5), rr = r & 15, cc = c & 31, ob = rr * 64 + cc * 2; return st * 1024 + (ob ^ (((ob >> 9) & 1) << 5)); }
__host__ __device__ __forceinline__ void stage_rc(int b, int& R, int& C) { const int st = b / 1024, sb = b % 1024, swz = sb ^ (((sb >> 9) & 1) << 5); R = (st >> 1) * 16 + swz / 64; C = (st & 1) * 32 + (swz % 64) / 2; }
__host__ __device__ __forceinline__ int perm32(int rho) { const int n = rho >> 4, i = rho & 15; return 8 * (i >> 2) + 4 * n + (i & 3); }

struct Unit { int pm, pn; };
struct Gemm { const bf16_t* A; const bf16_t* Bt; int M, N, K; };

struct StaticOrder {
    int nM, nN, nwg, G, c;
    __host__ __device__ void init(int M, int N, int G_, int c_) { nM = M / BM; nN = N / BM; nwg = nM * nN; G = G_; c = c_; }
    __host__ __device__ bool next(int i, Unit& u) const {
        const long L = (long)i * G + c; if (L >= nwg) return false;
        int wgid = (int)L; { const int q = nwg / NXCD, r = nwg % NXCD, xcd = wgid % NXCD, off = wgid / NXCD; wgid = (xcd < r ? xcd * (q + 1) : r * (q + 1) + (xcd - r) * q) + off; }
        const int nig = WGM * nN, gid = wgid / nig, fm = gid * WGM, gsz = (nM - fm) < WGM ? (nM - fm) : WGM;
        u.pm = fm + ((wgid % nig) % gsz); u.pn = (wgid % nig) / gsz; return true;
    }
    __device__ __forceinline__ void a_ready(const Unit&) const {}
    __device__ __forceinline__ void done(const Unit&) const {}
};
__device__ __forceinline__ unsigned cvt_pk_bf16(float lo, float hi) { unsigned r; asm volatile("v_cvt_pk_bf16_f32 %0, %1, %2" : "=v"(r) : "v"(lo), "v"(hi)); return r; }
struct EpiIn {
    static constexpr bool PERM = true, AFTER_DRAIN = false;
    int mode, l; unsigned char* ws; float* out;
    __device__ __forceinline__ void operator()(const f32x4 (&acc)[2][2][4][2], const Unit& u, int wr, int wc, int fr_, int fq_) const {
        int fr = fr_, fq = fq_; asm volatile("" : "+v"(fr), "+v"(fq));
        const int pn = u.pn;
        const float* rs = (const float*)(ws + (mode == 0 ? WS_RS : WS_RSMEM));
        bf16_t* const QB = (bf16_t*)(ws + WS_QB); bf16_t* const KB = (bf16_t*)(ws + WS_KB); bf16_t* const VB = (bf16_t*)(ws + WS_VB); bf16_t* const UB = (bf16_t*)(ws + WS_UB);
        bf16_t* const ZB = (bf16_t*)(ws + WS_ZB); bf16_t* const QMB = (bf16_t*)(ws + WS_QMB); bf16_t* const MKV = (bf16_t*)(ws + WS_MKV) + (size_t)l * NMEMROWS * 512;
        float* const oKp = out + O_PK + (size_t)l * NTP * 512; float* const oVp = out + O_PV + (size_t)l * NTP * 512; float* const oKs = out + O_SK + (size_t)l * NTS * 512; float* const oVs = out + O_SV + (size_t)l * NTS * 512;
        float* const oMK = out + O_PMK + (size_t)l * NMEMROWS * 256; float* const oMV = out + O_PMV + (size_t)l * NMEMROWS * 256;
        bf16_t* bdst; int bp; int bc; float mult = 1.f; int act = 0; float* fP = nullptr; float* fS = nullptr; int fp_ = 0, fc = 0;
        if (mode == 0) {
            if (pn < 2) { bdst = QB; bp = 512; bc = pn * 256; mult = C2; }
            else if (pn < 4) { bdst = KB; bp = 512; bc = (pn - 2) * 256; fP = oKp; fS = oKs; fp_ = 512; fc = bc; }
            else if (pn < 6) { bdst = VB; bp = 512; bc = (pn - 4) * 256; fP = oVp; fS = oVs; fp_ = 512; fc = bc; }
            else if (pn == 6) { bdst = UB; bp = 256; bc = 0; act = 1; }
            else if (pn == 7) { bdst = ZB; bp = 256; bc = 0; act = 1; }
            else { bdst = QMB; bp = 256; bc = 0; mult = C2; }
        } else { bdst = MKV; bp = 512; bc = pn * 256; fP = pn ? oMV : oMK; fS = fP; fp_ = 256; fc = 0; }
#pragma unroll
        for (int ai = 0; ai < 2; ++ai)
#pragma unroll
            for (int m = 0; m < 4; ++m) {
                const int row = u.pm * BM + ai * HALF + wr * 64 + m * 16 + fr;
                const float s = rs[row] * mult;
                float* frow = nullptr;
                if (fP) frow = (mode == 0 && row >= NTP) ? fS + (size_t)(row - NTP) * fp_ + fc : fP + (size_t)row * fp_ + fc;
#pragma unroll
                for (int bj = 0; bj < 2; ++bj) {
                    const int lc = bj * HALF + wc * 32 + 8 * fq;
                    f32x4 v0 = acc[ai][bj][m][0] * s, v1 = acc[ai][bj][m][1] * s;
                    if (act) { v0 = (f32x4){gelu_tanh(v0[0]), gelu_tanh(v0[1]), gelu_tanh(v0[2]), gelu_tanh(v0[3])}; v1 = (f32x4){gelu_tanh(v1[0]), gelu_tanh(v1[1]), gelu_tanh(v1[2]), gelu_tanh(v1[3])}; }
                    if (frow) { *(f32x4*)(frow + lc) = v0; *(f32x4*)(frow + lc + 4) = v1; }
                    u32x4 w; w.x = cvt_pk_bf16(v0[0], v0[1]); w.y = cvt_pk_bf16(v0[2], v0[3]); w.z = cvt_pk_bf16(v1[0], v1[1]); w.w = cvt_pk_bf16(v1[2], v1[3]);
                    *(u32x4*)(bdst + (size_t)row * bp + bc + lc) = w;
                }
            }
    }
};
struct EpiY {
    static constexpr bool PERM = true, AFTER_DRAIN = false;
    unsigned char* ws;
    __device__ __forceinline__ void operator()(const f32x4 (&acc)[2][2][4][2], const Unit& u, int wr, int wc, int fr_, int fq_) const {
        int fr = fr_, fq = fq_; asm volatile("" : "+v"(fr), "+v"(fq));
        float* const Y = (float*)(ws + WS_Y); float* const YSQ = (float*)(ws + WS_YSQ);
#pragma unroll
        for (int ai = 0; ai < 2; ++ai)
#pragma unroll
            for (int m = 0; m < 4; ++m) {
                const int row = u.pm * BM + ai * HALF + wr * 64 + m * 16 + fr;
                float ss = 0.f;
#pragma unroll
                for (int bj = 0; bj < 2; ++bj) {
                    const int c = u.pn * BM + bj * HALF + wc * 32 + 8 * fq;
                    const f32x4 v0 = acc[ai][bj][m][0], v1 = acc[ai][bj][m][1];
                    *(f32x4*)(Y + (size_t)row * DM + c) = v0; *(f32x4*)(Y + (size_t)row * DM + c + 4) = v1;
                    ss += (v0[0] * v0[0] + v0[1] * v0[1]) + (v0[2] * v0[2] + v0[3] * v0[3]) + (v1[0] * v1[0] + v1[1] * v1[1]) + (v1[2] * v1[2] + v1[3] * v1[3]);
                }
                ss += __shfl_xor(ss, 16); ss += __shfl_xor(ss, 32);
                if (fq == 0) YSQ[(size_t)row * 16 + u.pn * 4 + wc] = ss;
            }
    }
};
struct EpiUp {
    static constexpr bool PERM = true, AFTER_DRAIN = false;
    unsigned char* ws; const float* wdw; const float* bdw;
    __device__ __forceinline__ void operator()(const f32x4 (&acc)[2][2][4][2], const Unit& u, int wr, int wc, int fr_, int fq_) const {
        int fr = fr_, fq = fq_; asm volatile("" : "+v"(fr), "+v"(fq));
        const int f0 = u.pn * 128 + wc * 32 + 8 * fq;
        const float* rs = (const float*)(ws + WS_RS); bf16_t* const G = (bf16_t*)(ws + WS_G);
        float* const AF = (float*)(ws + WS_AF); float* const LF = (float*)(ws + WS_LF); float* const AL = (float*)(ws + WS_AL); float* const SA = (float*)(ws + WS_SA); float* const SL = (float*)(ws + WS_SL);
        const int lane = fq * 16 + fr;
        if (u.pm == NTP / BM) {
#pragma unroll
            for (int ai = 0; ai < 2; ++ai)
#pragma unroll
                for (int m = 0; m < 4; ++m) {
                    const int lr = ai * HALF + wr * 64 + m * 16 + fr; const float s = rs[NTP + lr];
                    *(f32x4*)(SA + (size_t)lr * FF + f0) = acc[ai][0][m][0] * s; *(f32x4*)(SA + (size_t)lr * FF + f0 + 4) = acc[ai][0][m][1] * s;
                    *(f32x4*)(SL + (size_t)lr * FF + f0) = acc[ai][1][m][0] * s; *(f32x4*)(SL + (size_t)lr * FF + f0 + 4) = acc[ai][1][m][1] * s;
                }
            return;
        }
        const int src1 = (lane & 48) | ((fr - 1) & 15), src2 = (lane & 48) | ((fr - 2) & 15);
#pragma unroll
        for (int n = 0; n < 2; ++n) {
            const int fn = f0 + 4 * n;
            const f32x4 w0 = *(const f32x4*)(wdw + fn), w1 = *(const f32x4*)(wdw + FF + fn), w2 = *(const f32x4*)(wdw + 2 * FF + fn), bb = *(const f32x4*)(bdw + fn);
#pragma unroll
            for (int ai = 0; ai < 2; ++ai) {
                const int strip = u.pm * 4 + ai * 2 + wr;
                f32x4 ap = {0.f, 0.f, 0.f, 0.f};
#pragma unroll
                for (int m = 0; m < 4; ++m) {
                    const int row = u.pm * BM + ai * HALF + wr * 64 + m * 16 + fr; const float s = rs[row];
                    const f32x4 a = acc[ai][0][m][n] * s, li = acc[ai][1][m][n] * s; f32x4 gv;
#pragma unroll
                    for (int e = 0; e < 4; ++e) {
                        const float s1 = (fr == 15) ? ap[e] : a[e], s2 = (fr >= 14) ? ap[e] : a[e];
                        const float a1 = __shfl(s1, src1), a0 = __shfl(s2, src2);
                        gv[e] = silu_f(bb[e] + w0[e] * a0 + w1[e] * a1 + w2[e] * a[e]) * li[e];
                    }
                    if (m == 0 && fr < 2) {
                        *(f32x4*)(AF + ((size_t)strip * 2 + fr) * FF + fn) = a; *(f32x4*)(LF + ((size_t)strip * 2 + fr) * FF + fn) = li;
                    } else {
                        unsigned long long w = (unsigned long long)cvt_pk_bf16(gv[0], gv[1]) | ((unsigned long long)cvt_pk_bf16(gv[2], gv[3]) << 32);
                        *(unsigned long long*)(G + (size_t)row * FF + fn) = w;
                    }
                    if (m == 3 && fr >= 14) *(f32x4*)(AL + ((size_t)strip * 2 + (fr - 14)) * FF + fn) = a;
                    ap = a;
                    __builtin_amdgcn_sched_barrier(0);
                }
            }
        }
    }
};
template <class Epi, class Sched, bool ALIGN_EPI = false, bool SP2 = false>
__device__ __forceinline__ void gemm_phase(PG8_LAS unsigned char* lds, const Gemm g, const Sched& S, const Epi& E) {
    const int tid = otid(), wid = __builtin_amdgcn_readfirstlane(tid >> 6), lane = tid & 63, wr = wid >> 2, wc = wid & 3, fr = lane & 15, fq = lane >> 4;
    const int K = g.K, nt = K / BK;
    unsigned voffA[2], voffB[2];
#pragma unroll
    for (int i = 0; i < 2; ++i) { int R, C; stage_rc(tid * 16 + i * 8192, R, C); const int Rb = Epi::PERM ? ((R & ~31) + perm32(R & 31)) : R;
        voffA[i] = (unsigned)(R * K + C) * 2u; voffB[i] = (unsigned)(Rb * K + C) * 2u; }
    const size_t kstep = (size_t)(BK * 2);
    const size_t hstep = (size_t)HALF * K * 2;
    const size_t tstep = 2 * hstep;
    const unsigned ldsw = (unsigned)wid * 1024u;
    const int aoff = lds_byte(wr * 64 + fr, fq * 8), boff = lds_byte(wc * 32 + fr, fq * 8);
#define PG8_SA(b, h) (((b) * 2 + (h)) * HTB)
#define PG8_SB(b, h) ((4 + (b) * 2 + (h)) * HTB)
#define PG8_STAGE(bufoff, gbase, voff) do { _Pragma("unroll") for (int _i = 0; _i < 2; ++_i) \
        __builtin_amdgcn_global_load_lds((const unsigned*)((const char*)(gbase) + (voff)[_i]), (PG8_LAS unsigned*)(lds + (bufoff) + ldsw + _i * 8192), 16, 0, 0); } while (0)
#define PG8_LDA(dst, b, h) do { _Pragma("unroll") for (int m = 0; m < 4; ++m) _Pragma("unroll") for (int k = 0; k < 2; ++k) dst[m][k] = *(const PG8_LAS bf16x8*)(lds + PG8_SA(b, h) + aoff + m * 2048 + k * 1024); } while (0)
#define PG8_LDB(dst, b, h) do { _Pragma("unroll") for (int n = 0; n < 2; ++n) _Pragma("unroll") for (int k = 0; k < 2; ++k) dst[n][k] = *(const PG8_LAS bf16x8*)(lds + PG8_SB(b, h) + boff + n * 2048 + k * 1024); } while (0)
#define PG8_MMA(ai, bj, At, Bt) do { __builtin_amdgcn_s_setprio(1); _Pragma("unroll") for (int m = 0; m < 4; ++m) _Pragma("unroll") for (int n = 0; n < 2; ++n) _Pragma("unroll") for (int k = 0; k < 2; ++k) \
        acc[ai][bj][m][n] = __builtin_amdgcn_mfma_f32_16x16x32_bf16(Bt[n][k], At[m][k], acc[ai][bj][m][n], 0, 0, 0); __builtin_amdgcn_s_setprio(0); } while (0)
#define PG8_WAIT_V(n) asm volatile("s_waitcnt vmcnt(" #n ")" ::: "memory")
#define PG8_WAIT_L(n) asm volatile("s_waitcnt lgkmcnt(" #n ")" ::: "memory")
#define PG8_BAR __builtin_amdgcn_s_barrier()
#define PG8_SCHED __builtin_amdgcn_sched_barrier(0)
    Unit cur, nxt; int ui = 0;
    if (!S.next(0, cur)) return;
    f32x4 acc[2][2][4][2];
#pragma unroll
    for (int a = 0; a < 2; ++a)
#pragma unroll
        for (int b = 0; b < 2; ++b)
#pragma unroll
            for (int m = 0; m < 4; ++m)
#pragma unroll
                for (int n = 0; n < 2; ++n) acc[a][b][m][n] = (f32x4){0.f, 0.f, 0.f, 0.f};
    bf16x8 At[4][2], B0[2][2], B1[2][2];
    const char* cA = (const char*)g.A + (size_t)cur.pm * tstep; const char* cB = (const char*)g.Bt + (size_t)cur.pn * tstep;
    S.a_ready(cur);
    if constexpr (SP2) {
        PG8_STAGE(PG8_SB(0, 0), cB, voffB); PG8_STAGE(PG8_SB(0, 1), cB + hstep, voffB); PG8_STAGE(PG8_SA(0, 0), cA, voffA); PG8_STAGE(PG8_SA(0, 1), cA + hstep, voffA);
        if (wr == 1) PG8_BAR;
        PG8_WAIT_V(2); PG8_BAR;
        PG8_STAGE(PG8_SB(1, 0), cB + kstep, voffB); PG8_STAGE(PG8_SA(1, 0), cA + kstep, voffA); PG8_STAGE(PG8_SB(1, 1), cB + hstep + kstep, voffB);
        PG8_WAIT_V(6); PG8_BAR;
    } else {
        PG8_STAGE(PG8_SB(0, 0), cB, voffB); PG8_STAGE(PG8_SA(0, 0), cA, voffA); PG8_STAGE(PG8_SB(0, 1), cB + hstep, voffB); PG8_STAGE(PG8_SA(0, 1), cA + hstep, voffA);
        if (wr == 1) PG8_BAR;
        PG8_WAIT_V(4); PG8_BAR;
        PG8_STAGE(PG8_SB(1, 0), cB + kstep, voffB); PG8_STAGE(PG8_SA(1, 0), cA + kstep, voffA); PG8_STAGE(PG8_SB(1, 1), cB + hstep + kstep, voffB);
        PG8_WAIT_V(6); PG8_BAR;
    }
    for (;;) {
        const bool has_next = S.next(ui + 1, nxt);
        const char* nA = has_next ? (const char*)g.A + (size_t)nxt.pm * tstep : cA; const char* nB = has_next ? (const char*)g.Bt + (size_t)nxt.pn * tstep : cB;
        for (int t = 0; t < nt; t += 2) {
            const bool last = (t == nt - 2);
            const char* a1 = cA + (size_t)(t + 1) * kstep;
            const char* a2 = last ? nA : cA + (size_t)(t + 2) * kstep; const char* b2 = last ? nB : cB + (size_t)(t + 2) * kstep;
            const char* a3 = a2 + kstep; const char* b3 = b2 + kstep;
            if (last && has_next) S.a_ready(nxt);
            if constexpr (SP2) {
            PG8_LDB(B0, 0, 0); PG8_LDB(B1, 0, 1); PG8_SCHED; PG8_LDA(At, 0, 0); PG8_STAGE(PG8_SA(1, 1), a1 + hstep, voffA);
            PG8_WAIT_V(8); PG8_WAIT_L(0); PG8_BAR; PG8_MMA(0, 0, At, B0); PG8_MMA(0, 1, At, B1); PG8_BAR; PG8_SCHED;
            PG8_LDA(At, 0, 1); PG8_STAGE(PG8_SB(0, 0), b2, voffB); PG8_STAGE(PG8_SB(0, 1), b2 + hstep, voffB); PG8_STAGE(PG8_SA(0, 0), a2, voffA);
            PG8_WAIT_V(8); PG8_WAIT_L(0); PG8_BAR; PG8_MMA(1, 0, At, B0); PG8_MMA(1, 1, At, B1); PG8_BAR; PG8_SCHED;
            PG8_LDB(B0, 1, 0); PG8_LDB(B1, 1, 1); PG8_SCHED; PG8_LDA(At, 1, 0); PG8_STAGE(PG8_SA(0, 1), a2 + hstep, voffA);
            PG8_WAIT_V(8); PG8_WAIT_L(0); PG8_BAR; PG8_MMA(0, 0, At, B0); PG8_MMA(0, 1, At, B1); PG8_BAR; PG8_SCHED;
            PG8_LDA(At, 1, 1); PG8_STAGE(PG8_SB(1, 0), b3, voffB); PG8_STAGE(PG8_SB(1, 1), b3 + hstep, voffB); PG8_STAGE(PG8_SA(1, 0), a3, voffA);
            PG8_WAIT_V(8); PG8_WAIT_L(0); PG8_BAR; PG8_MMA(1, 0, At, B0); PG8_MMA(1, 1, At, B1); PG8_BAR; PG8_SCHED;
            } else {
            PG8_LDB(B0, 0, 0); PG8_SCHED; PG8_LDA(At, 0, 0); PG8_STAGE(PG8_SA(1, 1), a1 + hstep, voffA);
            PG8_WAIT_L(8); PG8_BAR; PG8_WAIT_L(0); PG8_MMA(0, 0, At, B0); PG8_BAR; PG8_SCHED;
            PG8_LDB(B1, 0, 1); PG8_STAGE(PG8_SB(0, 0), b2, voffB);
            PG8_BAR; PG8_WAIT_L(0); PG8_MMA(0, 1, At, B1); PG8_BAR;
            PG8_LDA(At, 0, 1); PG8_STAGE(PG8_SA(0, 0), a2, voffA);
            PG8_BAR; PG8_WAIT_L(0); PG8_MMA(1, 0, At, B0); PG8_BAR; PG8_SCHED;
            PG8_STAGE(PG8_SB(0, 1), b2 + hstep, voffB);
            PG8_WAIT_V(6); PG8_BAR; PG8_MMA(1, 1, At, B1); PG8_BAR;
            PG8_LDB(B0, 1, 0); PG8_SCHED; PG8_LDA(At, 1, 0); PG8_STAGE(PG8_SA(0, 1), a2 + hstep, voffA);
            PG8_WAIT_L(8); PG8_BAR; PG8_WAIT_L(0); PG8_MMA(0, 0, At, B0); PG8_BAR; PG8_SCHED;
            PG8_LDB(B1, 1, 1); PG8_STAGE(PG8_SB(1, 0), b3, voffB);
            PG8_BAR; PG8_WAIT_L(0); PG8_MMA(0, 1, At, B1); PG8_BAR;
            PG8_LDA(At, 1, 1); PG8_STAGE(PG8_SA(1, 0), a3, voffA);
            PG8_BAR; PG8_WAIT_L(0); PG8_MMA(1, 0, At, B0); PG8_BAR; PG8_SCHED;
            PG8_STAGE(PG8_SB(1, 1), b3 + hstep, voffB);
            PG8_WAIT_V(6); PG8_BAR; PG8_MMA(1, 1, At, B1); PG8_BAR;
            }
        }
        if constexpr (ALIGN_EPI) { if (wr == 0) PG8_BAR; }
        if constexpr (!Epi::AFTER_DRAIN) { E(acc, cur, wr, wc, fr, fq); S.done(cur); }
        if (!has_next) break;
#pragma unroll
        for (int a = 0; a < 2; ++a)
#pragma unroll
            for (int b = 0; b < 2; ++b)
#pragma unroll
                for (int m = 0; m < 4; ++m)
#pragma unroll
                    for (int n = 0; n < 2; ++n) acc[a][b][m][n] = (f32x4){0.f, 0.f, 0.f, 0.f};
        cur = nxt; cA = nA; cB = nB; ++ui;
        if constexpr (ALIGN_EPI) { if (wr == 1) PG8_BAR; }
    }
    PG8_WAIT_V(0);
    if constexpr (!ALIGN_EPI) { if (wr == 0) PG8_BAR; }
    PG8_BAR;
    if constexpr (Epi::AFTER_DRAIN) { E.fused(acc, cur, wr, wc, fr, fq, lds, wid, lane); S.done(cur); }
#undef PG8_SA
#undef PG8_SB
#undef PG8_STAGE
#undef PG8_LDA
#undef PG8_LDB
#undef PG8_MMA
#undef PG8_WAIT_V
#undef PG8_WAIT_L
#undef PG8_BAR
#undef PG8_SCHED
}
}
using pg8::bf16x8; using pg8::f32x4; using pg8::u32x4;
struct P {
    const float* in[26]; float* out; unsigned char* ws; int ph_lo, ph_hi, coop, pad;
};
#define INP(i) (p.in[(i) + opq0()])
#define WSB (p.ws + opq0())
#define OUTB (p.out + opq0())
#define MFMA32(a, b, c) __builtin_amdgcn_mfma_f32_32x32x16_bf16(a, b, c, 0, 0, 0)
#define MFMA16(a, b, c) __builtin_amdgcn_mfma_f32_16x16x32_bf16(a, b, c, 0, 0, 0)
typedef short v4i16_t __attribute__((ext_vector_type(4)));
__device__ __forceinline__ s16x4 trr(LAS const unsigned char* p) { return __builtin_bit_cast(s16x4, __builtin_amdgcn_ds_read_tr16_b64_v4i16((LAS v4i16_t*)p)); }

__device__ __forceinline__ void prep_tile(const float* src, int srcN, int K, const float* gain, us* dst, int kt, int n0dst, int n0src, LAS float* tile) {
    const int tid = otid();
#pragma unroll
    for (int i = 0; i < 8; ++i) { const int k = i * 8 + (tid >> 6), n = tid & 63; float v = src[(size_t)(kt * 64 + k) * srcN + n0src + n]; if (gain) v *= gain[kt * 64 + k]; tile[k * 65 + n] = v; }
    __syncthreads();
    const int n = tid >> 3, k8 = (tid & 7) * 8;
    u32x4 o; o.x = pk2(tile[(k8 + 0) * 65 + n], tile[(k8 + 1) * 65 + n]); o.y = pk2(tile[(k8 + 2) * 65 + n], tile[(k8 + 3) * 65 + n]);
    o.z = pk2(tile[(k8 + 4) * 65 + n], tile[(k8 + 5) * 65 + n]); o.w = pk2(tile[(k8 + 6) * 65 + n], tile[(k8 + 7) * 65 + n]);
    *(u32x4*)(dst + (size_t)(n0dst + n) * K + kt * 64 + k8) = o;
    __syncthreads();
}
__device__ __forceinline__ void prep_phase(const P& p, LAS unsigned char* lds) {
    LAS float* tile = (LAS float*)lds;
    constexpr int I_IN = 16 * 36, I_OUT = 16 * 16, I_UP = 16 * 88, I_DN = 44 * 16, I_MEM = 16 * 8, I_L = I_IN + I_OUT + I_UP + I_DN + I_MEM;
    for (int it = blockIdx.x; it < 2 * I_L; it += gridDim.x) {
        const int l = it / I_L; int r = it % I_L;
        if (r < I_IN) { const int kt = r / 36, nt = r % 36, nd = nt * 64; prep_tile(INP(10) + (size_t)l * DM * INC, INC, DM, INP(9) + l * DM, (us*)(WSB + WS_WIN) + (size_t)l * NIN * DM, kt, nd, nd < 1536 ? nd : nd + 8, tile); continue; } r -= I_IN;
        if (r < I_OUT) { const int kt = r / 16, nt = r % 16; prep_tile(INP(18) + (size_t)l * DM * DM, DM, DM, nullptr, (us*)(WSB + WS_WOUT) + (size_t)l * DM * DM, kt, nt * 64, nt * 64, tile); continue; } r -= I_OUT;
        if (r < I_UP) { const int kt = r / 88, nt = r % 88, nd = nt * 64, j = nd >> 8, w = nd & 255; prep_tile(INP(21) + (size_t)l * DM * NUP, NUP, DM, INP(20) + l * DM, (us*)(WSB + WS_WUP) + (size_t)l * NUP * DM, kt, nd, (w >> 7) * FF + 128 * j + (w & 127), tile); continue; } r -= I_UP;
        if (r < I_DN) { const int kt = r / 16, nt = r % 16; prep_tile(INP(24) + (size_t)l * FF * DM, DM, FF, nullptr, (us*)(WSB + WS_WDOWN) + (size_t)l * DM * FF, kt, nt * 64, nt * 64, tile); continue; } r -= I_DN;
        { const int kt = r / 8, nt = r % 8; prep_tile(INP(16) + (size_t)l * DM * 512, 512, DM, INP(15) + l * DM, (us*)(WSB + WS_WMEM) + (size_t)l * 512 * DM, kt, nt * 64, nt * 64, tile); }
    }
}

template <bool HAS_Y, bool DO_FG, bool WRITE_B>
__device__ __forceinline__ void row_pass(const float* xP, const float* xS, int nrows, float* xdst, const float* Y, const float* YSQ, const float* gpost,
                                         us* XB, float* RS, const float* win_l, const float* gpre, const float* bfg, float* lfP, float* lfS) {
    const int tid_ = otid(), lane = tid_ & 63, wid = tid_ >> 6;
    for (int row = blockIdx.x * 8 + wid; row < nrows; row += gridDim.x * 8) {
        const float* xr = (row < NTP) ? xP + (size_t)row * DM : xS + (size_t)(row - NTP) * DM;
        f32x4 v[4];
#pragma unroll
        for (int j = 0; j < 4; ++j) v[j] = *(const f32x4*)(xr + 4 * lane + 256 * j);
        if (HAS_Y) {
            const f32x4* q = (const f32x4*)(YSQ + (size_t)row * 16); const f32x4 a = q[0], b = q[1], c = q[2], d = q[3];
            const float ss = ((a[0] + a[1]) + (a[2] + a[3])) + ((b[0] + b[1]) + (b[2] + b[3])) + ((c[0] + c[1]) + (c[2] + c[3])) + ((d[0] + d[1]) + (d[2] + d[3]));
            const float ry = rsqrtf(ss * (1.f / DM) + EPS);
#pragma unroll
            for (int j = 0; j < 4; ++j) { const f32x4 y = *(const f32x4*)(Y + (size_t)row * DM + 4 * lane + 256 * j); const f32x4 g = *(const f32x4*)(gpost + 4 * lane + 256 * j); v[j] = v[j] + y * ry * g; }
        }
        if (xdst) {
#pragma unroll
            for (int j = 0; j < 4; ++j) *(f32x4*)(xdst + (size_t)row * DM + 4 * lane + 256 * j) = v[j];
        }
        if (WRITE_B) {
            float s = 0.f;
#pragma unroll
            for (int j = 0; j < 4; ++j) s += (v[j][0] * v[j][0] + v[j][1] * v[j][1]) + (v[j][2] * v[j][2] + v[j][3] * v[j][3]);
            const float rs = rsqrtf(wave_sum(s) * (1.f / DM) + EPS);
            if (lane == 0) RS[row] = rs;
#pragma unroll
            for (int j = 0; j < 4; ++j) { unsigned long long o = (unsigned long long)pk2(v[j][0], v[j][1]) | ((unsigned long long)pk2(v[j][2], v[j][3]) << 32); *(unsigned long long*)(XB + (size_t)row * DM + 4 * lane + 256 * j) = o; }
            if (DO_FG) {
                float f[8];
#pragma unroll
                for (int h = 0; h < 8; ++h) f[h] = 0.f;
#pragma unroll
                for (int j = 0; j < 4; ++j) { const f32x4 g = *(const f32x4*)(gpre + 4 * lane + 256 * j);
#pragma unroll
                    for (int e = 0; e < 4; ++e) { const int k = 4 * lane + 256 * j + e; const float xg = v[j][e] * g[e];
                        const f32x4 wa = *(const f32x4*)(win_l + (size_t)k * INC + 1536), wb = *(const f32x4*)(win_l + (size_t)k * INC + 1540);
                        f[0] += xg * wa[0]; f[1] += xg * wa[1]; f[2] += xg * wa[2]; f[3] += xg * wa[3]; f[4] += xg * wb[0]; f[5] += xg * wb[1]; f[6] += xg * wb[2]; f[7] += xg * wb[3]; } }
#pragma unroll
                for (int h = 0; h < 8; ++h) f[h] = wave_sum(f[h]);
                if (lane < 8) {
                    float z = 0.f;
#pragma unroll
                    for (int h = 0; h < 8; ++h) if (lane == h) z = f[h];
                    z = z * rs + bfg[lane];
                    const float lf = fminf(z, 0.f) - log1pf(__expf(-fabsf(z)));
                    if (row < NTP) lfP[(size_t)row * 8 + lane] = lf; else lfS[(size_t)(row - NTP) * 8 + lane] = lf;
                }
            }
        }
    }
}

constexpr int KPB = 144, VPB = 192, FL_V0 = 64 * KPB, FL_BUF = 64 * KPB + 64 * VPB, FL_BIAS = 2 * FL_BUF, FL_MISC = FL_BIAS + 2048 * 4;
__device__ __forceinline__ void flash_unit(LAS unsigned char* lds, const us* Q, int qp, const us* K, int kp, const us* V, int vp, us* O, int op, int ntiles, int band, bool use_bias) {
    const int tid = otid(), lane = tid & 63, wid = tid >> 6, r32 = lane & 31, hi = lane >> 5;
    bf16x8 qf[4];
#pragma unroll
    for (int d0 = 0; d0 < 4; ++d0) qf[d0] = *(const bf16x8*)(Q + (size_t)(wid * 32 + r32) * qp + d0 * 16 + hi * 8);
    const int srow = tid >> 3, sch = tid & 7;
    const us* kg = K + (size_t)srow * kp + sch * 8; const us* vg = V + (size_t)srow * vp + sch * 8;
    u32x4 kreg = *(const u32x4*)kg, vreg = *(const u32x4*)vg;
    *(LAS u32x4*)(lds + srow * KPB + sch * 16) = kreg; *(LAS u32x4*)(lds + FL_V0 + srow * VPB + sch * 16) = vreg;
    __syncthreads();
    f32x16 o0 = {}, o1 = {}; float mrun = -1e30f, lrun = 0.f;
    const int qrel = wid * 32 + r32;
    LAS const float* bias = (LAS const float*)(lds + FL_BIAS);
    for (int t = 0; t < ntiles; ++t) {
        const int cur = (t & 1) * FL_BUF, nxt = FL_BUF - cur;
        if (t + 1 < ntiles) { kreg = *(const u32x4*)(kg + (size_t)(t + 1) * 64 * kp); vreg = *(const u32x4*)(vg + (size_t)(t + 1) * 64 * vp); }
        const int jb = band ? t - (ntiles - band) : -1;
        const bool skip = (jb >= 0) && (64 * jb > wid * 32 + 31);
        if (!skip) {
            f32x16 p0 = {}, p1 = {};
            LAS const unsigned char* kb = lds + cur + r32 * KPB + hi * 16;
#pragma unroll
            for (int d0 = 0; d0 < 4; ++d0) {
                const bf16x8 a0 = *(LAS const bf16x8*)(kb + d0 * 32), a1 = *(LAS const bf16x8*)(kb + 32 * KPB + d0 * 32);
                p0 = MFMA32(a0, qf[d0], p0); p1 = MFMA32(a1, qf[d0], p1);
            }
            if (use_bias) {
                LAS const float* bp = bias + 64 * t + 4 * hi;
#pragma unroll
                for (int g = 0; g < 4; ++g) { const f32x4 b0 = *(LAS const f32x4*)(bp + 8 * g), b1 = *(LAS const f32x4*)(bp + 32 + 8 * g);
#pragma unroll
                    for (int i = 0; i < 4; ++i) { p0[4 * g + i] -= b0[i]; p1[4 * g + i] -= b1[i]; } }
            }
            if (jb >= 0) {
                const int qb4 = qrel - 64 * jb - 4 * hi; const int NEGB = __builtin_bit_cast(int, -1e30f);
#pragma unroll
                for (int r = 0; r < 16; ++r) { const int t0 = qb4 - ((r & 3) + 8 * (r >> 2)), m0 = t0 >> 31, m1 = (t0 - 32) >> 31;
                    const float x0 = p0[r], x1 = p1[r]; p0[r] = __int_as_float((__float_as_int(x0) & ~m0) | (NEGB & m0)); p1[r] = __int_as_float((__float_as_int(x1) & ~m1) | (NEGB & m1)); }
            }
            float mx = fmaxf(p0[0], p1[0]);
#pragma unroll
            for (int r = 1; r < 16; ++r) mx = fmaxf(mx, fmaxf(p0[r], p1[r]));
            mx = fmaxf(mx, __shfl_xor(mx, 32));
            const float mn = fmaxf(mrun, mx), alpha = __builtin_amdgcn_exp2f(mrun - mn); mrun = mn;
            lrun *= alpha; o0 = o0 * alpha; o1 = o1 * alpha;
            float ls = 0.f;
#pragma unroll
            for (int r = 0; r < 16; ++r) { p0[r] = __builtin_amdgcn_exp2f(p0[r] - mn); p1[r] = __builtin_amdgcn_exp2f(p1[r] - mn); ls += p0[r] + p1[r]; }
            lrun += ls;
            u32x4 pw[4];
#pragma unroll
            for (int s = 0; s < 2; ++s) {
                pw[s] = (u32x4){pg8::cvt_pk_bf16(p0[8 * s], p0[8 * s + 1]), pg8::cvt_pk_bf16(p0[8 * s + 2], p0[8 * s + 3]), pg8::cvt_pk_bf16(p0[8 * s + 4], p0[8 * s + 5]), pg8::cvt_pk_bf16(p0[8 * s + 6], p0[8 * s + 7])};
                pw[2 + s] = (u32x4){pg8::cvt_pk_bf16(p1[8 * s], p1[8 * s + 1]), pg8::cvt_pk_bf16(p1[8 * s + 2], p1[8 * s + 3]), pg8::cvt_pk_bf16(p1[8 * s + 4], p1[8 * s + 5]), pg8::cvt_pk_bf16(p1[8 * s + 6], p1[8 * s + 7])};
            }
            LAS const unsigned char* vb = lds + cur + FL_V0 + (4 * hi + ((lane & 15) >> 2)) * VPB + (((lane >> 4) & 1) * 16 + (lane & 3) * 4) * 2;
#pragma unroll
            for (int ks = 0; ks < 4; ++ks) {
                const s16x4 l0 = trr(vb + (16 * ks) * VPB), h0 = trr(vb + (16 * ks + 8) * VPB), l1 = trr(vb + (16 * ks) * VPB + 64), h1 = trr(vb + (16 * ks + 8) * VPB + 64);
                const bf16x8 a0 = (bf16x8){l0[0], l0[1], l0[2], l0[3], h0[0], h0[1], h0[2], h0[3]}, a1 = (bf16x8){l1[0], l1[1], l1[2], l1[3], h1[0], h1[1], h1[2], h1[3]};
                const bf16x8 pf = __builtin_bit_cast(bf16x8, pw[ks]);
                o0 = MFMA32(a0, pf, o0); o1 = MFMA32(a1, pf, o1);
            }
        }
        if (t + 1 < ntiles) { *(LAS u32x4*)(lds + nxt + srow * KPB + sch * 16) = kreg; *(LAS u32x4*)(lds + nxt + FL_V0 + srow * VPB + sch * 16) = vreg; }
        __syncthreads();
    }
    lrun += __shfl_xor(lrun, 32);
    const float inv = 1.f / lrun;
    us* orow = O + (size_t)(wid * 32 + r32) * op;
#pragma unroll
    for (int g = 0; g < 4; ++g) {
        const int d0 = 8 * g + 4 * hi;
        unsigned long long w0 = (unsigned long long)pk2(o0[4 * g] * inv, o0[4 * g + 1] * inv) | ((unsigned long long)pk2(o0[4 * g + 2] * inv, o0[4 * g + 3] * inv) << 32);
        unsigned long long w1 = (unsigned long long)pk2(o1[4 * g] * inv, o1[4 * g + 1] * inv) | ((unsigned long long)pk2(o1[4 * g + 2] * inv, o1[4 * g + 3] * inv) << 32);
        *(unsigned long long*)(orow + d0) = w0; *(unsigned long long*)(orow + 32 + d0) = w1;
    }
}
template <class F> __device__ __forceinline__ void block_cumsum(LAS float* dst, LAS float* wtot, int n, F f) {
    const int tid = otid(), lane = tid & 63, wid = tid >> 6;
    float a[4];
#pragma unroll
    for (int i = 0; i < 4; ++i) { const int j = 4 * tid + i; a[i] = (j < n) ? f(j) : 0.f; }
    const float s = (a[0] + a[1]) + (a[2] + a[3]);
    float sc = s;
#pragma unroll
    for (int o = 1; o < 64; o <<= 1) { const float t = __shfl_up(sc, o); if (lane >= o) sc += t; }
    if (lane == 63) wtot[wid] = sc;
    __syncthreads();
    float off = 0.f;
    for (int w = 0; w < wid; ++w) off += wtot[w];
    float c = off + sc - s;
#pragma unroll
    for (int i = 0; i < 4; ++i) { c += a[i]; const int j = 4 * tid + i; if (j < 2048) dst[j] = c * LOG2E; }
    __syncthreads();
}
constexpr int ZPB = 576, WPB = 272, SG_W = 128 * ZPB, SG_RS = SG_W + 128 * WPB;
__device__ __forceinline__ void sgu_unit(LAS unsigned char* lds, int R0, const us* ZB, const us* UB, us* CAT, const float* ws_l, const float* bs_l, const float* gs_l) {
    const int tid = otid(), lane = tid & 63, wid = tid >> 6, r32 = lane & 31, hi = lane >> 5;
#pragma unroll
    for (int i = 0; i < 8; ++i) { const int idx = tid + 512 * i, row = idx >> 5, ch = idx & 31; *(LAS u32x4*)(lds + row * ZPB + ch * 16) = *(const u32x4*)(ZB + (size_t)(R0 + row) * 256 + ch * 8); }
    __syncthreads();
    { const int row = tid >> 2, q = tid & 3; float ss = 0.f;
#pragma unroll
      for (int i = 0; i < 8; ++i) { const u32x4 w = *(LAS const u32x4*)(lds + row * ZPB + q * 128 + i * 16);
#pragma unroll
          for (int e = 0; e < 4; ++e) { const float a = bf2f(w[e] & 0xffffu), b = bf2f(w[e] >> 16); ss += a * a + b * b; } }
      ss += __shfl_xor(ss, 1); ss += __shfl_xor(ss, 2);
      if (q == 0) ((LAS float*)(lds + SG_RS))[row] = rsqrtf(ss * (1.f / 256.f) + EPS); }
    __syncthreads();
    LAS const float* rsz = (LAS const float*)(lds + SG_RS);
#pragma unroll 1
    for (int g = 0; g < 4; ++g) {
#pragma unroll
        for (int i = 0; i < 4; ++i) { const int idx = tid + 512 * i, row = idx >> 4, ch = idx & 15;
            const float* wp = ws_l + (size_t)g * 16384 + row * 128 + ch * 8; f32x4 a = *(const f32x4*)wp, b = *(const f32x4*)(wp + 4);
            const bool z = (ch >= 8) && (row < 64);
            u32x4 o;
            if (z) o = (u32x4){0u, 0u, 0u, 0u};
            else { const int j0 = ch * 8; o.x = pk2(a[0] * rsz[j0], a[1] * rsz[j0 + 1]); o.y = pk2(a[2] * rsz[j0 + 2], a[3] * rsz[j0 + 3]); o.z = pk2(b[0] * rsz[j0 + 4], b[1] * rsz[j0 + 5]); o.w = pk2(b[2] * rsz[j0 + 6], b[3] * rsz[j0 + 7]); }
            *(LAS u32x4*)(lds + SG_W + row * WPB + ch * 16) = o; }
        __syncthreads();
        const int ib = wid & 3, chh = wid >> 2, cbase = g * 64 + 32 * chh;
        f32x16 acc = {};
        LAS const unsigned char* ap = lds + SG_W + (32 * ib + r32) * WPB + hi * 16;
        LAS const unsigned char* bp = lds + (8 * hi + ((lane & 15) >> 2)) * ZPB + (cbase + 16 * ((lane >> 4) & 1) + 4 * (lane & 3)) * 2;
#pragma unroll
        for (int ks = 0; ks < 8; ++ks) {
            const bf16x8 a = *(LAS const bf16x8*)(ap + ks * 32);
            const s16x4 l0 = trr(bp + (16 * ks) * ZPB), h0 = trr(bp + (16 * ks + 4) * ZPB);
            const bf16x8 b = (bf16x8){l0[0], l0[1], l0[2], l0[3], h0[0], h0[1], h0[2], h0[3]};
            acc = MFMA32(a, b, acc);
        }
        const int c = cbase + r32; const float gs = gs_l[c];
#pragma unroll
        for (int r = 0; r < 16; ++r) { const int i = 32 * ib + (r & 3) + 8 * (r >> 2) + 4 * hi;
            const float mixed = gs * acc[r] + bs_l[g * 128 + i]; const float u = bf2f(UB[(size_t)(R0 + i) * 256 + c]);
            CAT[(size_t)(R0 + i) * DM + 512 + c] = (us)f2bf(u * mixed); }
        __syncthreads();
    }
}
__device__ __forceinline__ void sgu_sample_unit(LAS unsigned char* lds, int b, const us* ZB, const us* UB, us* CAT, const float* ws_l, const float* bs_l, const float* gs_l, float* outv) {
    const int tid = otid(), R0 = NTP + 16 * b;
    LAS float* z = (LAS float*)lds; LAS float* rsz = z + 16 * 256;
    for (int i = tid; i < 4096; i += 512) z[i] = bf2f(ZB[(size_t)R0 * 256 + i]);
    __syncthreads();
    { const int row = tid >> 5, q = tid & 31; float ss = 0.f;
      for (int i = 0; i < 8; ++i) { const float a = z[row * 256 + q + 32 * i]; ss += a * a; }
      ss += __shfl_xor(ss, 1); ss += __shfl_xor(ss, 2); ss += __shfl_xor(ss, 4); ss += __shfl_xor(ss, 8); ss += __shfl_xor(ss, 16);
      if (q == 0) rsz[row] = rsqrtf(ss * (1.f / 256.f) + EPS); }
    __syncthreads();
    for (int o = tid; o < 4096; o += 512) {
        const int i = o >> 8, c = o & 255, g = c >> 6; const float gs = gs_l[c];
        float acc = 0.f;
#pragma unroll
        for (int j = 0; j < 16; ++j) acc += ws_l[(size_t)g * 16384 + i * 128 + j] * rsz[j] * z[j * 256 + c];
        const float mixed = gs * acc + bs_l[g * 128 + i]; const float u = bf2f(UB[(size_t)(R0 + i) * 256 + c]);
        CAT[(size_t)(R0 + i) * DM + 512 + c] = (us)f2bf(u * mixed);
        outv[(size_t)(16 * b + i) * 256 + c] = z[i * 256 + c] * rsz[i] * gs;
    }
    __syncthreads();
}
constexpr int SA_SC = 4096, SA_SCP = 1088, SA_BIAS = SA_SC + 16 * SA_SCP * 4, SA_MISC = SA_BIAS + 2048 * 4;
__device__ __forceinline__ void small_attn(LAS unsigned char* lds, const us* Q, int qp, const float* Kc, const float* Vc, int cp, int ncache, const float* Kn, const float* Vn, int np, int nnew,
                                           const float* lfc, const float* lfn, bool fox, us* O, int op) {
    const int tid = otid(), lane = tid & 63, wid = tid >> 6;
    const int nk = ncache + nnew, nkb = (nk + 15) >> 4;
    LAS float* SC = (LAS float*)(lds + SA_SC); LAS float* bias = (LAS float*)(lds + SA_BIAS); LAS float* misc = (LAS float*)(lds + SA_MISC);
    if (tid < 128) { const int row = tid >> 3, ch = tid & 7; *(LAS u32x4*)(lds + row * 144 + ch * 16) = *(const u32x4*)(Q + (size_t)row * qp + ch * 8); }
    if (fox) block_cumsum(bias, misc, nk, [&](int j) { return j < ncache ? lfc[(size_t)j * 8] : lfn[(size_t)(j - ncache) * 8]; });
    else __syncthreads();
    { const int kl = lane & 15, kq = lane >> 4;
      for (int kb = wid; kb < nkb; kb += 8) {
        const int key = kb * 16 + kl; const bool valid = key < nk; const int kk = valid ? key : 0;
        const float* src = (kk < ncache) ? Kc + (size_t)kk * cp : Kn + (size_t)(kk - ncache) * np;
        f32x4 acc = {0.f, 0.f, 0.f, 0.f};
#pragma unroll
        for (int s = 0; s < 2; ++s) {
            const f32x4 x0 = *(const f32x4*)(src + 32 * s + 8 * kq), x1 = *(const f32x4*)(src + 32 * s + 8 * kq + 4);
            const u32x4 bw = (u32x4){pk2(x0[0], x0[1]), pk2(x0[2], x0[3]), pk2(x1[0], x1[1]), pk2(x1[2], x1[3])};
            const bf16x8 a = *(LAS const bf16x8*)(lds + kl * 144 + (32 * s + 8 * kq) * 2);
            acc = MFMA16(a, __builtin_bit_cast(bf16x8, bw), acc);
        }
        const float bj = fox ? bias[key] : 0.f;
#pragma unroll
        for (int r = 0; r < 4; ++r) { const int qrow = 4 * kq + r; float sv = acc[r] - bj; if (!valid || (fox && key > ncache + qrow)) sv = -1e30f; SC[qrow * SA_SCP + key] = sv; }
      } }
    __syncthreads();
#pragma unroll
    for (int rr = 0; rr < 2; ++rr) { const int row = 2 * wid + rr; float mx = -1e30f;
        for (int j = lane; j < nkb * 16; j += 64) mx = fmaxf(mx, SC[row * SA_SCP + j]);
#pragma unroll
        for (int o = 1; o < 64; o <<= 1) mx = fmaxf(mx, __shfl_xor(mx, o));
        float sum = 0.f;
        for (int j = lane; j < nkb * 16; j += 64) { const float e = __builtin_amdgcn_exp2f(SC[row * SA_SCP + j] - mx); SC[row * SA_SCP + j] = e; sum += e; }
        sum = wave_sum(sum);
        if (lane == 0) misc[16 + row] = 1.f / sum; }
    __syncthreads();
    { const int d = lane; float a0 = 0.f, a1 = 0.f; LAS const float* s0 = SC + (2 * wid) * SA_SCP; LAS const float* s1 = s0 + SA_SCP;
#pragma unroll 8
      for (int j = 0; j < ncache; ++j) { const float v = Vc[(size_t)j * cp + d]; a0 += s0[j] * v; a1 += s1[j] * v; }
      for (int j = 0; j < nnew; ++j) { const float v = Vn[(size_t)j * np + d]; a0 += s0[ncache + j] * v; a1 += s1[ncache + j] * v; }
      O[(size_t)(2 * wid) * op + d] = (us)f2bf(a0 * misc[16 + 2 * wid]); O[(size_t)(2 * wid + 1) * op + d] = (us)f2bf(a1 * misc[17 + 2 * wid]); }
    __syncthreads();
}
#ifdef DBG_FOX
__device__ __forceinline__ void dbg_fox(const P& p, int l) {
    const us* QBp = (const us*)(WSB + WS_QB); const us* KBp = (const us*)(WSB + WS_KB); const us* VBp = (const us*)(WSB + WS_VB); us* CATp = (us*)(WSB + WS_CAT);
    const float* lf = OUTB + O_PLF + (size_t)l * NTP * 8;
    for (int id = blockIdx.x * 512 + otid(); id < 131072; id += gridDim.x * 512) {
        const int q = id & 2047, bh = id >> 11, b = bh >> 3, h = bh & 7;
        if ((FQM >> (q >> 8)) & 1) continue;
        float qv[64], o[64];
#pragma unroll
        for (int c8 = 0; c8 < 8; ++c8) { const u32x4 w = *(const u32x4*)(QBp + ((size_t)b * SEQ + q) * 512 + h * 64 + c8 * 8);
#pragma unroll
            for (int e = 0; e < 4; ++e) { qv[c8 * 8 + 2 * e] = bf2f(w[e] & 0xffffu); qv[c8 * 8 + 2 * e + 1] = bf2f(w[e] >> 16); } }
#pragma unroll
        for (int d = 0; d < 64; ++d) o[d] = 0.f;
        float m = -1e30f, ls = 0.f, c = 0.f;
        for (int j = 0; j <= q; ++j) {
            c += lf[((size_t)b * SEQ + j) * 8 + h] * LOG2E;
            const us* kr = KBp + ((size_t)b * SEQ + j) * 512 + h * 64; const us* vr = VBp + ((size_t)b * SEQ + j) * 512 + h * 64;
            float s = 0.f;
#pragma unroll
            for (int c8 = 0; c8 < 8; ++c8) { const u32x4 w = *(const u32x4*)(kr + c8 * 8);
#pragma unroll
                for (int e = 0; e < 4; ++e) { s += qv[c8 * 8 + 2 * e] * bf2f(w[e] & 0xffffu) + qv[c8 * 8 + 2 * e + 1] * bf2f(w[e] >> 16); } }
            s -= c;
            const float mn = fmaxf(m, s), al = __builtin_amdgcn_exp2f(m - mn), pj = __builtin_amdgcn_exp2f(s - mn); m = mn; ls = ls * al + pj;
#pragma unroll
            for (int c8 = 0; c8 < 8; ++c8) { const u32x4 w = *(const u32x4*)(vr + c8 * 8);
#pragma unroll
                for (int e = 0; e < 4; ++e) { o[c8 * 8 + 2 * e] = o[c8 * 8 + 2 * e] * al + pj * bf2f(w[e] & 0xffffu); o[c8 * 8 + 2 * e + 1] = o[c8 * 8 + 2 * e + 1] * al + pj * bf2f(w[e] >> 16); } }
        }
        const float inv = 1.f / ls;
#pragma unroll
        for (int c8 = 0; c8 < 8; ++c8) { u32x4 w;
#pragma unroll
            for (int e = 0; e < 4; ++e) w[e] = pk2(o[c8 * 8 + 2 * e] * inv, o[c8 * 8 + 2 * e + 1] * inv);
            *(u32x4*)(CATp + ((size_t)b * SEQ + q) * DM + h * 64 + c8 * 8) = w; }
    }
}
#endif
__device__ __forceinline__ void attn_phase(const P& p, LAS unsigned char* lds, int l) {
    const int G = gridDim.x, bx = blockIdx.x, vcu = (G % 8 == 0) ? (bx % 8) * (G / 8) + bx / 8 : bx;
#define A_QB ((const us*)(WSB + WS_QB))
#define A_KB ((const us*)(WSB + WS_KB))
#define A_VB ((const us*)(WSB + WS_VB))
#define A_UB ((const us*)(WSB + WS_UB))
#define A_ZB ((const us*)(WSB + WS_ZB))
#define A_QMB ((const us*)(WSB + WS_QMB))
#define A_MKV ((const us*)(WSB + WS_MKV) + (size_t)l * NMEMROWS * 512)
#define A_CAT ((us*)(WSB + WS_CAT))
#define A_WS (INP(12) + (size_t)l * 4 * 16384)
#define A_BS (INP(13) + (size_t)l * 512)
#define A_GS (INP(14) + (size_t)l * 256)
#ifdef DBG_FOX
    dbg_fox(p, l);
#endif
    for (int v = vcu; v < 256; v += G) {
        const int bh = v >> 2, s = v & 3, b = bh >> 3, h = bh & 7;
#pragma unroll 1
        for (int k = 0; k < 2; ++k) { const int qb = k ? 7 - s : s;
#ifdef DBG_FOX
            if (!((FQM >> qb) & 1)) continue;
#endif
            const float* lfP = OUTB + O_PLF + (size_t)l * NTP * 8 + (size_t)b * SEQ * 8 + h;
            block_cumsum((LAS float*)(lds + FL_BIAS), (LAS float*)(lds + FL_MISC), 256 * (qb + 1), [&](int j) { return lfP[(size_t)j * 8]; });
            flash_unit(lds, A_QB + ((size_t)b * SEQ + qb * 256) * 512 + h * 64, 512, A_KB + (size_t)b * SEQ * 512 + h * 64, 512, A_VB + (size_t)b * SEQ * 512 + h * 64, 512,
                       A_CAT + ((size_t)b * SEQ + qb * 256) * DM + h * 64, DM, 4 * (qb + 1), 4, true); }
    }
    for (int v = vcu; v < 256; v += G) { const int bh = v >> 3, qb = v & 7, b = bh >> 2, h = bh & 3; const us* mkv = A_MKV + (size_t)b * 256 * 512 + h * 64;
        flash_unit(lds, A_QMB + ((size_t)b * SEQ + qb * 256) * 256 + h * 64, 256, mkv, 512, mkv + 256, 512,
                   A_CAT + ((size_t)b * SEQ + qb * 256) * DM + 768 + h * 64, DM, 4, 0, false); }
    for (int v = G - 1 - vcu; v < 128; v += G) sgu_unit(lds, v * 128, A_ZB, A_UB, A_CAT, A_WS, A_BS, A_GS);
    for (int v = vcu; v < 128; v += G) { const int b = v >> 3, h = v & 7; const size_t co = ((size_t)(l * NBS + b) * PAST) * 512 + h * 64, no = ((size_t)l * NTS + 16 * b) * 512 + h * 64;
        small_attn(lds, A_QB + (size_t)(NTP + 16 * b) * 512 + h * 64, 512, INP(3) + co, INP(4) + co, 512, PAST, OUTB + O_SK + no, OUTB + O_SV + no, 512, 16,
                   INP(5) + ((size_t)(l * NBS + b) * PAST) * 8 + h, OUTB + O_SLF + (size_t)l * NTS * 8 + (size_t)(16 * b) * 8 + h, true, A_CAT + (size_t)(NTP + 16 * b) * DM + h * 64, DM); }
    for (int v = G - 1 - vcu; v < 64; v += G) { const int b = v >> 2, h = v & 3; const size_t co = ((size_t)(l * NBS + b) * 256) * 256 + h * 64;
        small_attn(lds, A_QMB + (size_t)(NTP + 16 * b) * 256 + h * 64, 256, INP(6) + co, INP(7) + co, 256, 256,
                   nullptr, nullptr, 0, 0, nullptr, nullptr, false, A_CAT + (size_t)(NTP + 16 * b) * DM + 768 + h * 64, DM); }
    for (int v = vcu - 128; v >= 0 && v < 16; v += G) sgu_sample_unit(lds, v, A_ZB, A_UB, A_CAT, A_WS, A_BS, A_GS, OUTB + O_SGV + (size_t)l * NTS * 256);
}
__device__ __forceinline__ void gnorm_phase(const P& p, int l) {
    const int tid_ = otid(), lane = tid_ & 63, wid = tid_ >> 6; us* CAT = (us*)(WSB + WS_CAT); const float* gg = INP(17) + (size_t)l * DM;
    for (int row = blockIdx.x * 8 + wid; row < NT; row += gridDim.x * 8) {
        u32x4* rp = (u32x4*)(CAT + (size_t)row * DM + 16 * lane); const u32x4 w0 = rp[0], w1 = rp[1];
        float v[16];
#pragma unroll
        for (int e = 0; e < 4; ++e) { v[2 * e] = bf2f(w0[e] & 0xffffu); v[2 * e + 1] = bf2f(w0[e] >> 16); v[8 + 2 * e] = bf2f(w1[e] & 0xffffu); v[8 + 2 * e + 1] = bf2f(w1[e] >> 16); }
        float ss = 0.f;
#pragma unroll
        for (int e = 0; e < 16; ++e) ss += v[e] * v[e];
        ss += __shfl_xor(ss, 1); ss += __shfl_xor(ss, 2); ss += __shfl_xor(ss, 4); ss += __shfl_xor(ss, 8);
        const float s16 = __shfl_xor(ss, 16); float wdt = 256.f; if (lane < 32) { ss += s16; wdt = 512.f; }
        const float r = rsqrtf(ss / wdt + EPS);
        const f32x4 g0 = *(const f32x4*)(gg + 16 * lane), g1 = *(const f32x4*)(gg + 16 * lane + 4), g2 = *(const f32x4*)(gg + 16 * lane + 8), g3 = *(const f32x4*)(gg + 16 * lane + 12);
        u32x4 o0, o1;
        o0.x = pk2(v[0] * r * g0[0], v[1] * r * g0[1]); o0.y = pk2(v[2] * r * g0[2], v[3] * r * g0[3]); o0.z = pk2(v[4] * r * g1[0], v[5] * r * g1[1]); o0.w = pk2(v[6] * r * g1[2], v[7] * r * g1[3]);
        o1.x = pk2(v[8] * r * g2[0], v[9] * r * g2[1]); o1.y = pk2(v[10] * r * g2[2], v[11] * r * g2[3]); o1.z = pk2(v[12] * r * g3[0], v[13] * r * g3[1]); o1.w = pk2(v[14] * r * g3[2], v[15] * r * g3[3]);
        rp[0] = o0; rp[1] = o1;
    }
}
__device__ __forceinline__ void fixup_phase(const P& p, int l) {
    const float* wdw = INP(22) + (size_t)l * 3 * FF; const float* bdw = INP(23) + (size_t)l * FF;
    const float* AF = (const float*)(WSB + WS_AF); const float* LF = (const float*)(WSB + WS_LF); const float* AL = (const float*)(WSB + WS_AL);
    const float* SA = (const float*)(WSB + WS_SA); const float* SL = (const float*)(WSB + WS_SL); us* G = (us*)(WSB + WS_G);
    const int gt = blockIdx.x * 512 + otid(), gn = gridDim.x * 512;
    for (int i = gt; i < 256 * 2 * FF; i += gn) { const int f = i % FF, sr = i / FF, rr = sr & 1, s = sr >> 1;
        const bool first = (s & 31) == 0;
        const float l0 = first ? 0.f : AL[((size_t)(s - 1) * 2) * FF + f], l1 = first ? 0.f : AL[((size_t)(s - 1) * 2 + 1) * FF + f];
        const float a2 = AF[(size_t)sr * FF + f], a1 = rr ? AF[((size_t)s * 2) * FF + f] : l1, a0 = rr ? l1 : l0;
        const float g = silu_f(bdw[f] + wdw[f] * a0 + wdw[FF + f] * a1 + wdw[2 * FF + f] * a2) * LF[(size_t)sr * FF + f];
        G[((size_t)s * 64 + rr) * FF + f] = (us)f2bf(g); }
    const float* hist = INP(8) + (size_t)l * NBS * 2 * FF;
    for (int i = gt; i < NTS * FF; i += gn) { const int f = i % FF, r = i / FF, b = r >> 4, t = r & 15;
        const float a2 = SA[(size_t)r * FF + f];
        const float a1 = (t >= 1) ? SA[(size_t)(r - 1) * FF + f] : hist[((size_t)b * 2 + 1) * FF + f];
        const float a0 = (t >= 2) ? SA[(size_t)(r - 2) * FF + f] : hist[((size_t)b * 2 + t) * FF + f];
        const float g = silu_f(bdw[f] + wdw[f] * a0 + wdw[FF + f] * a1 + wdw[2 * FF + f] * a2) * SL[(size_t)r * FF + f];
        G[((size_t)NTP + r) * FF + f] = (us)f2bf(g); }
    float* oc = OUTB + O_PCONV + (size_t)l * NBP * 2 * FF;
    for (int i = gt; i < NBP * 2 * FF; i += gn) { const int f = i % FF, br = i / FF, b = br >> 1, rr = br & 1; oc[i] = AL[((size_t)(32 * b + 31) * 2 + rr) * FF + f]; }
    float* os = OUTB + O_SCONV + (size_t)l * NBS * 2 * FF;
    for (int i = gt; i < NBS * 2 * FF; i += gn) { const int f = i % FF, br = i / FF, b = br >> 1, rr = br & 1; os[i] = SA[((size_t)b * 16 + 14 + rr) * FF + f]; }
}
__device__ __forceinline__ void small_gemm(LAS unsigned char* lds, const us* A  , const us* Bt, int K, float* Y, float* YSQ) {
    const int tid = otid(), lane = tid & 63, wid = tid >> 6, cg4 = wid & 3, kh = wid >> 2, rl = lane & 15, kq = lane >> 4;
    LAS float* xch = (LAS float*)lds;
    for (int it = blockIdx.x; it < 256; it += gridDim.x) {
        const int rb = it >> 4, cb = it & 15;
        const us* ap = A + (size_t)(rb * 16 + rl) * K + kh * (K / 2) + 8 * kq; const us* bp = Bt + (size_t)(cb * 64 + cg4 * 16 + rl) * K + kh * (K / 2) + 8 * kq;
        f32x4 acc = {0.f, 0.f, 0.f, 0.f};
#pragma unroll 4
        for (int k = 0; k < K / 2; k += 32) acc = MFMA16(*(const bf16x8*)(ap + k), *(const bf16x8*)(bp + k), acc);
        if (kh == 1) *(LAS f32x4*)(xch + (cg4 * 64 + lane) * 4) = acc;
        __syncthreads();
        if (kh == 0) {
            acc = acc + *(LAS const f32x4*)(xch + (cg4 * 64 + lane) * 4);
            const int col = cb * 64 + cg4 * 16 + rl;
#pragma unroll
            for (int r = 0; r < 4; ++r) { const int row = rb * 16 + 4 * kq + r; Y[(size_t)row * DM + col] = acc[r];
                float ss = acc[r] * acc[r]; ss += __shfl_xor(ss, 1); ss += __shfl_xor(ss, 2); ss += __shfl_xor(ss, 4); ss += __shfl_xor(ss, 8);
                if (rl == 0) xch[1024 + cg4 * 16 + 4 * kq + r] = ss; }
        }
        __syncthreads();
        if (tid < 16) YSQ[(size_t)(rb * 16 + tid) * 16 + cb] = (xch[1024 + tid] + xch[1024 + 16 + tid]) + (xch[1024 + 32 + tid] + xch[1024 + 48 + tid]);
        __syncthreads();
    }
}
constexpr int LDS_BYTES = 147456;
constexpr int NPHASE = 19;
#define XB_TMO      128
#define XB_XCNT(j)  (256  + 64 * (j))
#define XB_XSUB(j)  (1280 + 64 * (j))
#define XB_XGEN(j)  (2304 + 64 * (j))
#define XB_TOP      3328
#define XB_TOPGEN   3392
#define XCD_BAR_WORDS 3456
#define XB_SPIN_CAP (1u << 18)

__device__ __forceinline__ unsigned xb_ld(unsigned* p)              { return __hip_atomic_load(p, __ATOMIC_RELAXED, __HIP_MEMORY_SCOPE_AGENT); }
__device__ __forceinline__ unsigned xb_add(unsigned* p, unsigned v) { return __hip_atomic_fetch_add(p, v, __ATOMIC_RELAXED, __HIP_MEMORY_SCOPE_AGENT); }
__device__ __forceinline__ unsigned xb_xcc_id() { return (unsigned)__builtin_amdgcn_s_getreg((3 << 11) | 20) & 0xFu; }
#define XB_SPIN(cond, bar) do { unsigned _sp = 0; while (cond) { __builtin_amdgcn_s_sleep(1); \
    if ((++_sp & 255u) == 0u) { if (xb_ld(&(bar)[XB_TMO])) break; if (_sp > XB_SPIN_CAP) { atomicAdd(&(bar)[XB_TMO], 1u); break; } } } } while (0)

struct XcdBarrier {
    unsigned* bar; unsigned x;
    volatile LAS unsigned* st;
};

__device__ __forceinline__ XcdBarrier xcd_barrier_post(unsigned* bar, volatile LAS unsigned* st) {
    XcdBarrier b; b.bar = bar; b.x = xb_xcc_id(); b.st = st;
    if (threadIdx.x == 0) (void)xb_add(&bar[XB_XCNT(b.x)], 1u);
    return b;
}
__device__ __forceinline__ void xcd_barrier_complete(unsigned* bar, unsigned x, unsigned& nloc, unsigned& nx) {
    const unsigned G = gridDim.x * gridDim.y * gridDim.z;
    unsigned sum, cnt, mine, sp = 0u;
    for (;;) {
        sum = 0u; cnt = 0u; mine = 0u;
#pragma unroll
        for (unsigned j = 0; j < 16; ++j) { const unsigned c = xb_ld(&bar[XB_XCNT(j)]); sum += c; cnt += (c > 0u) ? 1u : 0u; mine = (j == x) ? c : mine; }
        if (sum == G) break;
        __builtin_amdgcn_s_sleep(1);
        if ((++sp & 255u) == 0u) { if (xb_ld(&bar[XB_TMO])) break; if (sp > XB_SPIN_CAP) { atomicAdd(&bar[XB_TMO], 1u); break; } }
    }
    nloc = mine > 0u ? mine : 1u; nx = cnt > 0u ? cnt : 1u;
}

__device__ __forceinline__ void xcd_barrier(const XcdBarrier& b) {
    asm volatile("s_waitcnt vmcnt(0)" ::: "memory");
    __syncthreads();
    if (threadIdx.x == 0) {
        unsigned* bar = b.bar;
        __builtin_amdgcn_s_waitcnt(0);
        unsigned nloc = b.st[0], nx = b.st[1];
        if (nloc == 0u) { xcd_barrier_complete(bar, b.x, nloc, nx); b.st[0] = nloc; b.st[1] = nx; }
        const unsigned old = xb_add(&bar[XB_XSUB(b.x)], 1u);
        const unsigned gen = old / nloc;
        if (old + 1u == (gen + 1u) * nloc) {
            __builtin_amdgcn_fence(__ATOMIC_RELEASE, "agent");
            asm volatile("s_waitcnt vmcnt(0)" ::: "memory");
            const unsigned og = xb_add(&bar[XB_TOP], 1u);
            const unsigned tg = og / nx;
            if (og + 1u == (tg + 1u) * nx) xb_add(&bar[XB_TOPGEN], 1u);
            else XB_SPIN(xb_ld(&bar[XB_TOPGEN]) == tg, bar);
            __builtin_amdgcn_fence(__ATOMIC_ACQUIRE, "agent");
            xb_add(&bar[XB_XGEN(b.x)], 1u);
            asm volatile("s_waitcnt vmcnt(0)" ::: "memory");
        } else {
            XB_SPIN(xb_ld(&bar[XB_XGEN(b.x)]) == gen, bar);
            __builtin_amdgcn_fence(__ATOMIC_ACQUIRE, "agent");
            asm volatile("s_waitcnt vmcnt(0)" ::: "memory");
        }
    }
    __syncthreads();
}


__global__ void __launch_bounds__(512, 2) mega(P p) {
    extern __shared__ __attribute__((aligned(16))) unsigned char lds_raw[];
    LAS unsigned char* lds = (LAS unsigned char*)lds_raw;
    volatile LAS unsigned* xst = (volatile LAS unsigned*)(lds + LDS_BYTES - 16);
    if (threadIdx.x < 4) xst[threadIdx.x] = 0u;
    __syncthreads();
    if (p.coop) { cg::grid_group grid = cg::this_grid(); grid.sync();
        (void)xcd_barrier_post((unsigned*)(WSB + WS_CTL), xst); }
#define XB ((us*)(WSB + WS_XB))
#define RS ((float*)(WSB + WS_RS))
#define X (OUTB + O_Y)
#define Y ((float*)(WSB + WS_Y))
#define YSQ ((float*)(WSB + WS_YSQ))
    for (int ph = p.ph_lo; ph < p.ph_hi; ++ph) {
#ifdef RPT_MASK
      for (int rep = 0; rep < ((ph > 0 && ((RPT_MASK >> ((ph - 1) % 9)) & 1)) || (ph == 0 && (RPT_MASK & 0x200)) ? 2 : 1); ++rep) {
#else
      {
#endif
        if (ph == 0) {
            prep_phase(p, lds);
            row_pass<false, true, true>(INP(0), INP(1), NT, nullptr, nullptr, nullptr, nullptr, XB, RS, INP(10), INP(9), INP(11), OUTB + O_PLF, OUTB + O_SLF);
            row_pass<false, false, true>(INP(2), INP(2), NMEMROWS, nullptr, nullptr, nullptr, nullptr, (us*)(WSB + WS_MEMB), (float*)(WSB + WS_RSMEM), nullptr, nullptr, nullptr, nullptr, nullptr);
        } else {
            const int l = (ph - 1) / 9, s = (ph - 1) % 9;
            if (s == 0) {
                { pg8::Gemm g{XB, (const us*)(WSB + WS_WIN) + (size_t)l * NIN * DM, NT, NIN, DM}; pg8::StaticOrder S; S.init(NT, NIN, gridDim.x, blockIdx.x);
                  pg8::EpiIn E{0, l, WSB, OUTB};
                  pg8::gemm_phase<pg8::EpiIn, pg8::StaticOrder, true, true>(lds, g, S, E); }
                if (l == 0) {
#pragma unroll 1
                    for (int ll = 0; ll < 2; ++ll) {
                        pg8::Gemm g{(const us*)(WSB + WS_MEMB), (const us*)(WSB + WS_WMEM) + (size_t)ll * 512 * DM, NMEMROWS, 512, DM}; pg8::StaticOrder S; S.init(NMEMROWS, 512, gridDim.x, (blockIdx.x + 80 + 16 * ll) % gridDim.x);
                        pg8::EpiIn E{1, ll, WSB, OUTB};
                        pg8::gemm_phase<pg8::EpiIn, pg8::StaticOrder, true, true>(lds, g, S, E); }
                }
            } else if (s == 1) { attn_phase(p, lds, l);
            } else if (s == 2) { gnorm_phase(p, l);
            } else if (s == 3 || s == 7) {
                const us* A = (s == 3) ? (const us*)(WSB + WS_CAT) : (const us*)(WSB + WS_G); const int K = (s == 3) ? DM : FF;
                const us* Bt = (s == 3) ? (const us*)(WSB + WS_WOUT) + (size_t)l * DM * DM : (const us*)(WSB + WS_WDOWN) + (size_t)l * DM * FF;
                { pg8::Gemm g{A, Bt, NTP, DM, K}; pg8::StaticOrder S; S.init(NTP, DM, gridDim.x, blockIdx.x); pg8::EpiY E{WSB};
                  pg8::gemm_phase<pg8::EpiY, pg8::StaticOrder, true, true>(lds, g, S, E); }
                small_gemm(lds, A + (size_t)NTP * K, Bt, K, Y + (size_t)NTP * DM, YSQ + (size_t)NTP * 16);
            } else if (s == 4) {
                const float* xp = (l == 0) ? INP(0) : X; const float* xs = (l == 0) ? INP(1) : X + (size_t)NTP * DM;
                row_pass<true, false, true>(xp, xs, NT, X, Y, YSQ, INP(19) + (size_t)l * DM, XB, RS, nullptr, nullptr, nullptr, nullptr, nullptr);
            } else if (s == 5) {
                pg8::Gemm g{XB, (const us*)(WSB + WS_WUP) + (size_t)l * NUP * DM, NT, NUP, DM}; pg8::StaticOrder S; S.init(NT, NUP, gridDim.x, blockIdx.x);
                pg8::EpiUp E{WSB, INP(22) + (size_t)l * 3 * FF, INP(23) + (size_t)l * FF};
                pg8::gemm_phase<pg8::EpiUp, pg8::StaticOrder, true, true>(lds, g, S, E);
            } else if (s == 6) { fixup_phase(p, l);
            } else {
                if (l == 0) row_pass<true, true, true>(X, X + (size_t)NTP * DM, NT, X, Y, YSQ, INP(25), XB, RS, INP(10) + (size_t)DM * INC, INP(9) + DM, INP(11) + 8, OUTB + O_PLF + (size_t)NTP * 8, OUTB + O_SLF + (size_t)NTS * 8);
                else row_pass<true, false, false>(X, X + (size_t)NTP * DM, NT, X, Y, YSQ, INP(25) + DM, nullptr, nullptr, nullptr, nullptr, nullptr, nullptr, nullptr);
            }
        }
      }
        if (p.coop && ph + 1 < p.ph_hi) { XcdBarrier xb_; xb_.bar = (unsigned*)(WSB + WS_CTL); xb_.x = xb_xcc_id(); xb_.st = xst; xcd_barrier(xb_); }
    }
}

#undef XB
#undef RS
#undef X
#undef Y
#undef YSQ
extern "C" void kernel_launch(void* const* d_in, const int* in_sizes, int n_in, void* d_out, int out_size, void* d_ws, size_t ws_size, hipStream_t stream) {
    static int grid = 0;
    if (grid == 0) {
        if (n_in != 26 || out_size != (int)O_END || ws_size < WS_END) { fprintf(stderr, "kernel_launch: unexpected sizes n_in %d out %d ws %zu (need %zu)\n", n_in, out_size, ws_size, (size_t)WS_END); grid = -1; return; }
        int dev = 0, cus = 0, per_cu = 0;
        (void)hipGetDevice(&dev); (void)hipDeviceGetAttribute(&cus, hipDeviceAttributeMultiprocessorCount, dev);
        if (hipFuncSetAttribute((const void*)mega, hipFuncAttributeMaxDynamicSharedMemorySize, LDS_BYTES) != hipSuccess) { fprintf(stderr, "kernel_launch: hipFuncSetAttribute failed\n"); grid = -1; return; }
        (void)hipOccupancyMaxActiveBlocksPerMultiprocessor(&per_cu, (const void*)mega, 512, LDS_BYTES);
        (void)hipGetLastError();
        if (per_cu < 1) fprintf(stderr, "kernel_launch: occupancy query says %d blocks per CU\n", per_cu);
        grid = cus > 0 ? cus : 256;
    }
    if (grid < 0) return;
    if (hipMemsetAsync((char*)d_ws + WS_CTL, 0, 16384, stream) != hipSuccess) { fprintf(stderr, "kernel_launch: memset failed\n"); return; }
    P p{};
    for (int i = 0; i < 26; ++i) p.in[i] = (const float*)d_in[i];
    p.out = (float*)d_out; p.ws = (unsigned char*)d_ws; p.pad = 0;
#ifndef MK_MULTI
    p.ph_lo = 0; p.ph_hi = NPHASE; p.coop = 1;
    void* args[] = {&p};
    hipError_t e = hipLaunchCooperativeKernel((void*)mega, dim3(grid), dim3(512), args, LDS_BYTES, stream);
    if (e != hipSuccess) fprintf(stderr, "kernel_launch: cooperative launch failed: %s (grid %d)\n", hipGetErrorString(e), grid);
#else
    for (int ph = 0; ph < NPHASE; ++ph) { p.ph_lo = ph; p.ph_hi = ph + 1; p.coop = 0; hipLaunchKernelGGL(mega, dim3(grid), dim3(512), LDS_BYTES, stream, p); }
#endif
}
```

```cpp
#include <hip/hip_runtime.h>
#include <hip/hip_cooperative_groups.h>
#include <cstdio>
#include <cstdint>
namespace cg = cooperative_groups;
#define LAS __attribute__((address_space(3)))
typedef unsigned short us;
typedef float f32x16 __attribute__((ext_vector_type(16)));
typedef short s16x4 __attribute__((ext_vector_type(4)));

constexpr int DM = 1024, NTP = 16384, NTS = 256, NT = NTP + NTS, SEQ = 2048, NBP = 8, NBS = 16, PAST = 1024;
constexpr int INC = 2312, NIN = 2304, FF = 2816, NUP = 5632, NMEMROWS = 2048;
constexpr float LOG2E = 1.4426950408889634f, C2 = 0.125f * 1.4426950408889634f, EPS = 1e-6f;

constexpr size_t O_Y = 0, O_YS = 16777216, O_PK = 17039360, O_PV = 33816576, O_PLF = 50593792, O_PMK = 50855936, O_PMV = 51904512,
                 O_PCONV = 52953088, O_SK = 53043200, O_SV = 53305344, O_SLF = 53567488, O_SGV = 53571584, O_SCONV = 53702656, O_END = 53882880;
constexpr size_t MiB = 1u << 20;
constexpr size_t WS_WIN = 0;
constexpr size_t WS_WOUT = 10 * MiB;
constexpr size_t WS_WUP = 14 * MiB;
constexpr size_t WS_WDOWN = 36 * MiB;
constexpr size_t WS_WMEM = 47 * MiB;
constexpr size_t WS_XB = 49 * MiB;
constexpr size_t WS_MEMB = 82 * MiB;
constexpr size_t WS_MKV = 86 * MiB;
constexpr size_t WS_RS = 90 * MiB;
constexpr size_t WS_RSMEM = 90 * MiB + 128 * 1024;
constexpr size_t WS_YSQ = 91 * MiB;
constexpr size_t WS_AF = 93 * MiB;
constexpr size_t WS_LF = 99 * MiB;
constexpr size_t WS_AL = 105 * MiB;
constexpr size_t WS_SA = 111 * MiB;
constexpr size_t WS_SL = 114 * MiB;
constexpr size_t WS_Y = 117 * MiB;
constexpr size_t WS_ACT = 183 * MiB;
constexpr size_t WS_QB = WS_ACT;
constexpr size_t WS_KB = WS_ACT + 17 * MiB;
constexpr size_t WS_VB = WS_ACT + 34 * MiB;
constexpr size_t WS_UB = WS_ACT + 51 * MiB;
constexpr size_t WS_ZB = WS_ACT + 60 * MiB;
constexpr size_t WS_QMB = WS_ACT + 69 * MiB;
constexpr size_t WS_CAT = WS_ACT + 78 * MiB;
constexpr size_t WS_G = WS_ACT;
constexpr size_t WS_CTL = WS_ACT + 111 * MiB;
constexpr size_t WS_END = WS_ACT + 112 * MiB;

__device__ __forceinline__ unsigned f2bf(float f) { unsigned u = __builtin_bit_cast(unsigned, f); return (u + 0x7fffu + ((u >> 16) & 1u)) >> 16; }
__device__ __forceinline__ unsigned pk2(float lo, float hi) { return f2bf(lo) | (f2bf(hi) << 16); }
__device__ __forceinline__ float bf2f(unsigned h) { return __builtin_bit_cast(float, h << 16); }
__device__ __forceinline__ float gelu_tanh(float x) { const float y = 0.7978845608028654f * (x + 0.044715f * x * x * x); return x / (1.f + __expf(-2.f * y)); }
__device__ __forceinline__ float silu_f(float x) { return x / (1.f + __expf(-x)); }
__device__ __forceinline__ float wave_sum(float v) {
#pragma unroll
    for (int o = 1; o < 64; o <<= 1) v += __shfl_xor(v, o);
    return v;
}
__device__ __forceinline__ int opq0() { int z; asm volatile("s_mov_b32 %0, 0" : "=s"(z)); return z; }
__device__ __forceinline__ int otid() { int t = threadIdx.x; asm volatile("" : "+v"(t)); return t; }
namespace pg8 {
#define PG8_LAS __attribute__((address_space(3)))
typedef unsigned short bf16_t;
typedef short bf16x8 __attribute__((ext_vector_type(8)));
typedef float f32x4 __attribute__((ext_vector_type(4)));
typedef unsigned u32x4 __attribute__((ext_vector_type(4)));
constexpr int BM = 256, BK = 64, HALF = 128, HTB = HALF * BK * 2  , STAGE_BYTES = 8 * HTB, NXCD = 8, WGM = 8;

__host__ __device__ __forceinline__ int lds_byte(int r, int c) { const int st = (r >> 4) * 2 + (c >> 5), rr = r & 15, cc = c & 31, ob = rr * 64 + cc * 2; return st * 1024 + (ob ^ (((ob >> 9) & 1) << 5)); }
__host__ __device__ __forceinline__ void stage_rc(int b, int& R, int& C) { const int st = b / 1024, sb = b % 1024, swz = sb ^ (((sb >> 9) & 1) << 5); R = (st >> 1) * 16 + swz / 64; C = (st & 1) * 32 + (swz % 64) / 2; }
__host__ __device__ __forceinline__ int perm32(int rho) { const int n = rho >> 4, i = rho & 15; return 8 * (i >> 2) + 4 * n + (i & 3); }

struct Unit { int pm, pn; };
struct Gemm { const bf16_t* A; const bf16_t* Bt; int M, N, K; };

struct StaticOrder {
    int nM, nN, nwg, G, c;
    __host__ __device__ void init(int M, int N, int G_, int c_) { nM = M / BM; nN = N / BM; nwg = nM * nN; G = G_; c = c_; }
    __host__ __device__ bool next(int i, Unit& u) const {
        const long L = (long)i * G + c; if (L >= nwg) return false;
        int wgid = (int)L; { const int q = nwg / NXCD, r = nwg % NXCD, xcd = wgid % NXCD, off = wgid / NXCD; wgid = (xcd < r ? xcd * (q + 1) : r * (q + 1) + (xcd - r) * q) + off; }
        const int nig = WGM * nN, gid = wgid / nig, fm = gid * WGM, gsz = (nM - fm) < WGM ? (nM - fm) : WGM;
        u.pm = fm + ((wgid % nig) % gsz); u.pn = (wgid % nig) / gsz; return true;
    }
    __device__ __forceinline__ void a_ready(const Unit&) const {}
    __device__ __forceinline__ void done(const Unit&) const {}
};
__device__ __forceinline__ unsigned cvt_pk_bf16(float lo, float hi) { unsigned r; asm volatile("v_cvt_pk_bf16_f32 %0, %1, %2" : "=v"(r) : "v"(lo), "v"(hi)); return r; }
struct EpiIn {
    static constexpr bool PERM = true, AFTER_DRAIN = false;
    int mode, l; unsigned char* ws; float* out;
    __device__ __forceinline__ void operator()(const f32x4 (&acc)[2][2][4][2], const Unit& u, int wr, int wc, int fr_, int fq_) const {
        int fr = fr_, fq = fq_; asm volatile("" : "+v"(fr), "+v"(fq));
        const int pn = u.pn;
        const float* rs = (const float*)(ws + (mode == 0 ? WS_RS : WS_RSMEM));
        bf16_t* const QB = (bf16_t*)(ws + WS_QB); bf16_t* const KB = (bf16_t*)(ws + WS_KB); bf16_t* const VB = (bf16_t*)(ws + WS_VB); bf16_t* const UB = (bf16_t*)(ws + WS_UB);
        bf16_t* const ZB = (bf16_t*)(ws + WS_ZB); bf16_t* const QMB = (bf16_t*)(ws + WS_QMB); bf16_t* const MKV = (bf16_t*)(ws + WS_MKV) + (size_t)l * NMEMROWS * 512;
        float* const oKp = out + O_PK + (size_t)l * NTP * 512; float* const oVp = out + O_PV + (size_t)l * NTP * 512; float* const oKs = out + O_SK + (size_t)l * NTS * 512; float* const oVs = out + O_SV + (size_t)l * NTS * 512;
        float* const oMK = out + O_PMK + (size_t)l * NMEMROWS * 256; float* const oMV = out + O_PMV + (size_t)l * NMEMROWS * 256;
        bf16_t* bdst; int bp; int bc; float mult = 1.f; int act = 0; float* fP = nullptr; float* fS = nullptr; int fp_ = 0, fc = 0;
        if (mode == 0) {
            if (pn < 2) { bdst = QB; bp = 512; bc = pn * 256; mult = C2; }
            else if (pn < 4) { bdst = KB; bp = 512; bc = (pn - 2) * 256; fP = oKp; fS = oKs; fp_ = 512; fc = bc; }
            else if (pn < 6) { bdst = VB; bp = 512; bc = (pn - 4) * 256; fP = oVp; fS = oVs; fp_ = 512; fc = bc; }
            else if (pn == 6) { bdst = UB; bp = 256; bc = 0; act = 1; }
            else if (pn == 7) { bdst = ZB; bp = 256; bc = 0; act = 1; }
            else { bdst = QMB; bp = 256; bc = 0; mult = C2; }
        } else { bdst = MKV; bp = 512; bc = pn * 256; fP = pn ? oMV : oMK; fS = fP; fp_ = 256; fc = 0; }
#pragma unroll
        for (int ai = 0; ai < 2; ++ai)
#pragma unroll
            for (int m = 0; m < 4; ++m) {
                const int row = u.pm * BM + ai * HALF + wr * 64 + m * 16 + fr;
                const float s = rs[row] * mult;
                float* frow = nullptr;
                if (fP) frow = (mode == 0 && row >= NTP) ? fS + (size_t)(row - NTP) * fp_ + fc : fP + (size_t)row * fp_ + fc;
#pragma unroll
                for (int bj = 0; bj < 2; ++bj) {
                    const int lc = bj * HALF + wc * 32 + 8 * fq;
                    f32x4 v0 = acc[ai][bj][m][0] * s, v1 = acc[ai][bj][m][1] * s;
                    if (act) { v0 = (f32x4){gelu_tanh(v0[0]), gelu_tanh(v0[1]), gelu_tanh(v0[2]), gelu_tanh(v0[3])}; v1 = (f32x4){gelu_tanh(v1[0]), gelu_tanh(v1[1]), gelu_tanh(v1[2]), gelu_tanh(v1[3])}; }
                    if (frow) { *(f32x4*)(frow + lc) = v0; *(f32x4*)(frow + lc + 4) = v1; }
                    u32x4 w; w.x = cvt_pk_bf16(v0[0], v0[1]); w.y = cvt_pk_bf16(v0[2], v0[3]); w.z = cvt_pk_bf16(v1[0], v1[1]); w.w = cvt_pk_bf16(v1[2], v1[3]);
                    *(u32x4*)(bdst + (size_t)row * bp + bc + lc) = w;
                }
            }
    }
};
struct EpiY {
    static constexpr bool PERM = true, AFTER_DRAIN = false;
    unsigned char* ws;
    __device__ __forceinline__ void operator()(const f32x4 (&acc)[2][2][4][2], const Unit& u, int wr, int wc, int fr_, int fq_) const {
        int fr = fr_, fq = fq_; asm volatile("" : "+v"(fr), "+v"(fq));
        bf16_t* const Y = (bf16_t*)(ws + WS_Y); float* const YSQ = (float*)(ws + WS_YSQ);
#pragma unroll
        for (int ai = 0; ai < 2; ++ai)
#pragma unroll
            for (int m = 0; m < 4; ++m) {
                const int row = u.pm * BM + ai * HALF + wr * 64 + m * 16 + fr;
                float ss = 0.f;
#pragma unroll
                for (int bj = 0; bj < 2; ++bj) {
                    const int c = u.pn * BM + bj * HALF + wc * 32 + 8 * fq;
                    const f32x4 v0 = acc[ai][bj][m][0], v1 = acc[ai][bj][m][1];
                    u32x4 w; w.x = cvt_pk_bf16(v0[0], v0[1]); w.y = cvt_pk_bf16(v0[2], v0[3]); w.z = cvt_pk_bf16(v1[0], v1[1]); w.w = cvt_pk_bf16(v1[2], v1[3]);
                    *(u32x4*)(Y + (size_t)row * DM + c) = w;
                    ss += (v0[0] * v0[0] + v0[1] * v0[1]) + (v0[2] * v0[2] + v0[3] * v0[3]) + (v1[0] * v1[0] + v1[1] * v1[1]) + (v1[2] * v1[2] + v1[3] * v1[3]);
                }
                ss += __shfl_xor(ss, 16); ss += __shfl_xor(ss, 32);
                if (fq == 0) YSQ[(size_t)row * 16 + u.pn * 4 + wc] = ss;
            }
    }
};
struct EpiUp {
    static constexpr bool PERM = true, AFTER_DRAIN = false;
    unsigned char* ws; const float* wdw; const float* bdw;
    __device__ __forceinline__ void operator()(const f32x4 (&acc)[2][2][4][2], const Unit& u, int wr, int wc, int fr_, int fq_) const {
        int fr = fr_, fq = fq_; asm volatile("" : "+v"(fr), "+v"(fq));
        const int f0 = u.pn * 128 + wc * 32 + 8 * fq;
        const float* rs = (const float*)(ws + WS_RS); bf16_t* const G = (bf16_t*)(ws + WS_G);
        float* const AF = (float*)(ws + WS_AF); float* const LF = (float*)(ws + WS_LF); float* const AL = (float*)(ws + WS_AL); float* const SA = (float*)(ws + WS_SA); float* const SL = (float*)(ws + WS_SL);
        const int lane = fq * 16 + fr;
        if (u.pm == NTP / BM) {
#pragma unroll
            for (int ai = 0; ai < 2; ++ai)
#pragma unroll
                for (int m = 0; m < 4; ++m) {
                    const int lr = ai * HALF + wr * 64 + m * 16 + fr; const float s = rs[NTP + lr];
                    *(f32x4*)(SA + (size_t)lr * FF + f0) = acc[ai][0][m][0] * s; *(f32x4*)(SA + (size_t)lr * FF + f0 + 4) = acc[ai][0][m][1] * s;
                    *(f32x4*)(SL + (size_t)lr * FF + f0) = acc[ai][1][m][0] * s; *(f32x4*)(SL + (size_t)lr * FF + f0 + 4) = acc[ai][1][m][1] * s;
                }
            return;
        }
        const int src1 = (lane & 48) | ((fr - 1) & 15), src2 = (lane & 48) | ((fr - 2) & 15);
#pragma unroll
        for (int n = 0; n < 2; ++n) {
            const int fn = f0 + 4 * n;
            const f32x4 w0 = *(const f32x4*)(wdw + fn), w1 = *(const f32x4*)(wdw + FF + fn), w2 = *(const f32x4*)(wdw + 2 * FF + fn), bb = *(const f32x4*)(bdw + fn);
#pragma unroll
            for (int ai = 0; ai < 2; ++ai) {
                const int strip = u.pm * 4 + ai * 2 + wr;
                f32x4 ap = {0.f, 0.f, 0.f, 0.f};
#pragma unroll
                for (int m = 0; m < 4; ++m) {
                    const int row = u.pm * BM + ai * HALF + wr * 64 + m * 16 + fr; const float s = rs[row];
                    const f32x4 a = acc[ai][0][m][n] * s, li = acc[ai][1][m][n] * s; f32x4 gv;
#pragma unroll
                    for (int e = 0; e < 4; ++e) {
                        const float s1 = (fr == 15) ? ap[e] : a[e], s2 = (fr >= 14) ? ap[e] : a[e];
                        const float a1 = __shfl(s1, src1), a0 = __shfl(s2, src2);
                        gv[e] = silu_f(bb[e] + w0[e] * a0 + w1[e] * a1 + w2[e] * a[e]) * li[e];
                    }
                    if (m == 0 && fr < 2) {
                        *(f32x4*)(AF + ((size_t)strip * 2 + fr) * FF + fn) = a; *(f32x4*)(LF + ((size_t)strip * 2 + fr) * FF + fn) = li;
                    } else {
                        unsigned long long w = (unsigned long long)cvt_pk_bf16(gv[0], gv[1]) | ((unsigned long long)cvt_pk_bf16(gv[2], gv[3]) << 32);
                        *(unsigned long long*)(G + (size_t)row * FF + fn) = w;
                    }
                    if (m == 3 && fr >= 14) *(f32x4*)(AL + ((size_t)strip * 2 + (fr - 14)) * FF + fn) = a;
                    ap = a;
                    __builtin_amdgcn_sched_barrier(0);
                }
            }
        }
    }
};
template <class Epi, class Sched, bool ALIGN_EPI = false, bool SP2 = false>
__device__ __forceinline__ void gemm_phase(PG8_LAS unsigned char* lds, const Gemm g, const Sched& S, const Epi& E) {
    const int tid = otid(), wid = __builtin_amdgcn_readfirstlane(tid >> 6), lane = tid & 63, wr = wid >> 2, wc = wid & 3, fr = lane & 15, fq = lane >> 4;
    const int K = g.K, nt = K / BK;
    unsigned voffA[2], voffB[2];
#pragma unroll
    for (int i = 0; i < 2; ++i) { int R, C; stage_rc(tid * 16 + i * 8192, R, C); const int Rb = Epi::PERM ? ((R & ~31) + perm32(R & 31)) : R;
        voffA[i] = (unsigned)(R * K + C) * 2u; voffB[i] = (unsigned)(Rb * K + C) * 2u; }
    const size_t kstep = (size_t)(BK * 2);
    const size_t hstep = (size_t)HALF * K * 2;
    const size_t tstep = 2 * hstep;
    const unsigned ldsw = (unsigned)wid * 1024u;
    const int aoff = lds_byte(wr * 64 + fr, fq * 8), boff = lds_byte(wc * 32 + fr, fq * 8);
#define PG8_SA(b, h) (((b) * 2 + (h)) * HTB)
#define PG8_SB(b, h) ((4 + (b) * 2 + (h)) * HTB)
#define PG8_STAGE(bufoff, gbase, voff) do { _Pragma("unroll") for (int _i = 0; _i < 2; ++_i) \
        __builtin_amdgcn_global_load_lds((const unsigned*)((const char*)(gbase) + (voff)[_i]), (PG8_LAS unsigned*)(lds + (bufoff) + ldsw + _i * 8192), 16, 0, 0); } while (0)
#define PG8_LDA(dst, b, h) do { _Pragma("unroll") for (int m = 0; m < 4; ++m) _Pragma("unroll") for (int k = 0; k < 2; ++k) dst[m][k] = *(const PG8_LAS bf16x8*)(lds + PG8_SA(b, h) + aoff + m * 2048 + k * 1024); } while (0)
#define PG8_LDB(dst, b, h) do { _Pragma("unroll") for (int n = 0; n < 2; ++n) _Pragma("unroll") for (int k = 0; k < 2; ++k) dst[n][k] = *(const PG8_LAS bf16x8*)(lds + PG8_SB(b, h) + boff + n * 2048 + k * 1024); } while (0)
#define PG8_MMA(ai, bj, At, Bt) do { __builtin_amdgcn_s_setprio(1); _Pragma("unroll") for (int m = 0; m < 4; ++m) _Pragma("unroll") for (int n = 0; n < 2; ++n) _Pragma("unroll") for (int k = 0; k < 2; ++k) \
        acc[ai][bj][m][n] = __builtin_amdgcn_mfma_f32_16x16x32_bf16(Bt[n][k], At[m][k], acc[ai][bj][m][n], 0, 0, 0); __builtin_amdgcn_s_setprio(0); } while (0)
#define PG8_WAIT_V(n) asm volatile("s_waitcnt vmcnt(" #n ")" ::: "memory")
#define PG8_WAIT_L(n) asm volatile("s_waitcnt lgkmcnt(" #n ")" ::: "memory")
#define PG8_BAR __builtin_amdgcn_s_barrier()
#define PG8_SCHED __builtin_amdgcn_sched_barrier(0)
    Unit cur, nxt; int ui = 0;
    if (!S.next(0, cur)) return;
    f32x4 acc[2][2][4][2];
#pragma unroll
    for (int a = 0; a < 2; ++a)
#pragma unroll
        for (int b = 0; b < 2; ++b)
#pragma unroll
            for (int m = 0; m < 4; ++m)
#pragma unroll
                for (int n = 0; n < 2; ++n) acc[a][b][m][n] = (f32x4){0.f, 0.f, 0.f, 0.f};
    bf16x8 At[4][2], B0[2][2], B1[2][2];
    const char* cA = (const char*)g.A + (size_t)cur.pm * tstep; const char* cB = (const char*)g.Bt + (size_t)cur.pn * tstep;
    S.a_ready(cur);
    if constexpr (SP2) {
        PG8_STAGE(PG8_SB(0, 0), cB, voffB); PG8_STAGE(PG8_SB(0, 1), cB + hstep, voffB); PG8_STAGE(PG8_SA(0, 0), cA, voffA); PG8_STAGE(PG8_SA(0, 1), cA + hstep, voffA);
        if (wr == 1) PG8_BAR;
        PG8_WAIT_V(2); PG8_BAR;
        PG8_STAGE(PG8_SB(1, 0), cB + kstep, voffB); PG8_STAGE(PG8_SA(1, 0), cA + kstep, voffA); PG8_STAGE(PG8_SB(1, 1), cB + hstep + kstep, voffB);
        PG8_WAIT_V(6); PG8_BAR;
    } else {
        PG8_STAGE(PG8_SB(0, 0), cB, voffB); PG8_STAGE(PG8_SA(0, 0), cA, voffA); PG8_STAGE(PG8_SB(0, 1), cB + hstep, voffB); PG8_STAGE(PG8_SA(0, 1), cA + hstep, voffA);
        if (wr == 1) PG8_BAR;
        PG8_WAIT_V(4); PG8_BAR;
        PG8_STAGE(PG8_SB(1, 0), cB + kstep, voffB); PG8_STAGE(PG8_SA(1, 0), cA + kstep, voffA); PG8_STAGE(PG8_SB(1, 1), cB + hstep + kstep, voffB);
        PG8_WAIT_V(6); PG8_BAR;
    }
    for (;;) {
        const bool has_next = S.next(ui + 1, nxt);
        const char* nA = has_next ? (const char*)g.A + (size_t)nxt.pm * tstep : cA; const char* nB = has_next ? (const char*)g.Bt + (size_t)nxt.pn * tstep : cB;
        for (int t = 0; t < nt; t += 2) {
            const bool last = (t == nt - 2);
            const char* a1 = cA + (size_t)(t + 1) * kstep;
            const char* a2 = last ? nA : cA + (size_t)(t + 2) * kstep; const char* b2 = last ? nB : cB + (size_t)(t + 2) * kstep;
            const char* a3 = a2 + kstep; const char* b3 = b2 + kstep;
            if (last && has_next) S.a_ready(nxt);
            if constexpr (SP2) {
            PG8_LDB(B0, 0, 0); PG8_LDB(B1, 0, 1); PG8_SCHED; PG8_LDA(At, 0, 0); PG8_STAGE(PG8_SA(1, 1), a1 + hstep, voffA);
            PG8_WAIT_V(8); PG8_WAIT_L(0); PG8_BAR; PG8_MMA(0, 0, At, B0); PG8_MMA(0, 1, At, B1); PG8_BAR; PG8_SCHED;
            PG8_LDA(At, 0, 1); PG8_STAGE(PG8_SB(0, 0), b2, voffB); PG8_STAGE(PG8_SB(0, 1), b2 + hstep, voffB); PG8_STAGE(PG8_SA(0, 0), a2, voffA);
            PG8_WAIT_V(8); PG8_WAIT_L(0); PG8_BAR; PG8_MMA(1, 0, At, B0); PG8_MMA(1, 1, At, B1); PG8_BAR; PG8_SCHED;
            PG8_LDB(B0, 1, 0); PG8_LDB(B1, 1, 1); PG8_SCHED; PG8_LDA(At, 1, 0); PG8_STAGE(PG8_SA(0, 1), a2 + hstep, voffA);
            PG8_WAIT_V(8); PG8_WAIT_L(0); PG8_BAR; PG8_MMA(0, 0, At, B0); PG8_MMA(0, 1, At, B1); PG8_BAR; PG8_SCHED;
            PG8_LDA(At, 1, 1); PG8_STAGE(PG8_SB(1, 0), b3, voffB); PG8_STAGE(PG8_SB(1, 1), b3 + hstep, voffB); PG8_STAGE(PG8_SA(1, 0), a3, voffA);
            PG8_WAIT_V(8); PG8_WAIT_L(0); PG8_BAR; PG8_MMA(1, 0, At, B0); PG8_MMA(1, 1, At, B1); PG8_BAR; PG8_SCHED;
            } else {
            PG8_LDB(B0, 0, 0); PG8_SCHED; PG8_LDA(At, 0, 0); PG8_STAGE(PG8_SA(1, 1), a1 + hstep, voffA);
            PG8_WAIT_L(8); PG8_BAR; PG8_WAIT_L(0); PG8_MMA(0, 0, At, B0); PG8_BAR; PG8_SCHED;
            PG8_LDB(B1, 0, 1); PG8_STAGE(PG8_SB(0, 0), b2, voffB);
            PG8_BAR; PG8_WAIT_L(0); PG8_MMA(0, 1, At, B1); PG8_BAR;
            PG8_LDA(At, 0, 1); PG8_STAGE(PG8_SA(0, 0), a2, voffA);
            PG8_BAR; PG8_WAIT_L(0); PG8_MMA(1, 0, At, B0); PG8_BAR; PG8_SCHED;
            PG8_STAGE(PG8_SB(0, 1), b2 + hstep, voffB);
            PG8_WAIT_V(6); PG8_BAR; PG8_MMA(1, 1, At, B1); PG8_BAR;
            PG8_LDB(B0, 1, 0); PG8_SCHED; PG8_LDA(At, 1, 0); PG8_STAGE(PG8_SA(0, 1), a2 + hstep, voffA);
            PG8_WAIT_L(8); PG8_BAR; PG8_WAIT_L(0); PG8_MMA(0, 0, At, B0); PG8_BAR; PG8_SCHED;
            PG8_LDB(B1, 1, 1); PG8_STAGE(PG8_SB(1, 0), b3, voffB);
            PG8_BAR; PG8_WAIT_L(0); PG8_MMA(0, 1, At, B1); PG8_BAR;
            PG8_LDA(At, 1, 1); PG8_STAGE(PG8_SA(1, 0), a3, voffA);
            PG8_BAR; PG8_WAIT_L(0); PG8_MMA(1, 0, At, B0); PG8_BAR; PG8_SCHED;
            PG8_STAGE(PG8_SB(1, 1), b3 + hstep, voffB);
            PG8_WAIT_V(6); PG8_BAR; PG8_MMA(1, 1, At, B1); PG8_BAR;
            }
        }
        if constexpr (ALIGN_EPI) { if (wr == 0) PG8_BAR; }
        if constexpr (!Epi::AFTER_DRAIN) { E(acc, cur, wr, wc, fr, fq); S.done(cur); }
        if (!has_next) break;
#pragma unroll
        for (int a = 0; a < 2; ++a)
#pragma unroll
            for (int b = 0; b < 2; ++b)
#pragma unroll
                for (int m = 0; m < 4; ++m)
#pragma unroll
                    for (int n = 0; n < 2; ++n) acc[a][b][m][n] = (f32x4){0.f, 0.f, 0.f, 0.f};
        cur = nxt; cA = nA; cB = nB; ++ui;
        if constexpr (ALIGN_EPI) { if (wr == 1) PG8_BAR; }
    }
    PG8_WAIT_V(0);
    if constexpr (!ALIGN_EPI) { if (wr == 0) PG8_BAR; }
    PG8_BAR;
    if constexpr (Epi::AFTER_DRAIN) { E.fused(acc, cur, wr, wc, fr, fq, lds, wid, lane); S.done(cur); }
#undef PG8_SA
#undef PG8_SB
#undef PG8_STAGE
#undef PG8_LDA
#undef PG8_LDB
#undef PG8_MMA
#undef PG8_WAIT_V
#undef PG8_WAIT_L
#undef PG8_BAR
#undef PG8_SCHED
}
}
using pg8::bf16x8; using pg8::f32x4; using pg8::u32x4;
struct P {
    const float* in[26]; float* out; unsigned char* ws; int ph_lo, ph_hi, coop, pad;
};
#define INP(i) (p.in[(i) + opq0()])
#define WSB (p.ws + opq0())
#define OUTB (p.out + opq0())
#define MFMA32(a, b, c) __builtin_amdgcn_mfma_f32_32x32x16_bf16(a, b, c, 0, 0, 0)
#define MFMA16(a, b, c) __builtin_amdgcn_mfma_f32_16x16x32_bf16(a, b, c, 0, 0, 0)
typedef short v4i16_t __attribute__((ext_vector_type(4)));
__device__ __forceinline__ s16x4 trr(LAS const unsigned char* p) { return __builtin_bit_cast(s16x4, __builtin_amdgcn_ds_read_tr16_b64_v4i16((LAS v4i16_t*)p)); }

__device__ __forceinline__ void prep_tile(const float* src, int srcN, int K, const float* gain, us* dst, int kt, int n0dst, int n0src, LAS float* tile) {
    const int tid = otid();
#pragma unroll
    for (int i = 0; i < 8; ++i) { const int k = i * 8 + (tid >> 6), n = tid & 63; float v = src[(size_t)(kt * 64 + k) * srcN + n0src + n]; if (gain) v *= gain[kt * 64 + k]; tile[k * 65 + n] = v; }
    __syncthreads();
    const int n = tid >> 3, k8 = (tid & 7) * 8;
    u32x4 o; o.x = pk2(tile[(k8 + 0) * 65 + n], tile[(k8 + 1) * 65 + n]); o.y = pk2(tile[(k8 + 2) * 65 + n], tile[(k8 + 3) * 65 + n]);
    o.z = pk2(tile[(k8 + 4) * 65 + n], tile[(k8 + 5) * 65 + n]); o.w = pk2(tile[(k8 + 6) * 65 + n], tile[(k8 + 7) * 65 + n]);
    *(u32x4*)(dst + (size_t)(n0dst + n) * K + kt * 64 + k8) = o;
    __syncthreads();
}
__device__ __forceinline__ void prep_phase(const P& p, LAS unsigned char* lds) {
    LAS float* tile = (LAS float*)lds;
    constexpr int I_IN = 16 * 36, I_OUT = 16 * 16, I_UP = 16 * 88, I_DN = 44 * 16, I_MEM = 16 * 8, I_L = I_IN + I_OUT + I_UP + I_DN + I_MEM;
    for (int it = blockIdx.x; it < 2 * I_L; it += gridDim.x) {
        const int l = it / I_L; int r = it % I_L;
        if (r < I_IN) { const int kt = r / 36, nt = r % 36, nd = nt * 64; prep_tile(INP(10) + (size_t)l * DM * INC, INC, DM, INP(9) + l * DM, (us*)(WSB + WS_WIN) + (size_t)l * NIN * DM, kt, nd, nd < 1536 ? nd : nd + 8, tile); continue; } r -= I_IN;
        if (r < I_OUT) { const int kt = r / 16, nt = r % 16; prep_tile(INP(18) + (size_t)l * DM * DM, DM, DM, nullptr, (us*)(WSB + WS_WOUT) + (size_t)l * DM * DM, kt, nt * 64, nt * 64, tile); continue; } r -= I_OUT;
        if (r < I_UP) { const int kt = r / 88, nt = r % 88, nd = nt * 64, j = nd >> 8, w = nd & 255; prep_tile(INP(21) + (size_t)l * DM * NUP, NUP, DM, INP(20) + l * DM, (us*)(WSB + WS_WUP) + (size_t)l * NUP * DM, kt, nd, (w >> 7) * FF + 128 * j + (w & 127), tile); continue; } r -= I_UP;
        if (r < I_DN) { const int kt = r / 16, nt = r % 16; prep_tile(INP(24) + (size_t)l * FF * DM, DM, FF, nullptr, (us*)(WSB + WS_WDOWN) + (size_t)l * DM * FF, kt, nt * 64, nt * 64, tile); continue; } r -= I_DN;
        { const int kt = r / 8, nt = r % 8; prep_tile(INP(16) + (size_t)l * DM * 512, 512, DM, INP(15) + l * DM, (us*)(WSB + WS_WMEM) + (size_t)l * 512 * DM, kt, nt * 64, nt * 64, tile); }
    }
}

template <bool HAS_Y, bool DO_FG, bool WRITE_B>
__device__ __forceinline__ void row_pass(const float* xP, const float* xS, int nrows, float* xdst, const us* Y, const float* YSQ, const float* gpost,
                                         us* XB, float* RS, const float* win_l, const float* gpre, const float* bfg, float* lfP, float* lfS) {
    const int tid_ = otid(), lane = tid_ & 63, wid = tid_ >> 6;
    for (int row = blockIdx.x * 8 + wid; row < nrows; row += gridDim.x * 8) {
        const float* xr = (row < NTP) ? xP + (size_t)row * DM : xS + (size_t)(row - NTP) * DM;
        f32x4 v[4];
#pragma unroll
        for (int j = 0; j < 4; ++j) v[j] = *(const f32x4*)(xr + 4 * lane + 256 * j);
        if (HAS_Y) {
            const f32x4* q = (const f32x4*)(YSQ + (size_t)row * 16); const f32x4 a = q[0], b = q[1], c = q[2], d = q[3];
            const float ss = ((a[0] + a[1]) + (a[2] + a[3])) + ((b[0] + b[1]) + (b[2] + b[3])) + ((c[0] + c[1]) + (c[2] + c[3])) + ((d[0] + d[1]) + (d[2] + d[3]));
            const float ry = rsqrtf(ss * (1.f / DM) + EPS);
#pragma unroll
            for (int j = 0; j < 4; ++j) { const unsigned long long yw = *(const unsigned long long*)(Y + (size_t)row * DM + 4 * lane + 256 * j);
                const f32x4 y = {bf2f((unsigned)yw & 0xffffu), bf2f(((unsigned)yw) >> 16), bf2f((unsigned)(yw >> 32) & 0xffffu), bf2f((unsigned)(yw >> 48))}; const f32x4 g = *(const f32x4*)(gpost + 4 * lane + 256 * j); v[j] = v[j] + y * ry * g; }
        }
        if (xdst) {
#pragma unroll
            for (int j = 0; j < 4; ++j) *(f32x4*)(xdst + (size_t)row * DM + 4 * lane + 256 * j) = v[j];
        }
        if (WRITE_B) {
            float s = 0.f;
#pragma unroll
            for (int j = 0; j < 4; ++j) s += (v[j][0] * v[j][0] + v[j][1] * v[j][1]) + (v[j][2] * v[j][2] + v[j][3] * v[j][3]);
            const float rs = rsqrtf(wave_sum(s) * (1.f / DM) + EPS);
            if (lane == 0) RS[row] = rs;
#pragma unroll
            for (int j = 0; j < 4; ++j) { unsigned long long o = (unsigned long long)pk2(v[j][0], v[j][1]) | ((unsigned long long)pk2(v[j][2], v[j][3]) << 32); *(unsigned long long*)(XB + (size_t)row * DM + 4 * lane + 256 * j) = o; }
            if (DO_FG) {
                float f[8];
#pragma unroll
                for (int h = 0; h < 8; ++h) f[h] = 0.f;
#pragma unroll
                for (int j = 0; j < 4; ++j) { const f32x4 g = *(const f32x4*)(gpre + 4 * lane + 256 * j);
#pragma unroll
                    for (int e = 0; e < 4; ++e) { const int k = 4 * lane + 256 * j + e; const float xg = v[j][e] * g[e];
                        const f32x4 wa = *(const f32x4*)(win_l + (size_t)k * INC + 1536), wb = *(const f32x4*)(win_l + (size_t)k * INC + 1540);
                        f[0] += xg * wa[0]; f[1] += xg * wa[1]; f[2] += xg * wa[2]; f[3] += xg * wa[3]; f[4] += xg * wb[0]; f[5] += xg * wb[1]; f[6] += xg * wb[2]; f[7] += xg * wb[3]; } }
#pragma unroll
                for (int h = 0; h < 8; ++h) f[h] = wave_sum(f[h]);
                if (lane < 8) {
                    float z = 0.f;
#pragma unroll
                    for (int h = 0; h < 8; ++h) if (lane == h) z = f[h];
                    z = z * rs + bfg[lane];
                    const float lf = fminf(z, 0.f) - log1pf(__expf(-fabsf(z)));
                    if (row < NTP) lfP[(size_t)row * 8 + lane] = lf; else lfS[(size_t)(row - NTP) * 8 + lane] = lf;
                }
            }
        }
    }
}

constexpr int KPB = 144, VPB = 192, FL_V0 = 64 * KPB, FL_BUF = 64 * KPB + 64 * VPB, FL_BIAS = 2 * FL_BUF, FL_MISC = FL_BIAS + 2048 * 4;
__device__ __forceinline__ void flash_unit(LAS unsigned char* lds, const us* Q, int qp, const us* K, int kp, const us* V, int vp, us* O, int op, int ntiles, int band, bool use_bias) {
    const int tid = otid(), lane = tid & 63, wid = tid >> 6, r32 = lane & 31, hi = lane >> 5;
    bf16x8 qf[4];
#pragma unroll
    for (int d0 = 0; d0 < 4; ++d0) qf[d0] = *(const bf16x8*)(Q + (size_t)(wid * 32 + r32) * qp + d0 * 16 + hi * 8);
    const int srow = tid >> 3, sch = tid & 7;
    const us* kg = K + (size_t)srow * kp + sch * 8; const us* vg = V + (size_t)srow * vp + sch * 8;
    u32x4 kreg = *(const u32x4*)kg, vreg = *(const u32x4*)vg;
    *(LAS u32x4*)(lds + srow * KPB + sch * 16) = kreg; *(LAS u32x4*)(lds + FL_V0 + srow * VPB + sch * 16) = vreg;
    __syncthreads();
    f32x16 o0 = {}, o1 = {}; float mrun = -1e30f, lrun = 0.f;
    const int qrel = wid * 32 + r32;
    LAS const float* bias = (LAS const float*)(lds + FL_BIAS);
    for (int t = 0; t < ntiles; ++t) {
        const int cur = (t & 1) * FL_BUF, nxt = FL_BUF - cur;
        if (t + 1 < ntiles) { kreg = *(const u32x4*)(kg + (size_t)(t + 1) * 64 * kp); vreg = *(const u32x4*)(vg + (size_t)(t + 1) * 64 * vp); }
        const int jb = band ? t - (ntiles - band) : -1;
        const bool skip = (jb >= 0) && (64 * jb > wid * 32 + 31);
        if (!skip) {
            f32x16 p0 = {}, p1 = {};
            LAS const unsigned char* kb = lds + cur + r32 * KPB + hi * 16;
#pragma unroll
            for (int d0 = 0; d0 < 4; ++d0) {
                const bf16x8 a0 = *(LAS const bf16x8*)(kb + d0 * 32), a1 = *(LAS const bf16x8*)(kb + 32 * KPB + d0 * 32);
                p0 = MFMA32(a0, qf[d0], p0); p1 = MFMA32(a1, qf[d0], p1);
            }
            if (use_bias) {
                LAS const float* bp = bias + 64 * t + 4 * hi;
#pragma unroll
                for (int g = 0; g < 4; ++g) { const f32x4 b0 = *(LAS const f32x4*)(bp + 8 * g), b1 = *(LAS const f32x4*)(bp + 32 + 8 * g);
#pragma unroll
                    for (int i = 0; i < 4; ++i) { p0[4 * g + i] -= b0[i]; p1[4 * g + i] -= b1[i]; } }
            }
            if (jb >= 0) {
                const int qb4 = qrel - 64 * jb - 4 * hi; const int NEGB = __builtin_bit_cast(int, -1e30f);
#pragma unroll
                for (int r = 0; r < 16; ++r) { const int t0 = qb4 - ((r & 3) + 8 * (r >> 2)), m0 = t0 >> 31, m1 = (t0 - 32) >> 31;
                    const float x0 = p0[r], x1 = p1[r]; p0[r] = __int_as_float((__float_as_int(x0) & ~m0) | (NEGB & m0)); p1[r] = __int_as_float((__float_as_int(x1) & ~m1) | (NEGB & m1)); }
            }
            float mx = fmaxf(p0[0], p1[0]);
#pragma unroll
            for (int r = 1; r < 16; ++r) mx = fmaxf(mx, fmaxf(p0[r], p1[r]));
            mx = fmaxf(mx, __shfl_xor(mx, 32));
            const float mn = fmaxf(mrun, mx), alpha = __builtin_amdgcn_exp2f(mrun - mn); mrun = mn;
            lrun *= alpha; o0 = o0 * alpha; o1 = o1 * alpha;
            float ls = 0.f;
#pragma unroll
            for (int r = 0; r < 16; ++r) { p0[r] = __builtin_amdgcn_exp2f(p0[r] - mn); p1[r] = __builtin_amdgcn_exp2f(p1[r] - mn); ls += p0[r] + p1[r]; }
            lrun += ls;
            u32x4 pw[4];
#pragma unroll
            for (int s = 0; s < 2; ++s) {
                pw[s] = (u32x4){pg8::cvt_pk_bf16(p0[8 * s], p0[8 * s + 1]), pg8::cvt_pk_bf16(p0[8 * s + 2], p0[8 * s + 3]), pg8::cvt_pk_bf16(p0[8 * s + 4], p0[8 * s + 5]), pg8::cvt_pk_bf16(p0[8 * s + 6], p0[8 * s + 7])};
                pw[2 + s] = (u32x4){pg8::cvt_pk_bf16(p1[8 * s], p1[8 * s + 1]), pg8::cvt_pk_bf16(p1[8 * s + 2], p1[8 * s + 3]), pg8::cvt_pk_bf16(p1[8 * s + 4], p1[8 * s + 5]), pg8::cvt_pk_bf16(p1[8 * s + 6], p1[8 * s + 7])};
            }
            LAS const unsigned char* vb = lds + cur + FL_V0 + (4 * hi + ((lane & 15) >> 2)) * VPB + (((lane >> 4) & 1) * 16 + (lane & 3) * 4) * 2;
#pragma unroll
            for (int ks = 0; ks < 4; ++ks) {
                const s16x4 l0 = trr(vb + (16 * ks) * VPB), h0 = trr(vb + (16 * ks + 8) * VPB), l1 = trr(vb + (16 * ks) * VPB + 64), h1 = trr(vb + (16 * ks + 8) * VPB + 64);
                const bf16x8 a0 = (bf16x8){l0[0], l0[1], l0[2], l0[3], h0[0], h0[1], h0[2], h0[3]}, a1 = (bf16x8){l1[0], l1[1], l1[2], l1[3], h1[0], h1[1], h1[2], h1[3]};
                const bf16x8 pf = __builtin_bit_cast(bf16x8, pw[ks]);
                o0 = MFMA32(a0, pf, o0); o1 = MFMA32(a1, pf, o1);
            }
        }
        if (t + 1 < ntiles) { *(LAS u32x4*)(lds + nxt + srow * KPB + sch * 16) = kreg; *(LAS u32x4*)(lds + nxt + FL_V0 + srow * VPB + sch * 16) = vreg; }
        __syncthreads();
    }
    lrun += __shfl_xor(lrun, 32);
    const float inv = 1.f / lrun;
    us* orow = O + (size_t)(wid * 32 + r32) * op;
#pragma unroll
    for (int g = 0; g < 4; ++g) {
        const int d0 = 8 * g + 4 * hi;
        unsigned long long w0 = (unsigned long long)pk2(o0[4 * g] * inv, o0[4 * g + 1] * inv) | ((unsigned long long)pk2(o0[4 * g + 2] * inv, o0[4 * g + 3] * inv) << 32);
        unsigned long long w1 = (unsigned long long)pk2(o1[4 * g] * inv, o1[4 * g + 1] * inv) | ((unsigned long long)pk2(o1[4 * g + 2] * inv, o1[4 * g + 3] * inv) << 32);
        *(unsigned long long*)(orow + d0) = w0; *(unsigned long long*)(orow + 32 + d0) = w1;
    }
}
template <class F> __device__ __forceinline__ void block_cumsum(LAS float* dst, LAS float* wtot, int n, F f) {
    const int tid = otid(), lane = tid & 63, wid = tid >> 6;
    float a[4];
#pragma unroll
    for (int i = 0; i < 4; ++i) { const int j = 4 * tid + i; a[i] = (j < n) ? f(j) : 0.f; }
    const float s = (a[0] + a[1]) + (a[2] + a[3]);
    float sc = s;
#pragma unroll
    for (int o = 1; o < 64; o <<= 1) { const float t = __shfl_up(sc, o); if (lane >= o) sc += t; }
    if (lane == 63) wtot[wid] = sc;
    __syncthreads();
    float off = 0.f;
    for (int w = 0; w < wid; ++w) off += wtot[w];
    float c = off + sc - s;
#pragma unroll
    for (int i = 0; i < 4; ++i) { c += a[i]; const int j = 4 * tid + i; if (j < 2048) dst[j] = c * LOG2E; }
    __syncthreads();
}
constexpr int ZPB = 576, WPB = 272, SG_W = 128 * ZPB, SG_RS = SG_W + 128 * WPB;
__device__ __forceinline__ void sgu_unit(LAS unsigned char* lds, int R0, const us* ZB, const us* UB, us* CAT, const float* ws_l, const float* bs_l, const float* gs_l) {
    const int tid = otid(), lane = tid & 63, wid = tid >> 6, r32 = lane & 31, hi = lane >> 5;
#pragma unroll
    for (int i = 0; i < 8; ++i) { const int idx = tid + 512 * i, row = idx >> 5, ch = idx & 31; *(LAS u32x4*)(lds + row * ZPB + ch * 16) = *(const u32x4*)(ZB + (size_t)(R0 + row) * 256 + ch * 8); }
    __syncthreads();
    { const int row = tid >> 2, q = tid & 3; float ss = 0.f;
#pragma unroll
      for (int i = 0; i < 8; ++i) { const u32x4 w = *(LAS const u32x4*)(lds + row * ZPB + q * 128 + i * 16);
#pragma unroll
          for (int e = 0; e < 4; ++e) { const float a = bf2f(w[e] & 0xffffu), b = bf2f(w[e] >> 16); ss += a * a + b * b; } }
      ss += __shfl_xor(ss, 1); ss += __shfl_xor(ss, 2);
      if (q == 0) ((LAS float*)(lds + SG_RS))[row] = rsqrtf(ss * (1.f / 256.f) + EPS); }
    __syncthreads();
    LAS const float* rsz = (LAS const float*)(lds + SG_RS);
#pragma unroll 1
    for (int g = 0; g < 4; ++g) {
#pragma unroll
        for (int i = 0; i < 4; ++i) { const int idx = tid + 512 * i, row = idx >> 4, ch = idx & 15;
            const float* wp = ws_l + (size_t)g * 16384 + row * 128 + ch * 8; f32x4 a = *(const f32x4*)wp, b = *(const f32x4*)(wp + 4);
            const bool z = (ch >= 8) && (row < 64);
            u32x4 o;
            if (z) o = (u32x4){0u, 0u, 0u, 0u};
            else { const int j0 = ch * 8; o.x = pk2(a[0] * rsz[j0], a[1] * rsz[j0 + 1]); o.y = pk2(a[2] * rsz[j0 + 2], a[3] * rsz[j0 + 3]); o.z = pk2(b[0] * rsz[j0 + 4], b[1] * rsz[j0 + 5]); o.w = pk2(b[2] * rsz[j0 + 6], b[3] * rsz[j0 + 7]); }
            *(LAS u32x4*)(lds + SG_W + row * WPB + ch * 16) = o; }
        __syncthreads();
        const int ib = wid & 3, chh = wid >> 2, cbase = g * 64 + 32 * chh;
        f32x16 acc = {};
        LAS const unsigned char* ap = lds + SG_W + (32 * ib + r32) * WPB + hi * 16;
        LAS const unsigned char* bp = lds + (8 * hi + ((lane & 15) >> 2)) * ZPB + (cbase + 16 * ((lane >> 4) & 1) + 4 * (lane & 3)) * 2;
#pragma unroll
        for (int ks = 0; ks < 8; ++ks) {
            const bf16x8 a = *(LAS const bf16x8*)(ap + ks * 32);
            const s16x4 l0 = trr(bp + (16 * ks) * ZPB), h0 = trr(bp + (16 * ks + 4) * ZPB);
            const bf16x8 b = (bf16x8){l0[0], l0[1], l0[2], l0[3], h0[0], h0[1], h0[2], h0[3]};
            acc = MFMA32(a, b, acc);
        }
        const int c = cbase + r32; const float gs = gs_l[c];
#pragma unroll
        for (int r = 0; r < 16; ++r) { const int i = 32 * ib + (r & 3) + 8 * (r >> 2) + 4 * hi;
            const float mixed = gs * acc[r] + bs_l[g * 128 + i]; const float u = bf2f(UB[(size_t)(R0 + i) * 256 + c]);
            CAT[(size_t)(R0 + i) * DM + 512 + c] = (us)f2bf(u * mixed); }
        __syncthreads();
    }
}
__device__ __forceinline__ void sgu_sample_unit(LAS unsigned char* lds, int b, const us* ZB, const us* UB, us* CAT, const float* ws_l, const float* bs_l, const float* gs_l, float* outv) {
    const int tid = otid(), R0 = NTP + 16 * b;
    LAS float* z = (LAS float*)lds; LAS float* rsz = z + 16 * 256;
    for (int i = tid; i < 4096; i += 512) z[i] = bf2f(ZB[(size_t)R0 * 256 + i]);
    __syncthreads();
    { const int row = tid >> 5, q = tid & 31; float ss = 0.f;
      for (int i = 0; i < 8; ++i) { const float a = z[row * 256 + q + 32 * i]; ss += a * a; }
      ss += __shfl_xor(ss, 1); ss += __shfl_xor(ss, 2); ss += __shfl_xor(ss, 4); ss += __shfl_xor(ss, 8); ss += __shfl_xor(ss, 16);
      if (q == 0) rsz[row] = rsqrtf(ss * (1.f / 256.f) + EPS); }
    __syncthreads();
    for (int o = tid; o < 4096; o += 512) {
        const int i = o >> 8, c = o & 255, g = c >> 6; const float gs = gs_l[c];
        float acc = 0.f;
#pragma unroll
        for (int j = 0; j < 16; ++j) acc += ws_l[(size_t)g * 16384 + i * 128 + j] * rsz[j] * z[j * 256 + c];
        const float mixed = gs * acc + bs_l[g * 128 + i]; const float u = bf2f(UB[(size_t)(R0 + i) * 256 + c]);
        CAT[(size_t)(R0 + i) * DM + 512 + c] = (us)f2bf(u * mixed);
        outv[(size_t)(16 * b + i) * 256 + c] = z[i * 256 + c] * rsz[i] * gs;
    }
    __syncthreads();
}
constexpr int SA_SC = 4096, SA_NKMAX = 1056, SA_BIAS = SA_SC + SA_NKMAX * 17 * 4 + 896, SA_MISC = SA_BIAS + 2048 * 4, SA_RED = SA_MISC + 1024;
__device__ __forceinline__ void small_attn(LAS unsigned char* lds, const us* Q, int qp, const float* Kc, const float* Vc, int cp, int ncache, const float* Kn, const float* Vn, int np, int nnew,
                                           const float* lfc, const float* lfn, bool fox, us* O, int op) {
    const int tid = otid(), lane = tid & 63, wid = tid >> 6;
    const int nk = ncache + nnew, nkb = (nk + 15) >> 4;
    LAS float* SC = (LAS float*)(lds + SA_SC); LAS float* bias = (LAS float*)(lds + SA_BIAS); LAS float* misc = (LAS float*)(lds + SA_MISC); LAS float* red = (LAS float*)(lds + SA_RED);
    if (tid < 128) { const int row = tid >> 3, ch = tid & 7; *(LAS u32x4*)(lds + row * 144 + ch * 16) = *(const u32x4*)(Q + (size_t)row * qp + ch * 8); }
    if (fox) block_cumsum(bias, misc, nk, [&](int j) { return j < ncache ? lfc[(size_t)j * 8] : lfn[(size_t)(j - ncache) * 8]; });
    else __syncthreads();
    { const int kl = lane & 15, kq = lane >> 4;
#pragma unroll 3
      for (int kb = wid; kb < nkb; kb += 8) {
        const int key = kb * 16 + kl; const bool valid = key < nk; const int kk = valid ? key : 0;
        const float* src = (kk < ncache) ? Kc + (size_t)kk * cp : Kn + (size_t)(kk - ncache) * np;
        f32x4 acc = {0.f, 0.f, 0.f, 0.f};
#pragma unroll
        for (int s = 0; s < 2; ++s) {
            const f32x4 x0 = *(const f32x4*)(src + 32 * s + 8 * kq), x1 = *(const f32x4*)(src + 32 * s + 8 * kq + 4);
            const u32x4 bw = (u32x4){pk2(x0[0], x0[1]), pk2(x0[2], x0[3]), pk2(x1[0], x1[1]), pk2(x1[2], x1[3])};
            const bf16x8 a = *(LAS const bf16x8*)(lds + kl * 144 + (32 * s + 8 * kq) * 2);
            acc = MFMA16(a, __builtin_bit_cast(bf16x8, bw), acc);
        }
        const float bj = fox ? bias[key] : 0.f;
#pragma unroll
        for (int r = 0; r < 4; ++r) { const int qrow = 4 * kq + r; float sv = acc[r] - bj; if (!valid || (fox && key > ncache + qrow)) sv = -1e30f; SC[key * 17 + qrow] = sv; }
      } }
    __syncthreads();
#pragma unroll
    for (int rr = 0; rr < 2; ++rr) { const int row = 2 * wid + rr; float mx = -1e30f;
        for (int j = lane; j < nkb * 16; j += 64) mx = fmaxf(mx, SC[j * 17 + row]);
#pragma unroll
        for (int o = 1; o < 64; o <<= 1) mx = fmaxf(mx, __shfl_xor(mx, o));
        float sum = 0.f;
        for (int j = lane; j < nkb * 16; j += 64) { const float e = __builtin_amdgcn_exp2f(SC[j * 17 + row] - mx); SC[j * 17 + row] = e; sum += e; }
        sum = wave_sum(sum);
        if (lane == 0) misc[16 + row] = 1.f / sum; }
    __syncthreads();
    {
      const int d = lane, kpw = (nk + 7) >> 3, j0 = wid * kpw, j1 = min(nk, j0 + kpw), jc = min(j1, ncache);
      float acc[16];
#pragma unroll
      for (int i = 0; i < 16; ++i) acc[i] = 0.f;
#pragma unroll 8
      for (int j = j0; j < jc; ++j) { const float v = Vc[(size_t)j * cp + d]; LAS const float* pj = SC + j * 17;
#pragma unroll
          for (int i = 0; i < 16; ++i) acc[i] += pj[i] * v; }
      for (int j = max(j0, ncache); j < j1; ++j) { const float v = Vn[(size_t)(j - ncache) * np + d]; LAS const float* pj = SC + j * 17;
#pragma unroll
          for (int i = 0; i < 16; ++i) acc[i] += pj[i] * v; }
#pragma unroll
      for (int i = 0; i < 16; ++i) red[(wid * 16 + i) * 64 + d] = acc[i]; }
    __syncthreads();
    { const int d = lane, r0 = 2 * wid; float a0 = 0.f, a1 = 0.f;
#pragma unroll
      for (int w = 0; w < 8; ++w) { a0 += red[(w * 16 + r0) * 64 + d]; a1 += red[(w * 16 + r0 + 1) * 64 + d]; }
      O[(size_t)r0 * op + d] = (us)f2bf(a0 * misc[16 + r0]); O[(size_t)(r0 + 1) * op + d] = (us)f2bf(a1 * misc[17 + r0]); }
    __syncthreads();
}
#ifdef DBG_FOX
__device__ __forceinline__ void dbg_fox(const P& p, int l) {
    const us* QBp = (const us*)(WSB + WS_QB); const us* KBp = (const us*)(WSB + WS_KB); const us* VBp = (const us*)(WSB + WS_VB); us* CATp = (us*)(WSB + WS_CAT);
    const float* lf = OUTB + O_PLF + (size_t)l * NTP * 8;
    for (int id = blockIdx.x * 512 + otid(); id < 131072; id += gridDim.x * 512) {
        const int q = id & 2047, bh = id >> 11, b = bh >> 3, h = bh & 7;
        if ((FQM >> (q >> 8)) & 1) continue;
        float qv[64], o[64];
#pragma unroll
        for (int c8 = 0; c8 < 8; ++c8) { const u32x4 w = *(const u32x4*)(QBp + ((size_t)b * SEQ + q) * 512 + h * 64 + c8 * 8);
#pragma unroll
            for (int e = 0; e < 4; ++e) { qv[c8 * 8 + 2 * e] = bf2f(w[e] & 0xffffu); qv[c8 * 8 + 2 * e + 1] = bf2f(w[e] >> 16); } }
#pragma unroll
        for (int d = 0; d < 64; ++d) o[d] = 0.f;
        float m = -1e30f, ls = 0.f, c = 0.f;
        for (int j = 0; j <= q; ++j) {
            c += lf[((size_t)b * SEQ + j) * 8 + h] * LOG2E;
            const us* kr = KBp + ((size_t)b * SEQ + j) * 512 + h * 64; const us* vr = VBp + ((size_t)b * SEQ + j) * 512 + h * 64;
            float s = 0.f;
#pragma unroll
            for (int c8 = 0; c8 < 8; ++c8) { const u32x4 w = *(const u32x4*)(kr + c8 * 8);
#pragma unroll
                for (int e = 0; e < 4; ++e) { s += qv[c8 * 8 + 2 * e] * bf2f(w[e] & 0xffffu) + qv[c8 * 8 + 2 * e + 1] * bf2f(w[e] >> 16); } }
            s -= c;
            const float mn = fmaxf(m, s), al = __builtin_amdgcn_exp2f(m - mn), pj = __builtin_amdgcn_exp2f(s - mn); m = mn; ls = ls * al + pj;
#pragma unroll
            for (int c8 = 0; c8 < 8; ++c8) { const u32x4 w = *(const u32x4*)(vr + c8 * 8);
#pragma unroll
                for (int e = 0; e < 4; ++e) { o[c8 * 8 + 2 * e] = o[c8 * 8 + 2 * e] * al + pj * bf2f(w[e] & 0xffffu); o[c8 * 8 + 2 * e + 1] = o[c8 * 8 + 2 * e + 1] * al + pj * bf2f(w[e] >> 16); } }
        }
        const float inv = 1.f / ls;
#pragma unroll
        for (int c8 = 0; c8 < 8; ++c8) { u32x4 w;
#pragma unroll
            for (int e = 0; e < 4; ++e) w[e] = pk2(o[c8 * 8 + 2 * e] * inv, o[c8 * 8 + 2 * e + 1] * inv);
            *(u32x4*)(CATp + ((size_t)b * SEQ + q) * DM + h * 64 + c8 * 8) = w; }
    }
}
#endif
__device__ __forceinline__ void attn_phase(const P& p, LAS unsigned char* lds, int l) {
    const int G = gridDim.x, bx = blockIdx.x, vcu = (G % 8 == 0) ? (bx % 8) * (G / 8) + bx / 8 : bx;
#define A_QB ((const us*)(WSB + WS_QB))
#define A_KB ((const us*)(WSB + WS_KB))
#define A_VB ((const us*)(WSB + WS_VB))
#define A_UB ((const us*)(WSB + WS_UB))
#define A_ZB ((const us*)(WSB + WS_ZB))
#define A_QMB ((const us*)(WSB + WS_QMB))
#define A_MKV ((const us*)(WSB + WS_MKV) + (size_t)l * NMEMROWS * 512)
#define A_CAT ((us*)(WSB + WS_CAT))
#define A_WS (INP(12) + (size_t)l * 4 * 16384)
#define A_BS (INP(13) + (size_t)l * 512)
#define A_GS (INP(14) + (size_t)l * 256)
#ifdef DBG_FOX
    dbg_fox(p, l);
#endif
    for (int v = vcu; v < 256; v += G) {
        const int bh = v >> 2, s = v & 3, b = bh >> 3, h = bh & 7;
#pragma unroll 1
        for (int k = 0; k < 2; ++k) { const int qb = k ? 7 - s : s;
#ifdef DBG_FOX
            if (!((FQM >> qb) & 1)) continue;
#endif
            const float* lfP = OUTB + O_PLF + (size_t)l * NTP * 8 + (size_t)b * SEQ * 8 + h;
            block_cumsum((LAS float*)(lds + FL_BIAS), (LAS float*)(lds + FL_MISC), 256 * (qb + 1), [&](int j) { return lfP[(size_t)j * 8]; });
            flash_unit(lds, A_QB + ((size_t)b * SEQ + qb * 256) * 512 + h * 64, 512, A_KB + (size_t)b * SEQ * 512 + h * 64, 512, A_VB + (size_t)b * SEQ * 512 + h * 64, 512,
                       A_CAT + ((size_t)b * SEQ + qb * 256) * DM + h * 64, DM, 4 * (qb + 1), 4, true); }
    }
    for (int v = vcu; v < 256; v += G) { const int bh = v >> 3, qb = v & 7, b = bh >> 2, h = bh & 3; const us* mkv = A_MKV + (size_t)b * 256 * 512 + h * 64;
        flash_unit(lds, A_QMB + ((size_t)b * SEQ + qb * 256) * 256 + h * 64, 256, mkv, 512, mkv + 256, 512,
                   A_CAT + ((size_t)b * SEQ + qb * 256) * DM + 768 + h * 64, DM, 4, 0, false); }
    for (int v = G - 1 - vcu; v < 128; v += G) sgu_unit(lds, v * 128, A_ZB, A_UB, A_CAT, A_WS, A_BS, A_GS);
    for (int v = vcu; v < 128; v += G) { const int b = v >> 3, h = v & 7; const size_t co = ((size_t)(l * NBS + b) * PAST) * 512 + h * 64, no = ((size_t)l * NTS + 16 * b) * 512 + h * 64;
        small_attn(lds, A_QB + (size_t)(NTP + 16 * b) * 512 + h * 64, 512, INP(3) + co, INP(4) + co, 512, PAST, OUTB + O_SK + no, OUTB + O_SV + no, 512, 16,
                   INP(5) + ((size_t)(l * NBS + b) * PAST) * 8 + h, OUTB + O_SLF + (size_t)l * NTS * 8 + (size_t)(16 * b) * 8 + h, true, A_CAT + (size_t)(NTP + 16 * b) * DM + h * 64, DM); }
    for (int v = G - 1 - vcu; v < 64; v += G) { const int b = v >> 2, h = v & 3; const size_t co = ((size_t)(l * NBS + b) * 256) * 256 + h * 64;
        small_attn(lds, A_QMB + (size_t)(NTP + 16 * b) * 256 + h * 64, 256, INP(6) + co, INP(7) + co, 256, 256,
                   nullptr, nullptr, 0, 0, nullptr, nullptr, false, A_CAT + (size_t)(NTP + 16 * b) * DM + 768 + h * 64, DM); }
    for (int v = vcu - 128; v >= 0 && v < 16; v += G) sgu_sample_unit(lds, v, A_ZB, A_UB, A_CAT, A_WS, A_BS, A_GS, OUTB + O_SGV + (size_t)l * NTS * 256);
}
__device__ __forceinline__ void gnorm_phase(const P& p, int l) {
    const int tid_ = otid(), lane = tid_ & 63, wid = tid_ >> 6; us* CAT = (us*)(WSB + WS_CAT); const float* gg = INP(17) + (size_t)l * DM;
    for (int row = blockIdx.x * 8 + wid; row < NT; row += gridDim.x * 8) {
        u32x4* rp = (u32x4*)(CAT + (size_t)row * DM + 16 * lane); const u32x4 w0 = rp[0], w1 = rp[1];
        float v[16];
#pragma unroll
        for (int e = 0; e < 4; ++e) { v[2 * e] = bf2f(w0[e] & 0xffffu); v[2 * e + 1] = bf2f(w0[e] >> 16); v[8 + 2 * e] = bf2f(w1[e] & 0xffffu); v[8 + 2 * e + 1] = bf2f(w1[e] >> 16); }
        float ss = 0.f;
#pragma unroll
        for (int e = 0; e < 16; ++e) ss += v[e] * v[e];
        ss += __shfl_xor(ss, 1); ss += __shfl_xor(ss, 2); ss += __shfl_xor(ss, 4); ss += __shfl_xor(ss, 8);
        const float s16 = __shfl_xor(ss, 16); float wdt = 256.f; if (lane < 32) { ss += s16; wdt = 512.f; }
        const float r = rsqrtf(ss / wdt + EPS);
        const f32x4 g0 = *(const f32x4*)(gg + 16 * lane), g1 = *(const f32x4*)(gg + 16 * lane + 4), g2 = *(const f32x4*)(gg + 16 * lane + 8), g3 = *(const f32x4*)(gg + 16 * lane + 12);
        u32x4 o0, o1;
        o0.x = pk2(v[0] * r * g0[0], v[1] * r * g0[1]); o0.y = pk2(v[2] * r * g0[2], v[3] * r * g0[3]); o0.z = pk2(v[4] * r * g1[0], v[5] * r * g1[1]); o0.w = pk2(v[6] * r * g1[2], v[7] * r * g1[3]);
        o1.x = pk2(v[8] * r * g2[0], v[9] * r * g2[1]); o1.y = pk2(v[10] * r * g2[2], v[11] * r * g2[3]); o1.z = pk2(v[12] * r * g3[0], v[13] * r * g3[1]); o1.w = pk2(v[14] * r * g3[2], v[15] * r * g3[3]);
        rp[0] = o0; rp[1] = o1;
    }
}
__device__ __forceinline__ void fixup_phase(const P& p, int l) {
    const float* wdw = INP(22) + (size_t)l * 3 * FF; const float* bdw = INP(23) + (size_t)l * FF;
    const float* AF = (const float*)(WSB + WS_AF); const float* LF = (const float*)(WSB + WS_LF); const float* AL = (const float*)(WSB + WS_AL);
    const float* SA = (const float*)(WSB + WS_SA); const float* SL = (const float*)(WSB + WS_SL); us* G = (us*)(WSB + WS_G);
    const int gt = blockIdx.x * 512 + otid(), gn = gridDim.x * 512;
    for (int i = gt; i < 256 * 2 * FF; i += gn) { const int f = i % FF, sr = i / FF, rr = sr & 1, s = sr >> 1;
        const bool first = (s & 31) == 0;
        const float l0 = first ? 0.f : AL[((size_t)(s - 1) * 2) * FF + f], l1 = first ? 0.f : AL[((size_t)(s - 1) * 2 + 1) * FF + f];
        const float a2 = AF[(size_t)sr * FF + f], a1 = rr ? AF[((size_t)s * 2) * FF + f] : l1, a0 = rr ? l1 : l0;
        const float g = silu_f(bdw[f] + wdw[f] * a0 + wdw[FF + f] * a1 + wdw[2 * FF + f] * a2) * LF[(size_t)sr * FF + f];
        G[((size_t)s * 64 + rr) * FF + f] = (us)f2bf(g); }
    const float* hist = INP(8) + (size_t)l * NBS * 2 * FF;
    for (int i = gt; i < NTS * FF; i += gn) { const int f = i % FF, r = i / FF, b = r >> 4, t = r & 15;
        const float a2 = SA[(size_t)r * FF + f];
        const float a1 = (t >= 1) ? SA[(size_t)(r - 1) * FF + f] : hist[((size_t)b * 2 + 1) * FF + f];
        const float a0 = (t >= 2) ? SA[(size_t)(r - 2) * FF + f] : hist[((size_t)b * 2 + t) * FF + f];
        const float g = silu_f(bdw[f] + wdw[f] * a0 + wdw[FF + f] * a1 + wdw[2 * FF + f] * a2) * SL[(size_t)r * FF + f];
        G[((size_t)NTP + r) * FF + f] = (us)f2bf(g); }
    float* oc = OUTB + O_PCONV + (size_t)l * NBP * 2 * FF;
    for (int i = gt; i < NBP * 2 * FF; i += gn) { const int f = i % FF, br = i / FF, b = br >> 1, rr = br & 1; oc[i] = AL[((size_t)(32 * b + 31) * 2 + rr) * FF + f]; }
    float* os = OUTB + O_SCONV + (size_t)l * NBS * 2 * FF;
    for (int i = gt; i < NBS * 2 * FF; i += gn) { const int f = i % FF, br = i / FF, b = br >> 1, rr = br & 1; os[i] = SA[((size_t)b * 16 + 14 + rr) * FF + f]; }
}
__device__ __forceinline__ void small_gemm(LAS unsigned char* lds, const us* A  , const us* Bt, int K, us* Y, float* YSQ) {
    const int tid = otid(), lane = tid & 63, wid = tid >> 6, cg4 = wid & 3, kh = wid >> 2, rl = lane & 15, kq = lane >> 4;
    LAS float* xch = (LAS float*)lds;
    for (int it = blockIdx.x; it < 256; it += gridDim.x) {
        const int rb = it >> 4, cb = it & 15;
        const us* ap = A + (size_t)(rb * 16 + rl) * K + kh * (K / 2) + 8 * kq; const us* bp = Bt + (size_t)(cb * 64 + cg4 * 16 + rl) * K + kh * (K / 2) + 8 * kq;
        f32x4 acc = {0.f, 0.f, 0.f, 0.f};
#pragma unroll 4
        for (int k = 0; k < K / 2; k += 32) acc = MFMA16(*(const bf16x8*)(ap + k), *(const bf16x8*)(bp + k), acc);
        if (kh == 1) *(LAS f32x4*)(xch + (cg4 * 64 + lane) * 4) = acc;
        __syncthreads();
        if (kh == 0) {
            acc = acc + *(LAS const f32x4*)(xch + (cg4 * 64 + lane) * 4);
            const int col = cb * 64 + cg4 * 16 + rl;
#pragma unroll
            for (int r = 0; r < 4; ++r) { const int row = rb * 16 + 4 * kq + r; Y[(size_t)row * DM + col] = (us)f2bf(acc[r]);
                float ss = acc[r] * acc[r]; ss += __shfl_xor(ss, 1); ss += __shfl_xor(ss, 2); ss += __shfl_xor(ss, 4); ss += __shfl_xor(ss, 8);
                if (rl == 0) xch[1024 + cg4 * 16 + 4 * kq + r] = ss; }
        }
        __syncthreads();
        if (tid < 16) YSQ[(size_t)(rb * 16 + tid) * 16 + cb] = (xch[1024 + tid] + xch[1024 + 16 + tid]) + (xch[1024 + 32 + tid] + xch[1024 + 48 + tid]);
        __syncthreads();
    }
}
constexpr int LDS_BYTES = 147456;
constexpr int NPHASE = 19;
#define XB_TMO      128
#define XB_XCNT(j)  (256  + 64 * (j))
#define XB_XSUB(j)  (1280 + 64 * (j))
#define XB_XGEN(j)  (2304 + 64 * (j))
#define XB_TOP      3328
#define XB_TOPGEN   3392
#define XCD_BAR_WORDS 3456
#define XB_SPIN_CAP (1u << 18)

__device__ __forceinline__ unsigned xb_ld(unsigned* p)              { return __hip_atomic_load(p, __ATOMIC_RELAXED, __HIP_MEMORY_SCOPE_AGENT); }
__device__ __forceinline__ unsigned xb_add(unsigned* p, unsigned v) { return __hip_atomic_fetch_add(p, v, __ATOMIC_RELAXED, __HIP_MEMORY_SCOPE_AGENT); }
__device__ __forceinline__ unsigned xb_xcc_id() { return (unsigned)__builtin_amdgcn_s_getreg((3 << 11) | 20) & 0xFu; }
#define XB_SPIN(cond, bar) do { unsigned _sp = 0; while (cond) { __builtin_amdgcn_s_sleep(1); \
    if ((++_sp & 255u) == 0u) { if (xb_ld(&(bar)[XB_TMO])) break; if (_sp > XB_SPIN_CAP) { atomicAdd(&(bar)[XB_TMO], 1u); break; } } } } while (0)

struct XcdBarrier {
    unsigned* bar; unsigned x;
    volatile LAS unsigned* st;
};

__device__ __forceinline__ XcdBarrier xcd_barrier_post(unsigned* bar, volatile LAS unsigned* st) {
    XcdBarrier b; b.bar = bar; b.x = xb_xcc_id(); b.st = st;
    if (threadIdx.x == 0) (void)xb_add(&bar[XB_XCNT(b.x)], 1u);
    return b;
}
__device__ __forceinline__ void xcd_barrier_complete(unsigned* bar, unsigned x, unsigned& nloc, unsigned& nx) {
    const unsigned G = gridDim.x * gridDim.y * gridDim.z;
    unsigned sum, cnt, mine, sp = 0u;
    for (;;) {
        sum = 0u; cnt = 0u; mine = 0u;
#pragma unroll
        for (unsigned j = 0; j < 16; ++j) { const unsigned c = xb_ld(&bar[XB_XCNT(j)]); sum += c; cnt += (c > 0u) ? 1u : 0u; mine = (j == x) ? c : mine; }
        if (sum == G) break;
        __builtin_amdgcn_s_sleep(1);
        if ((++sp & 255u) == 0u) { if (xb_ld(&bar[XB_TMO])) break; if (sp > XB_SPIN_CAP) { atomicAdd(&bar[XB_TMO], 1u); break; } }
    }
    nloc = mine > 0u ? mine : 1u; nx = cnt > 0u ? cnt : 1u;
}

__device__ __forceinline__ void xcd_barrier(const XcdBarrier& b) {
    asm volatile("s_waitcnt vmcnt(0)" ::: "memory");
    __syncthreads();
    if (threadIdx.x == 0) {
        unsigned* bar = b.bar;
        __builtin_amdgcn_s_waitcnt(0);
        unsigned nloc = b.st[0], nx = b.st[1];
        if (nloc == 0u) { xcd_barrier_complete(bar, b.x, nloc, nx); b.st[0] = nloc; b.st[1] = nx; }
        const unsigned old = xb_add(&bar[XB_XSUB(b.x)], 1u);
        const unsigned gen = old / nloc;
        if (old + 1u == (gen + 1u) * nloc) {
            __builtin_amdgcn_fence(__ATOMIC_RELEASE, "agent");
            asm volatile("s_waitcnt vmcnt(0)" ::: "memory");
            const unsigned og = xb_add(&bar[XB_TOP], 1u);
            const unsigned tg = og / nx;
            if (og + 1u == (tg + 1u) * nx) xb_add(&bar[XB_TOPGEN], 1u);
            else XB_SPIN(xb_ld(&bar[XB_TOPGEN]) == tg, bar);
            __builtin_amdgcn_fence(__ATOMIC_ACQUIRE, "agent");
            xb_add(&bar[XB_XGEN(b.x)], 1u);
            asm volatile("s_waitcnt vmcnt(0)" ::: "memory");
        } else {
            XB_SPIN(xb_ld(&bar[XB_XGEN(b.x)]) == gen, bar);
            __builtin_amdgcn_fence(__ATOMIC_ACQUIRE, "agent");
            asm volatile("s_waitcnt vmcnt(0)" ::: "memory");
        }
    }
    __syncthreads();
}


__global__ void __launch_bounds__(512, 2) mega(P p) {
    extern __shared__ __attribute__((aligned(16))) unsigned char lds_raw[];
    LAS unsigned char* lds = (LAS unsigned char*)lds_raw;
    volatile LAS unsigned* xst = (volatile LAS unsigned*)(lds + LDS_BYTES - 16);
    if (threadIdx.x < 4) xst[threadIdx.x] = 0u;
    __syncthreads();
    if (p.coop) { cg::grid_group grid = cg::this_grid(); grid.sync();
        (void)xcd_barrier_post((unsigned*)(WSB + WS_CTL), xst); }
#define XB ((us*)(WSB + WS_XB))
#define RS ((float*)(WSB + WS_RS))
#define X (OUTB + O_Y)
#define Y ((us*)(WSB + WS_Y))
#define YSQ ((float*)(WSB + WS_YSQ))
    for (int ph = p.ph_lo; ph < p.ph_hi; ++ph) {
#ifdef RPT_MASK
      for (int rep = 0; rep < ((ph > 0 && ((RPT_MASK >> ((ph - 1) % 9)) & 1)) || (ph == 0 && (RPT_MASK & 0x200)) ? 2 : 1); ++rep) {
#else
      {
#endif
        if (ph == 0) {
            prep_phase(p, lds);
            row_pass<false, true, true>(INP(0), INP(1), NT, nullptr, nullptr, nullptr, nullptr, XB, RS, INP(10), INP(9), INP(11), OUTB + O_PLF, OUTB + O_SLF);
            row_pass<false, false, true>(INP(2), INP(2), NMEMROWS, nullptr, nullptr, nullptr, nullptr, (us*)(WSB + WS_MEMB), (float*)(WSB + WS_RSMEM), nullptr, nullptr, nullptr, nullptr, nullptr);
        } else {
            const int l = (ph - 1) / 9, s = (ph - 1) % 9;
            if (s == 0) {
                { pg8::Gemm g{XB, (const us*)(WSB + WS_WIN) + (size_t)l * NIN * DM, NT, NIN, DM}; pg8::StaticOrder S; S.init(NT, NIN, gridDim.x, blockIdx.x);
                  pg8::EpiIn E{0, l, WSB, OUTB};
                  pg8::gemm_phase<pg8::EpiIn, pg8::StaticOrder, true, true>(lds, g, S, E); }
                if (l == 0) {
#pragma unroll 1
                    for (int ll = 0; ll < 2; ++ll) {
                        pg8::Gemm g{(const us*)(WSB + WS_MEMB), (const us*)(WSB + WS_WMEM) + (size_t)ll * 512 * DM, NMEMROWS, 512, DM}; pg8::StaticOrder S; S.init(NMEMROWS, 512, gridDim.x, (blockIdx.x + 80 + 16 * ll) % gridDim.x);
                        pg8::EpiIn E{1, ll, WSB, OUTB};
                        pg8::gemm_phase<pg8::EpiIn, pg8::StaticOrder, true, true>(lds, g, S, E); }
                }
            } else if (s == 1) { attn_phase(p, lds, l);
            } else if (s == 2) { gnorm_phase(p, l);
            } else if (s == 3 || s == 7) {
                const us* A = (s == 3) ? (const us*)(WSB + WS_CAT) : (const us*)(WSB + WS_G); const int K = (s == 3) ? DM : FF;
                const us* Bt = (s == 3) ? (const us*)(WSB + WS_WOUT) + (size_t)l * DM * DM : (const us*)(WSB + WS_WDOWN) + (size_t)l * DM * FF;
                { pg8::Gemm g{A, Bt, NTP, DM, K}; pg8::StaticOrder S; S.init(NTP, DM, gridDim.x, blockIdx.x); pg8::EpiY E{WSB};
                  pg8::gemm_phase<pg8::EpiY, pg8::StaticOrder, true, true>(lds, g, S, E); }
                small_gemm(lds, A + (size_t)NTP * K, Bt, K, Y + (size_t)NTP * DM, YSQ + (size_t)NTP * 16);
            } else if (s == 4) {
                const float* xp = (l == 0) ? INP(0) : X; const float* xs = (l == 0) ? INP(1) : X + (size_t)NTP * DM;
                row_pass<true, false, true>(xp, xs, NT, X, Y, YSQ, INP(19) + (size_t)l * DM, XB, RS, nullptr, nullptr, nullptr, nullptr, nullptr);
            } else if (s == 5) {
                pg8::Gemm g{XB, (const us*)(WSB + WS_WUP) + (size_t)l * NUP * DM, NT, NUP, DM}; pg8::StaticOrder S; S.init(NT, NUP, gridDim.x, blockIdx.x);
                pg8::EpiUp E{WSB, INP(22) + (size_t)l * 3 * FF, INP(23) + (size_t)l * FF};
                pg8::gemm_phase<pg8::EpiUp, pg8::StaticOrder, true, true>(lds, g, S, E);
            } else if (s == 6) { fixup_phase(p, l);
            } else {
                if (l == 0) row_pass<true, true, true>(X, X + (size_t)NTP * DM, NT, X, Y, YSQ, INP(25), XB, RS, INP(10) + (size_t)DM * INC, INP(9) + DM, INP(11) + 8, OUTB + O_PLF + (size_t)NTP * 8, OUTB + O_SLF + (size_t)NTS * 8);
                else row_pass<true, false, false>(X, X + (size_t)NTP * DM, NT, X, Y, YSQ, INP(25) + DM, nullptr, nullptr, nullptr, nullptr, nullptr, nullptr, nullptr);
            }
        }
      }
        if (p.coop && ph + 1 < p.ph_hi) { XcdBarrier xb_; xb_.bar = (unsigned*)(WSB + WS_CTL); xb_.x = xb_xcc_id(); xb_.st = xst; xcd_barrier(xb_); }
    }
}

#undef XB
#undef RS
#undef X
#undef Y
#undef YSQ
extern "C" void kernel_launch(void* const* d_in, const int* in_sizes, int n_in, void* d_out, int out_size, void* d_ws, size_t ws_size, hipStream_t stream) {
    static int grid = 0;
    if (grid == 0) {
        if (n_in != 26 || out_size != (int)O_END || ws_size < WS_END) { fprintf(stderr, "kernel_launch: unexpected sizes n_in %d out %d ws %zu (need %zu)\n", n_in, out_size, ws_size, (size_t)WS_END); grid = -1; return; }
        int dev = 0, cus = 0, per_cu = 0;
        (void)hipGetDevice(&dev); (void)hipDeviceGetAttribute(&cus, hipDeviceAttributeMultiprocessorCount, dev);
        if (hipFuncSetAttribute((const void*)mega, hipFuncAttributeMaxDynamicSharedMemorySize, LDS_BYTES) != hipSuccess) { fprintf(stderr, "kernel_launch: hipFuncSetAttribute failed\n"); grid = -1; return; }
        (void)hipOccupancyMaxActiveBlocksPerMultiprocessor(&per_cu, (const void*)mega, 512, LDS_BYTES);
        (void)hipGetLastError();
        if (per_cu < 1) fprintf(stderr, "kernel_launch: occupancy query says %d blocks per CU\n", per_cu);
        grid = cus > 0 ? cus : 256;
    }
    if (grid < 0) return;
    if (hipMemsetAsync((char*)d_ws + WS_CTL, 0, 16384, stream) != hipSuccess) { fprintf(stderr, "kernel_launch: memset failed\n"); return; }
    P p{};
    for (int i = 0; i < 26; ++i) p.in[i] = (const float*)d_in[i];
    p.out = (float*)d_out; p.ws = (unsigned char*)d_ws; p.pad = 0;
#ifndef MK_MULTI
    p.ph_lo = 0; p.ph_hi = NPHASE; p.coop = 1;
    void* args[] = {&p};
    hipError_t e = hipLaunchCooperativeKernel((void*)mega, dim3(grid), dim3(512), args, LDS_BYTES, stream);
    if (e != hipSuccess) fprintf(stderr, "kernel_launch: cooperative launch failed: %s (grid %d)\n", hipGetErrorString(e), grid);
#else
    for (int ph = 0; ph < NPHASE; ++ph) { p.ph_lo = ph; p.ph_hi = ph + 1; p.coop = 0; hipLaunchKernelGGL(mega, dim3(grid), dim3(512), LDS_BYTES, stream, p); }
#endif
}
```

```cpp
#include <hip/hip_runtime.h>
#include <hip/hip_cooperative_groups.h>
#include <cstdio>
#include <cstdint>
namespace cg = cooperative_groups;
#define LAS __attribute__((address_space(3)))
typedef unsigned short us;
typedef float f32x16 __attribute__((ext_vector_type(16)));
typedef short s16x4 __attribute__((ext_vector_type(4)));

constexpr int DM = 1024, NTP = 16384, NTS = 256, NT = NTP + NTS, SEQ = 2048, NBP = 8, NBS = 16, PAST = 1024;
constexpr int INC = 2312, NIN = 2304, FF = 2816, NUP = 5632, NMEMROWS = 2048;
constexpr float LOG2E = 1.4426950408889634f, C2 = 0.125f * 1.4426950408889634f, EPS = 1e-6f;

constexpr size_t O_Y = 0, O_YS = 16777216, O_PK = 17039360, O_PV = 33816576, O_PLF = 50593792, O_PMK = 50855936, O_PMV = 51904512,
                 O_PCONV = 52953088, O_SK = 53043200, O_SV = 53305344, O_SLF = 53567488, O_SGV = 53571584, O_SCONV = 53702656, O_END = 53882880;
constexpr size_t MiB = 1u << 20;
constexpr size_t WS_WIN = 0;
constexpr size_t WS_WOUT = 10 * MiB;
constexpr size_t WS_WUP = 14 * MiB;
constexpr size_t WS_WDOWN = 36 * MiB;
constexpr size_t WS_WMEM = 47 * MiB;
constexpr size_t WS_XB = 49 * MiB;
constexpr size_t WS_MEMB = 82 * MiB;
constexpr size_t WS_MKV = 86 * MiB;
constexpr size_t WS_RS = 90 * MiB;
constexpr size_t WS_RSMEM = 90 * MiB + 128 * 1024;
constexpr size_t WS_YSQ = 91 * MiB;
constexpr size_t WS_AF = 93 * MiB;
constexpr size_t WS_LF = 99 * MiB;
constexpr size_t WS_AL = 105 * MiB;
constexpr size_t WS_SA = 111 * MiB;
constexpr size_t WS_SL = 114 * MiB;
constexpr size_t WS_Y = 117 * MiB;
constexpr size_t WS_ACT = 183 * MiB;
constexpr size_t WS_QB = WS_ACT;
constexpr size_t WS_KB = WS_ACT + 17 * MiB;
constexpr size_t WS_VB = WS_ACT + 34 * MiB;
constexpr size_t WS_UB = WS_ACT + 51 * MiB;
constexpr size_t WS_ZB = WS_ACT + 60 * MiB;
constexpr size_t WS_QMB = WS_ACT + 69 * MiB;
constexpr size_t WS_CAT = WS_ACT + 78 * MiB;
constexpr size_t WS_G = WS_ACT;
constexpr size_t WS_CTL = WS_ACT + 111 * MiB;
constexpr size_t WS_END = WS_ACT + 112 * MiB;

__device__ __forceinline__ unsigned f2bf(float f) { unsigned u = __builtin_bit_cast(unsigned, f); return (u + 0x7fffu + ((u >> 16) & 1u)) >> 16; }
__device__ __forceinline__ unsigned pk2(float lo, float hi) { return f2bf(lo) | (f2bf(hi) << 16); }
__device__ __forceinline__ float bf2f(unsigned h) { return __builtin_bit_cast(float, h << 16); }
__device__ __forceinline__ float gelu_tanh(float x) { const float y = 0.7978845608028654f * (x + 0.044715f * x * x * x); return x / (1.f + __expf(-2.f * y)); }
__device__ __forceinline__ float silu_f(float x) { return x / (1.f + __expf(-x)); }
__device__ __forceinline__ float wave_sum(float v) {
#pragma unroll
    for (int o = 1; o < 64; o <<= 1) v += __shfl_xor(v, o);
    return v;
}
__device__ __forceinline__ int opq0() { int z; asm volatile("s_mov_b32 %0, 0" : "=s"(z)); return z; }
__device__ __forceinline__ int otid() { int t = threadIdx.x; asm volatile("" : "+v"(t)); return t; }
namespace pg8 {
#define PG8_LAS __attribute__((address_space(3)))
typedef unsigned short bf16_t;
typedef short bf16x8 __attribute__((ext_vector_type(8)));
typedef float f32x4 __attribute__((ext_vector_type(4)));
typedef unsigned u32x4 __attribute__((ext_vector_type(4)));
constexpr int BM = 256, BK = 64, HALF = 128, HTB = HALF * BK * 2  , STAGE_BYTES = 8 * HTB, NXCD = 8, WGM = 8;

__host__ __device__ __forceinline__ int lds_byte(int r, int c) { const int st = (r >> 4) * 2 + (c >> 5), rr = r & 15, cc = c & 31, ob = rr * 64 + cc * 2; return st * 1024 + (ob ^ (((ob >> 9) & 1) << 5)); }
__host__ __device__ __forceinline__ void stage_rc(int b, int& R, int& C) { const int st = b / 1024, sb = b % 1024, swz = sb ^ (((sb >> 9) & 1) << 5); R = (st >> 1) * 16 + swz / 64; C = (st & 1) * 32 + (swz % 64) / 2; }
__host__ __device__ __forceinline__ int perm32(int rho) { const int n = rho >> 4, i = rho & 15; return 8 * (i >> 2) + 4 * n + (i & 3); }

struct Unit { int pm, pn; };
struct Gemm { const bf16_t* A; const bf16_t* Bt; int M, N, K; };

struct StaticOrder {
    int nM, nN, nwg, G, c;
    __host__ __device__ void init(int M, int N, int G_, int c_) { nM = M / BM; nN = N / BM; nwg = nM * nN; G = G_; c = c_; }
    __host__ __device__ bool next(int i, Unit& u) const {
        const long L = (long)i * G + c; if (L >= nwg) return false;
        int wgid = (int)L; { const int q = nwg / NXCD, r = nwg % NXCD, xcd = wgid % NXCD, off = wgid / NXCD; wgid = (xcd < r ? xcd * (q + 1) : r * (q + 1) + (xcd - r) * q) + off; }
        const int nig = WGM * nN, gid = wgid / nig, fm = gid * WGM, gsz = (nM - fm) < WGM ? (nM - fm) : WGM;
        u.pm = fm + ((wgid % nig) % gsz); u.pn = (wgid % nig) / gsz; return true;
    }
    __device__ __forceinline__ void a_ready(const Unit&) const {}
    __device__ __forceinline__ void done(const Unit&) const {}
};
__device__ __forceinline__ unsigned cvt_pk_bf16(float lo, float hi) { unsigned r; asm volatile("v_cvt_pk_bf16_f32 %0, %1, %2" : "=v"(r) : "v"(lo), "v"(hi)); return r; }
struct EpiIn {
    static constexpr bool PERM = true, AFTER_DRAIN = false;
    int mode, l; unsigned char* ws; float* out;
    __device__ __forceinline__ void operator()(const f32x4 (&acc)[2][2][4][2], const Unit& u, int wr, int wc, int fr_, int fq_) const {
        int fr = fr_, fq = fq_; asm volatile("" : "+v"(fr), "+v"(fq));
        const int pn = u.pn;
        const float* rs = (const float*)(ws + (mode == 0 ? WS_RS : WS_RSMEM));
        bf16_t* const QB = (bf16_t*)(ws + WS_QB); bf16_t* const KB = (bf16_t*)(ws + WS_KB); bf16_t* const VB = (bf16_t*)(ws + WS_VB); bf16_t* const UB = (bf16_t*)(ws + WS_UB);
        bf16_t* const ZB = (bf16_t*)(ws + WS_ZB); bf16_t* const QMB = (bf16_t*)(ws + WS_QMB); bf16_t* const MKV = (bf16_t*)(ws + WS_MKV) + (size_t)l * NMEMROWS * 512;
        float* const oKp = out + O_PK + (size_t)l * NTP * 512; float* const oVp = out + O_PV + (size_t)l * NTP * 512; float* const oKs = out + O_SK + (size_t)l * NTS * 512; float* const oVs = out + O_SV + (size_t)l * NTS * 512;
        float* const oMK = out + O_PMK + (size_t)l * NMEMROWS * 256; float* const oMV = out + O_PMV + (size_t)l * NMEMROWS * 256;
        bf16_t* bdst; int bp; int bc; float mult = 1.f; int act = 0; float* fP = nullptr; float* fS = nullptr; int fp_ = 0, fc = 0;
        if (mode == 0) {
            if (pn < 2) { bdst = QB; bp = 512; bc = pn * 256; mult = C2; }
            else if (pn < 4) { bdst = KB; bp = 512; bc = (pn - 2) * 256; fP = oKp; fS = oKs; fp_ = 512; fc = bc; }
            else if (pn < 6) { bdst = VB; bp = 512; bc = (pn - 4) * 256; fP = oVp; fS = oVs; fp_ = 512; fc = bc; }
            else if (pn == 6) { bdst = UB; bp = 256; bc = 0; act = 1; }
            else if (pn == 7) { bdst = ZB; bp = 256; bc = 0; act = 1; }
            else { bdst = QMB; bp = 256; bc = 0; mult = C2; }
        } else { bdst = MKV; bp = 512; bc = pn * 256; fP = pn ? oMV : oMK; fS = fP; fp_ = 256; fc = 0; }
#pragma unroll
        for (int ai = 0; ai < 2; ++ai)
#pragma unroll
            for (int m = 0; m < 4; ++m) {
                const int row = u.pm * BM + ai * HALF + wr * 64 + m * 16 + fr;
                const float s = rs[row] * mult;
                float* frow = nullptr;
                if (fP) frow = (mode == 0 && row >= NTP) ? fS + (size_t)(row - NTP) * fp_ + fc : fP + (size_t)row * fp_ + fc;
#pragma unroll
                for (int bj = 0; bj < 2; ++bj) {
                    const int lc = bj * HALF + wc * 32 + 8 * fq;
                    f32x4 v0 = acc[ai][bj][m][0] * s, v1 = acc[ai][bj][m][1] * s;
                    if (act) { v0 = (f32x4){gelu_tanh(v0[0]), gelu_tanh(v0[1]), gelu_tanh(v0[2]), gelu_tanh(v0[3])}; v1 = (f32x4){gelu_tanh(v1[0]), gelu_tanh(v1[1]), gelu_tanh(v1[2]), gelu_tanh(v1[3])}; }
                    if (frow) { *(f32x4*)(frow + lc) = v0; *(f32x4*)(frow + lc + 4) = v1; }
                    u32x4 w; w.x = cvt_pk_bf16(v0[0], v0[1]); w.y = cvt_pk_bf16(v0[2], v0[3]); w.z = cvt_pk_bf16(v1[0], v1[1]); w.w = cvt_pk_bf16(v1[2], v1[3]);
                    *(u32x4*)(bdst + (size_t)row * bp + bc + lc) = w;
                }
            }
    }
};
struct EpiY {
    static constexpr bool PERM = true, AFTER_DRAIN = false;
    unsigned char* ws;
    __device__ __forceinline__ void operator()(const f32x4 (&acc)[2][2][4][2], const Unit& u, int wr, int wc, int fr_, int fq_) const {
        int fr = fr_, fq = fq_; asm volatile("" : "+v"(fr), "+v"(fq));
        bf16_t* const Y = (bf16_t*)(ws + WS_Y); float* const YSQ = (float*)(ws + WS_YSQ);
#pragma unroll
        for (int ai = 0; ai < 2; ++ai)
#pragma unroll
            for (int m = 0; m < 4; ++m) {
                const int row = u.pm * BM + ai * HALF + wr * 64 + m * 16 + fr;
                float ss = 0.f;
#pragma unroll
                for (int bj = 0; bj < 2; ++bj) {
                    const int c = u.pn * BM + bj * HALF + wc * 32 + 8 * fq;
                    const f32x4 v0 = acc[ai][bj][m][0], v1 = acc[ai][bj][m][1];
                    u32x4 w; w.x = cvt_pk_bf16(v0[0], v0[1]); w.y = cvt_pk_bf16(v0[2], v0[3]); w.z = cvt_pk_bf16(v1[0], v1[1]); w.w = cvt_pk_bf16(v1[2], v1[3]);
                    *(u32x4*)(Y + (size_t)row * DM + c) = w;
                    ss += (v0[0] * v0[0] + v0[1] * v0[1]) + (v0[2] * v0[2] + v0[3] * v0[3]) + (v1[0] * v1[0] + v1[1] * v1[1]) + (v1[2] * v1[2] + v1[3] * v1[3]);
                }
                ss += __shfl_xor(ss, 16); ss += __shfl_xor(ss, 32);
                if (fq == 0) YSQ[(size_t)row * 16 + u.pn * 4 + wc] = ss;
            }
    }
};
struct EpiUp {
    static constexpr bool PERM = true, AFTER_DRAIN = false;
    unsigned char* ws; const float* wdw; const float* bdw;
    __device__ __forceinline__ void operator()(const f32x4 (&acc)[2][2][4][2], const Unit& u, int wr, int wc, int fr_, int fq_) const {
        int fr = fr_, fq = fq_; asm volatile("" : "+v"(fr), "+v"(fq));
        const int f0 = u.pn * 128 + wc * 32 + 8 * fq;
        const float* rs = (const float*)(ws + WS_RS); bf16_t* const G = (bf16_t*)(ws + WS_G);
        float* const AF = (float*)(ws + WS_AF); float* const LF = (float*)(ws + WS_LF); float* const AL = (float*)(ws + WS_AL); float* const SA = (float*)(ws + WS_SA); float* const SL = (float*)(ws + WS_SL);
        const int lane = fq * 16 + fr;
        if (u.pm == NTP / BM) {
#pragma unroll
            for (int ai = 0; ai < 2; ++ai)
#pragma unroll
                for (int m = 0; m < 4; ++m) {
                    const int lr = ai * HALF + wr * 64 + m * 16 + fr; const float s = rs[NTP + lr];
                    *(f32x4*)(SA + (size_t)lr * FF + f0) = acc[ai][0][m][0] * s; *(f32x4*)(SA + (size_t)lr * FF + f0 + 4) = acc[ai][0][m][1] * s;
                    *(f32x4*)(SL + (size_t)lr * FF + f0) = acc[ai][1][m][0] * s; *(f32x4*)(SL + (size_t)lr * FF + f0 + 4) = acc[ai][1][m][1] * s;
                }
            return;
        }
        const int src1 = (lane & 48) | ((fr - 1) & 15), src2 = (lane & 48) | ((fr - 2) & 15);
#pragma unroll
        for (int n = 0; n < 2; ++n) {
            const int fn = f0 + 4 * n;
            const f32x4 w0 = *(const f32x4*)(wdw + fn), w1 = *(const f32x4*)(wdw + FF + fn), w2 = *(const f32x4*)(wdw + 2 * FF + fn), bb = *(const f32x4*)(bdw + fn);
#pragma unroll
            for (int ai = 0; ai < 2; ++ai) {
                const int strip = u.pm * 4 + ai * 2 + wr;
                f32x4 ap = {0.f, 0.f, 0.f, 0.f};
#pragma unroll
                for (int m = 0; m < 4; ++m) {
                    const int row = u.pm * BM + ai * HALF + wr * 64 + m * 16 + fr; const float s = rs[row];
                    const f32x4 a = acc[ai][0][m][n] * s, li = acc[ai][1][m][n] * s; f32x4 gv;
#pragma unroll
                    for (int e = 0; e < 4; ++e) {
                        const float s1 = (fr == 15) ? ap[e] : a[e], s2 = (fr >= 14) ? ap[e] : a[e];
                        const float a1 = __shfl(s1, src1), a0 = __shfl(s2, src2);
                        gv[e] = silu_f(bb[e] + w0[e] * a0 + w1[e] * a1 + w2[e] * a[e]) * li[e];
                    }
                    if (m == 0 && fr < 2) {
                        *(f32x4*)(AF + ((size_t)strip * 2 + fr) * FF + fn) = a; *(f32x4*)(LF + ((size_t)strip * 2 + fr) * FF + fn) = li;
                    } else {
                        unsigned long long w = (unsigned long long)cvt_pk_bf16(gv[0], gv[1]) | ((unsigned long long)cvt_pk_bf16(gv[2], gv[3]) << 32);
                        *(unsigned long long*)(G + (size_t)row * FF + fn) = w;
                    }
                    if (m == 3 && fr >= 14) *(f32x4*)(AL + ((size_t)strip * 2 + (fr - 14)) * FF + fn) = a;
                    ap = a;
                    __builtin_amdgcn_sched_barrier(0);
                }
            }
        }
    }
};
template <class Epi, class Sched, bool ALIGN_EPI = false, bool SP2 = false>
__device__ __forceinline__ void gemm_phase(PG8_LAS unsigned char* lds, const Gemm g, const Sched& S, const Epi& E) {
    const int tid = otid(), wid = __builtin_amdgcn_readfirstlane(tid >> 6), lane = tid & 63, wr = wid >> 2, wc = wid & 3, fr = lane & 15, fq = lane >> 4;
    const int K = g.K, nt = K / BK;
    unsigned voffA[2], voffB[2];
#pragma unroll
    for (int i = 0; i < 2; ++i) { int R, C; stage_rc(tid * 16 + i * 8192, R, C); const int Rb = Epi::PERM ? ((R & ~31) + perm32(R & 31)) : R;
        voffA[i] = (unsigned)(R * K + C) * 2u; voffB[i] = (unsigned)(Rb * K + C) * 2u; }
    const size_t kstep = (size_t)(BK * 2);
    const size_t hstep = (size_t)HALF * K * 2;
    const size_t tstep = 2 * hstep;
    const unsigned ldsw = (unsigned)wid * 1024u;
    const int aoff = lds_byte(wr * 64 + fr, fq * 8), boff = lds_byte(wc * 32 + fr, fq * 8);
#define PG8_SA(b, h) (((b) * 2 + (h)) * HTB)
#define PG8_SB(b, h) ((4 + (b) * 2 + (h)) * HTB)
#define PG8_STAGE(bufoff, gbase, voff) do { _Pragma("unroll") for (int _i = 0; _i < 2; ++_i) \
        __builtin_amdgcn_global_load_lds((const unsigned*)((const char*)(gbase) + (voff)[_i]), (PG8_LAS unsigned*)(lds + (bufoff) + ldsw + _i * 8192), 16, 0, 0); } while (0)
#define PG8_LDA(dst, b, h) do { _Pragma("unroll") for (int m = 0; m < 4; ++m) _Pragma("unroll") for (int k = 0; k < 2; ++k) dst[m][k] = *(const PG8_LAS bf16x8*)(lds + PG8_SA(b, h) + aoff + m * 2048 + k * 1024); } while (0)
#define PG8_LDB(dst, b, h) do { _Pragma("unroll") for (int n = 0; n < 2; ++n) _Pragma("unroll") for (int k = 0; k < 2; ++k) dst[n][k] = *(const PG8_LAS bf16x8*)(lds + PG8_SB(b, h) + boff + n * 2048 + k * 1024); } while (0)
#define PG8_MMA(ai, bj, At, Bt) do { __builtin_amdgcn_s_setprio(1); _Pragma("unroll") for (int m = 0; m < 4; ++m) _Pragma("unroll") for (int n = 0; n < 2; ++n) _Pragma("unroll") for (int k = 0; k < 2; ++k) \
        acc[ai][bj][m][n] = __builtin_amdgcn_mfma_f32_16x16x32_bf16(Bt[n][k], At[m][k], acc[ai][bj][m][n], 0, 0, 0); __builtin_amdgcn_s_setprio(0); } while (0)
#define PG8_WAIT_V(n) asm volatile("s_waitcnt vmcnt(" #n ")" ::: "memory")
#define PG8_WAIT_L(n) asm volatile("s_waitcnt lgkmcnt(" #n ")" ::: "memory")
#define PG8_BAR __builtin_amdgcn_s_barrier()
#define PG8_SCHED __builtin_amdgcn_sched_barrier(0)
    Unit cur, nxt; int ui = 0;
    if (!S.next(0, cur)) return;
    f32x4 acc[2][2][4][2];
#pragma unroll
    for (int a = 0; a < 2; ++a)
#pragma unroll
        for (int b = 0; b < 2; ++b)
#pragma unroll
            for (int m = 0; m < 4; ++m)
#pragma unroll
                for (int n = 0; n < 2; ++n) acc[a][b][m][n] = (f32x4){0.f, 0.f, 0.f, 0.f};
    bf16x8 At[4][2], B0[2][2], B1[2][2];
    const char* cA = (const char*)g.A + (size_t)cur.pm * tstep; const char* cB = (const char*)g.Bt + (size_t)cur.pn * tstep;
    S.a_ready(cur);
    if constexpr (SP2) {
        PG8_STAGE(PG8_SB(0, 0), cB, voffB); PG8_STAGE(PG8_SB(0, 1), cB + hstep, voffB); PG8_STAGE(PG8_SA(0, 0), cA, voffA); PG8_STAGE(PG8_SA(0, 1), cA + hstep, voffA);
        if (wr == 1) PG8_BAR;
        PG8_WAIT_V(2); PG8_BAR;
        PG8_STAGE(PG8_SB(1, 0), cB + kstep, voffB); PG8_STAGE(PG8_SA(1, 0), cA + kstep, voffA); PG8_STAGE(PG8_SB(1, 1), cB + hstep + kstep, voffB);
        PG8_WAIT_V(6); PG8_BAR;
    } else {
        PG8_STAGE(PG8_SB(0, 0), cB, voffB); PG8_STAGE(PG8_SA(0, 0), cA, voffA); PG8_STAGE(PG8_SB(0, 1), cB + hstep, voffB); PG8_STAGE(PG8_SA(0, 1), cA + hstep, voffA);
        if (wr == 1) PG8_BAR;
        PG8_WAIT_V(4); PG8_BAR;
        PG8_STAGE(PG8_SB(1, 0), cB + kstep, voffB); PG8_STAGE(PG8_SA(1, 0), cA + kstep, voffA); PG8_STAGE(PG8_SB(1, 1), cB + hstep + kstep, voffB);
        PG8_WAIT_V(6); PG8_BAR;
    }
    for (;;) {
        const bool has_next = S.next(ui + 1, nxt);
        const char* nA = has_next ? (const char*)g.A + (size_t)nxt.pm * tstep : cA; const char* nB = has_next ? (const char*)g.Bt + (size_t)nxt.pn * tstep : cB;
        for (int t = 0; t < nt; t += 2) {
            const bool last = (t == nt - 2);
            const char* a1 = cA + (size_t)(t + 1) * kstep;
            const char* a2 = last ? nA : cA + (size_t)(t + 2) * kstep; const char* b2 = last ? nB : cB + (size_t)(t + 2) * kstep;
            const char* a3 = a2 + kstep; const char* b3 = b2 + kstep;
            if (last && has_next) S.a_ready(nxt);
            if constexpr (SP2) {
            PG8_LDB(B0, 0, 0); PG8_LDB(B1, 0, 1); PG8_SCHED; PG8_LDA(At, 0, 0); PG8_STAGE(PG8_SA(1, 1), a1 + hstep, voffA);
            PG8_WAIT_V(8); PG8_WAIT_L(0); PG8_BAR; PG8_MMA(0, 0, At, B0); PG8_MMA(0, 1, At, B1); PG8_BAR; PG8_SCHED;
            PG8_LDA(At, 0, 1); PG8_STAGE(PG8_SB(0, 0), b2, voffB); PG8_STAGE(PG8_SB(0, 1), b2 + hstep, voffB); PG8_STAGE(PG8_SA(0, 0), a2, voffA);
            PG8_WAIT_V(8); PG8_WAIT_L(0); PG8_BAR; PG8_MMA(1, 0, At, B0); PG8_MMA(1, 1, At, B1); PG8_BAR; PG8_SCHED;
            PG8_LDB(B0, 1, 0); PG8_LDB(B1, 1, 1); PG8_SCHED; PG8_LDA(At, 1, 0); PG8_STAGE(PG8_SA(0, 1), a2 + hstep, voffA);
            PG8_WAIT_V(8); PG8_WAIT_L(0); PG8_BAR; PG8_MMA(0, 0, At, B0); PG8_MMA(0, 1, At, B1); PG8_BAR; PG8_SCHED;
            PG8_LDA(At, 1, 1); PG8_STAGE(PG8_SB(1, 0), b3, voffB); PG8_STAGE(PG8_SB(1, 1), b3 + hstep, voffB); PG8_STAGE(PG8_SA(1, 0), a3, voffA);
            PG8_WAIT_V(8); PG8_WAIT_L(0); PG8_BAR; PG8_MMA(1, 0, At, B0); PG8_MMA(1, 1, At, B1); PG8_BAR; PG8_SCHED;
            } else {
            PG8_LDB(B0, 0, 0); PG8_SCHED; PG8_LDA(At, 0, 0); PG8_STAGE(PG8_SA(1, 1), a1 + hstep, voffA);
            PG8_WAIT_L(8); PG8_BAR; PG8_WAIT_L(0); PG8_MMA(0, 0, At, B0); PG8_BAR; PG8_SCHED;
            PG8_LDB(B1, 0, 1); PG8_STAGE(PG8_SB(0, 0), b2, voffB);
            PG8_BAR; PG8_WAIT_L(0); PG8_MMA(0, 1, At, B1); PG8_BAR;
            PG8_LDA(At, 0, 1); PG8_STAGE(PG8_SA(0, 0), a2, voffA);
            PG8_BAR; PG8_WAIT_L(0); PG8_MMA(1, 0, At, B0); PG8_BAR; PG8_SCHED;
            PG8_STAGE(PG8_SB(0, 1), b2 + hstep, voffB);
            PG8_WAIT_V(6); PG8_BAR; PG8_MMA(1, 1, At, B1); PG8_BAR;
            PG8_LDB(B0, 1, 0); PG8_SCHED; PG8_LDA(At, 1, 0); PG8_STAGE(PG8_SA(0, 1), a2 + hstep, voffA);
            PG8_WAIT_L(8); PG8_BAR; PG8_WAIT_L(0); PG8_MMA(0, 0, At, B0); PG8_BAR; PG8_SCHED;
            PG8_LDB(B1, 1, 1); PG8_STAGE(PG8_SB(1, 0), b3, voffB);
            PG8_BAR; PG8_WAIT_L(0); PG8_MMA(0, 1, At, B1); PG8_BAR;
            PG8_LDA(At, 1, 1); PG8_STAGE(PG8_SA(1, 0), a3, voffA);
            PG8_BAR; PG8_WAIT_L(0); PG8_MMA(1, 0, At, B0); PG8_BAR; PG8_SCHED;
            PG8_STAGE(PG8_SB(1, 1), b3 + hstep, voffB);
            PG8_WAIT_V(6); PG8_BAR; PG8_MMA(1, 1, At, B1); PG8_BAR;
            }
        }
        if constexpr (ALIGN_EPI) { if (wr == 0) PG8_BAR; }
        if constexpr (!Epi::AFTER_DRAIN) { E(acc, cur, wr, wc, fr, fq); S.done(cur); }
        if (!has_next) break;
#pragma unroll
        for (int a = 0; a < 2; ++a)
#pragma unroll
            for (int b = 0; b < 2; ++b)
#pragma unroll
                for (int m = 0; m < 4; ++m)
#pragma unroll
                    for (int n = 0; n < 2; ++n) acc[a][b][m][n] = (f32x4){0.f, 0.f, 0.f, 0.f};
        cur = nxt; cA = nA; cB = nB; ++ui;
        if constexpr (ALIGN_EPI) { if (wr == 1) PG8_BAR; }
    }
    PG8_WAIT_V(0);
    if constexpr (!ALIGN_EPI) { if (wr == 0) PG8_BAR; }
    PG8_BAR;
    if constexpr (Epi::AFTER_DRAIN) { E.fused(acc, cur, wr, wc, fr, fq, lds, wid, lane); S.done(cur); }
#undef PG8_SA
#undef PG8_SB
#undef PG8_STAGE
#undef PG8_LDA
#undef PG8_LDB
#undef PG8_MMA
#undef PG8_WAIT_V
#undef PG8_WAIT_L
#undef PG8_BAR
#undef PG8_SCHED
}
}
using pg8::bf16x8; using pg8::f32x4; using pg8::u32x4;
struct P {
    const float* in[26]; float* out; unsigned char* ws; int ph_lo, ph_hi, coop, pad;
};
#define INP(i) (p.in[(i) + opq0()])
#define WSB (p.ws + opq0())
#define OUTB (p.out + opq0())
#define MFMA32(a, b, c) __builtin_amdgcn_mfma_f32_32x32x16_bf16(a, b, c, 0, 0, 0)
#define MFMA16(a, b, c) __builtin_amdgcn_mfma_f32_16x16x32_bf16(a, b, c, 0, 0, 0)
typedef short v4i16_t __attribute__((ext_vector_type(4)));
__device__ __forceinline__ s16x4 trr(LAS const unsigned char* p) { return __builtin_bit_cast(s16x4, __builtin_amdgcn_ds_read_tr16_b64_v4i16((LAS v4i16_t*)p)); }

__device__ __forceinline__ void prep_tile(const float* src, int srcN, int K, const float* gain, us* dst, int kt, int n0dst, int n0src, LAS float* tile) {
    const int tid = otid();
#pragma unroll
    for (int i = 0; i < 8; ++i) { const int k = i * 8 + (tid >> 6), n = tid & 63; float v = src[(size_t)(kt * 64 + k) * srcN + n0src + n]; if (gain) v *= gain[kt * 64 + k]; tile[k * 65 + n] = v; }
    __syncthreads();
    const int n = tid >> 3, k8 = (tid & 7) * 8;
    u32x4 o; o.x = pk2(tile[(k8 + 0) * 65 + n], tile[(k8 + 1) * 65 + n]); o.y = pk2(tile[(k8 + 2) * 65 + n], tile[(k8 + 3) * 65 + n]);
    o.z = pk2(tile[(k8 + 4) * 65 + n], tile[(k8 + 5) * 65 + n]); o.w = pk2(tile[(k8 + 6) * 65 + n], tile[(k8 + 7) * 65 + n]);
    *(u32x4*)(dst + (size_t)(n0dst + n) * K + kt * 64 + k8) = o;
    __syncthreads();
}
__device__ __forceinline__ void prep_phase(const P& p, LAS unsigned char* lds) {
    LAS float* tile = (LAS float*)lds;
    constexpr int I_IN = 16 * 36, I_OUT = 16 * 16, I_UP = 16 * 88, I_DN = 44 * 16, I_MEM = 16 * 8, I_L = I_IN + I_OUT + I_UP + I_DN + I_MEM;
    for (int it = blockIdx.x; it < 2 * I_L; it += gridDim.x) {
        const int l = it / I_L; int r = it % I_L;
        if (r < I_IN) { const int kt = r / 36, nt = r % 36, nd = nt * 64; prep_tile(INP(10) + (size_t)l * DM * INC, INC, DM, INP(9) + l * DM, (us*)(WSB + WS_WIN) + (size_t)l * NIN * DM, kt, nd, nd < 1536 ? nd : nd + 8, tile); continue; } r -= I_IN;
        if (r < I_OUT) { const int kt = r / 16, nt = r % 16; prep_tile(INP(18) + (size_t)l * DM * DM, DM, DM, nullptr, (us*)(WSB + WS_WOUT) + (size_t)l * DM * DM, kt, nt * 64, nt * 64, tile); continue; } r -= I_OUT;
        if (r < I_UP) { const int kt = r / 88, nt = r % 88, nd = nt * 64, j = nd >> 8, w = nd & 255; prep_tile(INP(21) + (size_t)l * DM * NUP, NUP, DM, INP(20) + l * DM, (us*)(WSB + WS_WUP) + (size_t)l * NUP * DM, kt, nd, (w >> 7) * FF + 128 * j + (w & 127), tile); continue; } r -= I_UP;
        if (r < I_DN) { const int kt = r / 16, nt = r % 16; prep_tile(INP(24) + (size_t)l * FF * DM, DM, FF, nullptr, (us*)(WSB + WS_WDOWN) + (size_t)l * DM * FF, kt, nt * 64, nt * 64, tile); continue; } r -= I_DN;
        { const int kt = r / 8, nt = r % 8; prep_tile(INP(16) + (size_t)l * DM * 512, 512, DM, INP(15) + l * DM, (us*)(WSB + WS_WMEM) + (size_t)l * 512 * DM, kt, nt * 64, nt * 64, tile); }
    }
}

template <bool HAS_Y, bool DO_FG, bool WRITE_B>
__device__ __forceinline__ void row_pass(const float* xP, const float* xS, int nrows, float* xdst, const us* Y, const float* YSQ, const float* gpost,
                                         us* XB, float* RS, const float* win_l, const float* gpre, const float* bfg, float* lfP, float* lfS, LAS float* wfg) {
    const int tid_ = otid(), lane = tid_ & 63, wid = tid_ >> 6;
    if (DO_FG) {
        __syncthreads();
#pragma unroll
        for (int i = 0; i < 2; ++i) { const int k = tid_ + 512 * i; const float g = gpre[k];
            const f32x4 wa = *(const f32x4*)(win_l + (size_t)k * INC + 1536), wb = *(const f32x4*)(win_l + (size_t)k * INC + 1540);
            wfg[0 * 1028 + k] = g * wa[0]; wfg[1 * 1028 + k] = g * wa[1]; wfg[2 * 1028 + k] = g * wa[2]; wfg[3 * 1028 + k] = g * wa[3];
            wfg[4 * 1028 + k] = g * wb[0]; wfg[5 * 1028 + k] = g * wb[1]; wfg[6 * 1028 + k] = g * wb[2]; wfg[7 * 1028 + k] = g * wb[3]; }
        __syncthreads();
    }
    for (int row = blockIdx.x * 8 + wid; row < nrows; row += gridDim.x * 8) {
        const float* xr = (row < NTP) ? xP + (size_t)row * DM : xS + (size_t)(row - NTP) * DM;
        f32x4 v[4];
#pragma unroll
        for (int j = 0; j < 4; ++j) v[j] = *(const f32x4*)(xr + 4 * lane + 256 * j);
        if (HAS_Y) {
            const f32x4* q = (const f32x4*)(YSQ + (size_t)row * 16); const f32x4 a = q[0], b = q[1], c = q[2], d = q[3];
            const float ss = ((a[0] + a[1]) + (a[2] + a[3])) + ((b[0] + b[1]) + (b[2] + b[3])) + ((c[0] + c[1]) + (c[2] + c[3])) + ((d[0] + d[1]) + (d[2] + d[3]));
            const float ry = rsqrtf(ss * (1.f / DM) + EPS);
#pragma unroll
            for (int j = 0; j < 4; ++j) { const unsigned long long yw = *(const unsigned long long*)(Y + (size_t)row * DM + 4 * lane + 256 * j);
                const f32x4 y = {bf2f((unsigned)yw & 0xffffu), bf2f(((unsigned)yw) >> 16), bf2f((unsigned)(yw >> 32) & 0xffffu), bf2f((unsigned)(yw >> 48))}; const f32x4 g = *(const f32x4*)(gpost + 4 * lane + 256 * j); v[j] = v[j] + y * ry * g; }
        }
        if (xdst) {
#pragma unroll
            for (int j = 0; j < 4; ++j) *(f32x4*)(xdst + (size_t)row * DM + 4 * lane + 256 * j) = v[j];
        }
        if (WRITE_B) {
            float s = 0.f;
#pragma unroll
            for (int j = 0; j < 4; ++j) s += (v[j][0] * v[j][0] + v[j][1] * v[j][1]) + (v[j][2] * v[j][2] + v[j][3] * v[j][3]);
            const float rs = rsqrtf(wave_sum(s) * (1.f / DM) + EPS);
            if (lane == 0) RS[row] = rs;
#pragma unroll
            for (int j = 0; j < 4; ++j) { unsigned long long o = (unsigned long long)pk2(v[j][0], v[j][1]) | ((unsigned long long)pk2(v[j][2], v[j][3]) << 32); *(unsigned long long*)(XB + (size_t)row * DM + 4 * lane + 256 * j) = o; }
            if (DO_FG) {
                float f[8];
#pragma unroll
                for (int h = 0; h < 8; ++h) { f[h] = 0.f;
#pragma unroll
                    for (int j = 0; j < 4; ++j) { const f32x4 w = *(LAS const f32x4*)(wfg + h * 1028 + 4 * lane + 256 * j); f[h] += (v[j][0] * w[0] + v[j][1] * w[1]) + (v[j][2] * w[2] + v[j][3] * w[3]); } }
#pragma unroll
                for (int h = 0; h < 8; ++h) f[h] = wave_sum(f[h]);
                if (lane < 8) {
                    float z = 0.f;
#pragma unroll
                    for (int h = 0; h < 8; ++h) if (lane == h) z = f[h];
                    z = z * rs + bfg[lane];
                    const float lf = fminf(z, 0.f) - log1pf(__expf(-fabsf(z)));
                    if (row < NTP) lfP[(size_t)row * 8 + lane] = lf; else lfS[(size_t)(row - NTP) * 8 + lane] = lf;
                }
            }
        }
    }
}

constexpr int KPB = 144, VPB = 192, FL_V0 = 64 * KPB, FL_BUF = 64 * KPB + 64 * VPB, FL_BIAS = 2 * FL_BUF, FL_MISC = FL_BIAS + 2048 * 4;
__device__ __forceinline__ void flash_unit(LAS unsigned char* lds, const us* Q, int qp, const us* K, int kp, const us* V, int vp, us* O, int op, int ntiles, int band, bool use_bias) {
    const int tid = otid(), lane = tid & 63, wid = tid >> 6, r32 = lane & 31, hi = lane >> 5;
    bf16x8 qf[4];
#pragma unroll
    for (int d0 = 0; d0 < 4; ++d0) qf[d0] = *(const bf16x8*)(Q + (size_t)(wid * 32 + r32) * qp + d0 * 16 + hi * 8);
    const int srow = tid >> 3, sch = tid & 7;
    const us* kg = K + (size_t)srow * kp + sch * 8; const us* vg = V + (size_t)srow * vp + sch * 8;
    u32x4 kreg = *(const u32x4*)kg, vreg = *(const u32x4*)vg;
    *(LAS u32x4*)(lds + srow * KPB + sch * 16) = kreg; *(LAS u32x4*)(lds + FL_V0 + srow * VPB + sch * 16) = vreg;
    __syncthreads();
    f32x16 o0 = {}, o1 = {}; float mrun = -1e30f, lrun = 0.f;
    const int qrel = wid * 32 + r32;
    LAS const float* bias = (LAS const float*)(lds + FL_BIAS);
    for (int t = 0; t < ntiles; ++t) {
        const int cur = (t & 1) * FL_BUF, nxt = FL_BUF - cur;
        if (t + 1 < ntiles) { kreg = *(const u32x4*)(kg + (size_t)(t + 1) * 64 * kp); vreg = *(const u32x4*)(vg + (size_t)(t + 1) * 64 * vp); }
        const int jb = band ? t - (ntiles - band) : -1;
        const bool skip = (jb >= 0) && (64 * jb > wid * 32 + 31);
        if (!skip) {
            f32x16 p0 = {}, p1 = {};
            if (use_bias) {
                LAS const float* bp = bias + 64 * t + 4 * hi;
#pragma unroll
                for (int g = 0; g < 4; ++g) { const f32x4 b0 = *(LAS const f32x4*)(bp + 8 * g), b1 = *(LAS const f32x4*)(bp + 32 + 8 * g);
#pragma unroll
                    for (int i = 0; i < 4; ++i) { p0[4 * g + i] = b0[i]; p1[4 * g + i] = b1[i]; } }
            }
            LAS const unsigned char* kb = lds + cur + r32 * KPB + hi * 16;
#pragma unroll
            for (int d0 = 0; d0 < 4; ++d0) {
                const bf16x8 a0 = *(LAS const bf16x8*)(kb + d0 * 32), a1 = *(LAS const bf16x8*)(kb + 32 * KPB + d0 * 32);
                p0 = MFMA32(a0, qf[d0], p0); p1 = MFMA32(a1, qf[d0], p1);
            }
            if (jb >= 0) {
                const int qb4 = qrel - 64 * jb - 4 * hi; const int NEGB = __builtin_bit_cast(int, -1e30f);
#pragma unroll
                for (int r = 0; r < 16; ++r) { const int t0 = qb4 - ((r & 3) + 8 * (r >> 2)), m0 = t0 >> 31, m1 = (t0 - 32) >> 31;
                    const float x0 = p0[r], x1 = p1[r]; p0[r] = __int_as_float((__float_as_int(x0) & ~m0) | (NEGB & m0)); p1[r] = __int_as_float((__float_as_int(x1) & ~m1) | (NEGB & m1)); }
            }
            float mx = fmaxf(p0[0], p1[0]);
#pragma unroll
            for (int r = 1; r < 16; ++r) mx = fmaxf(mx, fmaxf(p0[r], p1[r]));
            mx = fmaxf(mx, __shfl_xor(mx, 32));
            const float mn = fmaxf(mrun, mx), alpha = __builtin_amdgcn_exp2f(mrun - mn); mrun = mn;
            lrun *= alpha; o0 = o0 * alpha; o1 = o1 * alpha;
            float ls = 0.f;
#pragma unroll
            for (int r = 0; r < 16; ++r) { p0[r] = __builtin_amdgcn_exp2f(p0[r] - mn); p1[r] = __builtin_amdgcn_exp2f(p1[r] - mn); ls += p0[r] + p1[r]; }
            lrun += ls;
            u32x4 pw[4];
#pragma unroll
            for (int s = 0; s < 2; ++s) {
                pw[s] = (u32x4){pg8::cvt_pk_bf16(p0[8 * s], p0[8 * s + 1]), pg8::cvt_pk_bf16(p0[8 * s + 2], p0[8 * s + 3]), pg8::cvt_pk_bf16(p0[8 * s + 4], p0[8 * s + 5]), pg8::cvt_pk_bf16(p0[8 * s + 6], p0[8 * s + 7])};
                pw[2 + s] = (u32x4){pg8::cvt_pk_bf16(p1[8 * s], p1[8 * s + 1]), pg8::cvt_pk_bf16(p1[8 * s + 2], p1[8 * s + 3]), pg8::cvt_pk_bf16(p1[8 * s + 4], p1[8 * s + 5]), pg8::cvt_pk_bf16(p1[8 * s + 6], p1[8 * s + 7])};
            }
            LAS const unsigned char* vb = lds + cur + FL_V0 + (4 * hi + ((lane & 15) >> 2)) * VPB + (((lane >> 4) & 1) * 16 + (lane & 3) * 4) * 2;
#pragma unroll
            for (int ks = 0; ks < 4; ++ks) {
                const s16x4 l0 = trr(vb + (16 * ks) * VPB), h0 = trr(vb + (16 * ks + 8) * VPB), l1 = trr(vb + (16 * ks) * VPB + 64), h1 = trr(vb + (16 * ks + 8) * VPB + 64);
                const bf16x8 a0 = (bf16x8){l0[0], l0[1], l0[2], l0[3], h0[0], h0[1], h0[2], h0[3]}, a1 = (bf16x8){l1[0], l1[1], l1[2], l1[3], h1[0], h1[1], h1[2], h1[3]};
                const bf16x8 pf = __builtin_bit_cast(bf16x8, pw[ks]);
                o0 = MFMA32(a0, pf, o0); o1 = MFMA32(a1, pf, o1);
            }
        }
        if (t + 1 < ntiles) { *(LAS u32x4*)(lds + nxt + srow * KPB + sch * 16) = kreg; *(LAS u32x4*)(lds + nxt + FL_V0 + srow * VPB + sch * 16) = vreg; }
        __syncthreads();
    }
    lrun += __shfl_xor(lrun, 32);
    const float inv = 1.f / lrun;
    us* orow = O + (size_t)(wid * 32 + r32) * op;
#pragma unroll
    for (int g = 0; g < 4; ++g) {
        const int d0 = 8 * g + 4 * hi;
        unsigned long long w0 = (unsigned long long)pk2(o0[4 * g] * inv, o0[4 * g + 1] * inv) | ((unsigned long long)pk2(o0[4 * g + 2] * inv, o0[4 * g + 3] * inv) << 32);
        unsigned long long w1 = (unsigned long long)pk2(o1[4 * g] * inv, o1[4 * g + 1] * inv) | ((unsigned long long)pk2(o1[4 * g + 2] * inv, o1[4 * g + 3] * inv) << 32);
        *(unsigned long long*)(orow + d0) = w0; *(unsigned long long*)(orow + 32 + d0) = w1;
    }
}
template <class F> __device__ __forceinline__ void block_cumsum(LAS float* dst, LAS float* wtot, int n, F f) {
    const int tid = otid(), lane = tid & 63, wid = tid >> 6;
    float a[4];
#pragma unroll
    for (int i = 0; i < 4; ++i) { const int j = 4 * tid + i; a[i] = (j < n) ? f(j) : 0.f; }
    const float s = (a[0] + a[1]) + (a[2] + a[3]);
    float sc = s;
#pragma unroll
    for (int o = 1; o < 64; o <<= 1) { const float t = __shfl_up(sc, o); if (lane >= o) sc += t; }
    if (lane == 63) wtot[wid] = sc;
    __syncthreads();
    float off = 0.f;
    for (int w = 0; w < wid; ++w) off += wtot[w];
    float c = off + sc - s;
#pragma unroll
    for (int i = 0; i < 4; ++i) { c += a[i]; const int j = 4 * tid + i; if (j < 2048) dst[j] = -c * LOG2E; }
    __syncthreads();
}
constexpr int ZPB = 576, WPB = 272, SG_W = 128 * ZPB, SG_RS = SG_W + 128 * WPB;
__device__ __forceinline__ void sgu_unit(LAS unsigned char* lds, int R0, const us* ZB, const us* UB, us* CAT, const float* ws_l, const float* bs_l, const float* gs_l) {
    const int tid = otid(), lane = tid & 63, wid = tid >> 6, r32 = lane & 31, hi = lane >> 5;
#pragma unroll
    for (int i = 0; i < 8; ++i) { const int idx = tid + 512 * i, row = idx >> 5, ch = idx & 31; *(LAS u32x4*)(lds + row * ZPB + ch * 16) = *(const u32x4*)(ZB + (size_t)(R0 + row) * 256 + ch * 8); }
    __syncthreads();
    { const int row = tid >> 2, q = tid & 3; float ss = 0.f;
#pragma unroll
      for (int i = 0; i < 8; ++i) { const u32x4 w = *(LAS const u32x4*)(lds + row * ZPB + q * 128 + i * 16);
#pragma unroll
          for (int e = 0; e < 4; ++e) { const float a = bf2f(w[e] & 0xffffu), b = bf2f(w[e] >> 16); ss += a * a + b * b; } }
      ss += __shfl_xor(ss, 1); ss += __shfl_xor(ss, 2);
      if (q == 0) ((LAS float*)(lds + SG_RS))[row] = rsqrtf(ss * (1.f / 256.f) + EPS); }
    __syncthreads();
    LAS const float* rsz = (LAS const float*)(lds + SG_RS);
#pragma unroll 1
    for (int g = 0; g < 4; ++g) {
#pragma unroll
        for (int i = 0; i < 4; ++i) { const int idx = tid + 512 * i, row = idx >> 4, ch = idx & 15;
            const float* wp = ws_l + (size_t)g * 16384 + row * 128 + ch * 8; f32x4 a = *(const f32x4*)wp, b = *(const f32x4*)(wp + 4);
            const bool z = (ch >= 8) && (row < 64);
            u32x4 o;
            if (z) o = (u32x4){0u, 0u, 0u, 0u};
            else { const int j0 = ch * 8; o.x = pk2(a[0] * rsz[j0], a[1] * rsz[j0 + 1]); o.y = pk2(a[2] * rsz[j0 + 2], a[3] * rsz[j0 + 3]); o.z = pk2(b[0] * rsz[j0 + 4], b[1] * rsz[j0 + 5]); o.w = pk2(b[2] * rsz[j0 + 6], b[3] * rsz[j0 + 7]); }
            *(LAS u32x4*)(lds + SG_W + row * WPB + ch * 16) = o; }
        __syncthreads();
        const int ib = wid & 3, chh = wid >> 2, cbase = g * 64 + 32 * chh;
        f32x16 acc = {};
        LAS const unsigned char* ap = lds + SG_W + (32 * ib + r32) * WPB + hi * 16;
        LAS const unsigned char* bp = lds + (8 * hi + ((lane & 15) >> 2)) * ZPB + (cbase + 16 * ((lane >> 4) & 1) + 4 * (lane & 3)) * 2;
#pragma unroll
        for (int ks = 0; ks < 8; ++ks) {
            const bf16x8 a = *(LAS const bf16x8*)(ap + ks * 32);
            const s16x4 l0 = trr(bp + (16 * ks) * ZPB), h0 = trr(bp + (16 * ks + 4) * ZPB);
            const bf16x8 b = (bf16x8){l0[0], l0[1], l0[2], l0[3], h0[0], h0[1], h0[2], h0[3]};
            acc = MFMA32(a, b, acc);
        }
        const int c = cbase + r32; const float gs = gs_l[c];
#pragma unroll
        for (int r = 0; r < 16; ++r) { const int i = 32 * ib + (r & 3) + 8 * (r >> 2) + 4 * hi;
            const float mixed = gs * acc[r] + bs_l[g * 128 + i]; const float u = bf2f(UB[(size_t)(R0 + i) * 256 + c]);
            CAT[(size_t)(R0 + i) * DM + 512 + c] = (us)f2bf(u * mixed); }
        __syncthreads();
    }
}
__device__ __forceinline__ void sgu_sample_unit(LAS unsigned char* lds, int b, const us* ZB, const us* UB, us* CAT, const float* ws_l, const float* bs_l, const float* gs_l, float* outv) {
    const int tid = otid(), R0 = NTP + 16 * b;
    LAS float* z = (LAS float*)lds; LAS float* rsz = z + 16 * 256;
    for (int i = tid; i < 4096; i += 512) z[i] = bf2f(ZB[(size_t)R0 * 256 + i]);
    __syncthreads();
    { const int row = tid >> 5, q = tid & 31; float ss = 0.f;
      for (int i = 0; i < 8; ++i) { const float a = z[row * 256 + q + 32 * i]; ss += a * a; }
      ss += __shfl_xor(ss, 1); ss += __shfl_xor(ss, 2); ss += __shfl_xor(ss, 4); ss += __shfl_xor(ss, 8); ss += __shfl_xor(ss, 16);
      if (q == 0) rsz[row] = rsqrtf(ss * (1.f / 256.f) + EPS); }
    __syncthreads();
    for (int o = tid; o < 4096; o += 512) {
        const int i = o >> 8, c = o & 255, g = c >> 6; const float gs = gs_l[c];
        float acc = 0.f;
#pragma unroll
        for (int j = 0; j < 16; ++j) acc += ws_l[(size_t)g * 16384 + i * 128 + j] * rsz[j] * z[j * 256 + c];
        const float mixed = gs * acc + bs_l[g * 128 + i]; const float u = bf2f(UB[(size_t)(R0 + i) * 256 + c]);
        CAT[(size_t)(R0 + i) * DM + 512 + c] = (us)f2bf(u * mixed);
        outv[(size_t)(16 * b + i) * 256 + c] = z[i * 256 + c] * rsz[i] * gs;
    }
    __syncthreads();
}
constexpr int SA_SC = 4096, SA_NKMAX = 1056, SA_BIAS = SA_SC + SA_NKMAX * 17 * 4 + 896, SA_MISC = SA_BIAS + 2048 * 4, SA_RED = SA_MISC + 1024;
__device__ __forceinline__ void small_attn(LAS unsigned char* lds, const us* Q, int qp, const float* Kc, const float* Vc, int cp, int ncache, const float* Kn, const float* Vn, int np, int nnew,
                                           const float* lfc, const float* lfn, bool fox, us* O, int op) {
    const int tid = otid(), lane = tid & 63, wid = tid >> 6;
    const int nk = ncache + nnew, nkb = (nk + 15) >> 4;
    LAS float* SC = (LAS float*)(lds + SA_SC); LAS float* bias = (LAS float*)(lds + SA_BIAS); LAS float* misc = (LAS float*)(lds + SA_MISC); LAS float* red = (LAS float*)(lds + SA_RED);
    if (tid < 128) { const int row = tid >> 3, ch = tid & 7; *(LAS u32x4*)(lds + row * 144 + ch * 16) = *(const u32x4*)(Q + (size_t)row * qp + ch * 8); }
    if (fox) block_cumsum(bias, misc, nk, [&](int j) { return j < ncache ? lfc[(size_t)j * 8] : lfn[(size_t)(j - ncache) * 8]; });
    else __syncthreads();
    { const int kl = lane & 15, kq = lane >> 4;
#pragma unroll 3
      for (int kb = wid; kb < nkb; kb += 8) {
        const int key = kb * 16 + kl; const bool valid = key < nk; const int kk = valid ? key : 0;
        const float* src = (kk < ncache) ? Kc + (size_t)kk * cp : Kn + (size_t)(kk - ncache) * np;
        f32x4 acc = {0.f, 0.f, 0.f, 0.f};
#pragma unroll
        for (int s = 0; s < 2; ++s) {
            const f32x4 x0 = *(const f32x4*)(src + 32 * s + 8 * kq), x1 = *(const f32x4*)(src + 32 * s + 8 * kq + 4);
            const u32x4 bw = (u32x4){pk2(x0[0], x0[1]), pk2(x0[2], x0[3]), pk2(x1[0], x1[1]), pk2(x1[2], x1[3])};
            const bf16x8 a = *(LAS const bf16x8*)(lds + kl * 144 + (32 * s + 8 * kq) * 2);
            acc = MFMA16(a, __builtin_bit_cast(bf16x8, bw), acc);
        }
        const float bj = fox ? bias[key] : 0.f;
#pragma unroll
        for (int r = 0; r < 4; ++r) { const int qrow = 4 * kq + r; float sv = acc[r] + bj; if (!valid || (fox && key > ncache + qrow)) sv = -1e30f; SC[key * 17 + qrow] = sv; }
      } }
    __syncthreads();
#pragma unroll
    for (int rr = 0; rr < 2; ++rr) { const int row = 2 * wid + rr; float mx = -1e30f;
        for (int j = lane; j < nkb * 16; j += 64) mx = fmaxf(mx, SC[j * 17 + row]);
#pragma unroll
        for (int o = 1; o < 64; o <<= 1) mx = fmaxf(mx, __shfl_xor(mx, o));
        float sum = 0.f;
        for (int j = lane; j < nkb * 16; j += 64) { const float e = __builtin_amdgcn_exp2f(SC[j * 17 + row] - mx); SC[j * 17 + row] = e; sum += e; }
        sum = wave_sum(sum);
        if (lane == 0) misc[16 + row] = 1.f / sum; }
    __syncthreads();
    {
      const int d = lane, kpw = (nk + 7) >> 3, j0 = wid * kpw, j1 = min(nk, j0 + kpw), jc = min(j1, ncache);
      float acc[16];
#pragma unroll
      for (int i = 0; i < 16; ++i) acc[i] = 0.f;
#pragma unroll 8
      for (int j = j0; j < jc; ++j) { const float v = Vc[(size_t)j * cp + d]; LAS const float* pj = SC + j * 17;
#pragma unroll
          for (int i = 0; i < 16; ++i) acc[i] += pj[i] * v; }
      for (int j = max(j0, ncache); j < j1; ++j) { const float v = Vn[(size_t)(j - ncache) * np + d]; LAS const float* pj = SC + j * 17;
#pragma unroll
          for (int i = 0; i < 16; ++i) acc[i] += pj[i] * v; }
#pragma unroll
      for (int i = 0; i < 16; ++i) red[(wid * 16 + i) * 64 + d] = acc[i]; }
    __syncthreads();
    { const int d = lane, r0 = 2 * wid; float a0 = 0.f, a1 = 0.f;
#pragma unroll
      for (int w = 0; w < 8; ++w) { a0 += red[(w * 16 + r0) * 64 + d]; a1 += red[(w * 16 + r0 + 1) * 64 + d]; }
      O[(size_t)r0 * op + d] = (us)f2bf(a0 * misc[16 + r0]); O[(size_t)(r0 + 1) * op + d] = (us)f2bf(a1 * misc[17 + r0]); }
    __syncthreads();
}
#ifdef DBG_FOX
__device__ __forceinline__ void dbg_fox(const P& p, int l) {
    const us* QBp = (const us*)(WSB + WS_QB); const us* KBp = (const us*)(WSB + WS_KB); const us* VBp = (const us*)(WSB + WS_VB); us* CATp = (us*)(WSB + WS_CAT);
    const float* lf = OUTB + O_PLF + (size_t)l * NTP * 8;
    for (int id = blockIdx.x * 512 + otid(); id < 131072; id += gridDim.x * 512) {
        const int q = id & 2047, bh = id >> 11, b = bh >> 3, h = bh & 7;
        if ((FQM >> (q >> 8)) & 1) continue;
        float qv[64], o[64];
#pragma unroll
        for (int c8 = 0; c8 < 8; ++c8) { const u32x4 w = *(const u32x4*)(QBp + ((size_t)b * SEQ + q) * 512 + h * 64 + c8 * 8);
#pragma unroll
            for (int e = 0; e < 4; ++e) { qv[c8 * 8 + 2 * e] = bf2f(w[e] & 0xffffu); qv[c8 * 8 + 2 * e + 1] = bf2f(w[e] >> 16); } }
#pragma unroll
        for (int d = 0; d < 64; ++d) o[d] = 0.f;
        float m = -1e30f, ls = 0.f, c = 0.f;
        for (int j = 0; j <= q; ++j) {
            c += lf[((size_t)b * SEQ + j) * 8 + h] * LOG2E;
            const us* kr = KBp + ((size_t)b * SEQ + j) * 512 + h * 64; const us* vr = VBp + ((size_t)b * SEQ + j) * 512 + h * 64;
            float s = 0.f;
#pragma unroll
            for (int c8 = 0; c8 < 8; ++c8) { const u32x4 w = *(const u32x4*)(kr + c8 * 8);
#pragma unroll
                for (int e = 0; e < 4; ++e) { s += qv[c8 * 8 + 2 * e] * bf2f(w[e] & 0xffffu) + qv[c8 * 8 + 2 * e + 1] * bf2f(w[e] >> 16); } }
            s -= c;
            const float mn = fmaxf(m, s), al = __builtin_amdgcn_exp2f(m - mn), pj = __builtin_amdgcn_exp2f(s - mn); m = mn; ls = ls * al + pj;
#pragma unroll
            for (int c8 = 0; c8 < 8; ++c8) { const u32x4 w = *(const u32x4*)(vr + c8 * 8);
#pragma unroll
                for (int e = 0; e < 4; ++e) { o[c8 * 8 + 2 * e] = o[c8 * 8 + 2 * e] * al + pj * bf2f(w[e] & 0xffffu); o[c8 * 8 + 2 * e + 1] = o[c8 * 8 + 2 * e + 1] * al + pj * bf2f(w[e] >> 16); } }
        }
        const float inv = 1.f / ls;
#pragma unroll
        for (int c8 = 0; c8 < 8; ++c8) { u32x4 w;
#pragma unroll
            for (int e = 0; e < 4; ++e) w[e] = pk2(o[c8 * 8 + 2 * e] * inv, o[c8 * 8 + 2 * e + 1] * inv);
            *(u32x4*)(CATp + ((size_t)b * SEQ + q) * DM + h * 64 + c8 * 8) = w; }
    }
}
#endif
__device__ __forceinline__ void attn_phase(const P& p, LAS unsigned char* lds, int l) {
    const int G = gridDim.x, bx = blockIdx.x, vcu = (G % 8 == 0) ? (bx % 8) * (G / 8) + bx / 8 : bx;
#define A_QB ((const us*)(WSB + WS_QB))
#define A_KB ((const us*)(WSB + WS_KB))
#define A_VB ((const us*)(WSB + WS_VB))
#define A_UB ((const us*)(WSB + WS_UB))
#define A_ZB ((const us*)(WSB + WS_ZB))
#define A_QMB ((const us*)(WSB + WS_QMB))
#define A_MKV ((const us*)(WSB + WS_MKV) + (size_t)l * NMEMROWS * 512)
#define A_CAT ((us*)(WSB + WS_CAT))
#define A_WS (INP(12) + (size_t)l * 4 * 16384)
#define A_BS (INP(13) + (size_t)l * 512)
#define A_GS (INP(14) + (size_t)l * 256)
#ifdef DBG_FOX
    dbg_fox(p, l);
#endif
    for (int v = vcu; v < 256; v += G) {
        const int bh = v >> 2, s = v & 3, b = bh >> 3, h = bh & 7;
#pragma unroll 1
        for (int k = 0; k < 2; ++k) { const int qb = k ? 7 - s : s;
#ifdef DBG_FOX
            if (!((FQM >> qb) & 1)) continue;
#endif
            const float* lfP = OUTB + O_PLF + (size_t)l * NTP * 8 + (size_t)b * SEQ * 8 + h;
            block_cumsum((LAS float*)(lds + FL_BIAS), (LAS float*)(lds + FL_MISC), 256 * (qb + 1), [&](int j) { return lfP[(size_t)j * 8]; });
            flash_unit(lds, A_QB + ((size_t)b * SEQ + qb * 256) * 512 + h * 64, 512, A_KB + (size_t)b * SEQ * 512 + h * 64, 512, A_VB + (size_t)b * SEQ * 512 + h * 64, 512,
                       A_CAT + ((size_t)b * SEQ + qb * 256) * DM + h * 64, DM, 4 * (qb + 1), 4, true); }
    }
    for (int v = vcu; v < 256; v += G) { const int bh = v >> 3, qb = v & 7, b = bh >> 2, h = bh & 3; const us* mkv = A_MKV + (size_t)b * 256 * 512 + h * 64;
        flash_unit(lds, A_QMB + ((size_t)b * SEQ + qb * 256) * 256 + h * 64, 256, mkv, 512, mkv + 256, 512,
                   A_CAT + ((size_t)b * SEQ + qb * 256) * DM + 768 + h * 64, DM, 4, 0, false); }
    for (int v = G - 1 - vcu; v < 128; v += G) sgu_unit(lds, v * 128, A_ZB, A_UB, A_CAT, A_WS, A_BS, A_GS);
    for (int v = vcu; v < 128; v += G) { const int b = v >> 3, h = v & 7; const size_t co = ((size_t)(l * NBS + b) * PAST) * 512 + h * 64, no = ((size_t)l * NTS + 16 * b) * 512 + h * 64;
        small_attn(lds, A_QB + (size_t)(NTP + 16 * b) * 512 + h * 64, 512, INP(3) + co, INP(4) + co, 512, PAST, OUTB + O_SK + no, OUTB + O_SV + no, 512, 16,
                   INP(5) + ((size_t)(l * NBS + b) * PAST) * 8 + h, OUTB + O_SLF + (size_t)l * NTS * 8 + (size_t)(16 * b) * 8 + h, true, A_CAT + (size_t)(NTP + 16 * b) * DM + h * 64, DM); }
    for (int v = G - 1 - vcu; v < 64; v += G) { const int b = v >> 2, h = v & 3; const size_t co = ((size_t)(l * NBS + b) * 256) * 256 + h * 64;
        small_attn(lds, A_QMB + (size_t)(NTP + 16 * b) * 256 + h * 64, 256, INP(6) + co, INP(7) + co, 256, 256,
                   nullptr, nullptr, 0, 0, nullptr, nullptr, false, A_CAT + (size_t)(NTP + 16 * b) * DM + 768 + h * 64, DM); }
    for (int v = vcu - 128; v >= 0 && v < 16; v += G) sgu_sample_unit(lds, v, A_ZB, A_UB, A_CAT, A_WS, A_BS, A_GS, OUTB + O_SGV + (size_t)l * NTS * 256);
}
__device__ __forceinline__ void gnorm_phase(const P& p, int l) {
    const int tid_ = otid(), lane = tid_ & 63, wid = tid_ >> 6; us* CAT = (us*)(WSB + WS_CAT); const float* gg = INP(17) + (size_t)l * DM;
    for (int row = blockIdx.x * 8 + wid; row < NT; row += gridDim.x * 8) {
        u32x4* rp = (u32x4*)(CAT + (size_t)row * DM + 16 * lane); const u32x4 w0 = rp[0], w1 = rp[1];
        float v[16];
#pragma unroll
        for (int e = 0; e < 4; ++e) { v[2 * e] = bf2f(w0[e] & 0xffffu); v[2 * e + 1] = bf2f(w0[e] >> 16); v[8 + 2 * e] = bf2f(w1[e] & 0xffffu); v[8 + 2 * e + 1] = bf2f(w1[e] >> 16); }
        float ss = 0.f;
#pragma unroll
        for (int e = 0; e < 16; ++e) ss += v[e] * v[e];
        ss += __shfl_xor(ss, 1); ss += __shfl_xor(ss, 2); ss += __shfl_xor(ss, 4); ss += __shfl_xor(ss, 8);
        const float s16 = __shfl_xor(ss, 16); float wdt = 256.f; if (lane < 32) { ss += s16; wdt = 512.f; }
        const float r = rsqrtf(ss / wdt + EPS);
        const f32x4 g0 = *(const f32x4*)(gg + 16 * lane), g1 = *(const f32x4*)(gg + 16 * lane + 4), g2 = *(const f32x4*)(gg + 16 * lane + 8), g3 = *(const f32x4*)(gg + 16 * lane + 12);
        u32x4 o0, o1;
        o0.x = pk2(v[0] * r * g0[0], v[1] * r * g0[1]); o0.y = pk2(v[2] * r * g0[2], v[3] * r * g0[3]); o0.z = pk2(v[4] * r * g1[0], v[5] * r * g1[1]); o0.w = pk2(v[6] * r * g1[2], v[7] * r * g1[3]);
        o1.x = pk2(v[8] * r * g2[0], v[9] * r * g2[1]); o1.y = pk2(v[10] * r * g2[2], v[11] * r * g2[3]); o1.z = pk2(v[12] * r * g3[0], v[13] * r * g3[1]); o1.w = pk2(v[14] * r * g3[2], v[15] * r * g3[3]);
        rp[0] = o0; rp[1] = o1;
    }
}
__device__ __forceinline__ void fixup_phase(const P& p, int l) {
    const float* wdw = INP(22) + (size_t)l * 3 * FF; const float* bdw = INP(23) + (size_t)l * FF;
    const float* AF = (const float*)(WSB + WS_AF); const float* LF = (const float*)(WSB + WS_LF); const float* AL = (const float*)(WSB + WS_AL);
    const float* SA = (const float*)(WSB + WS_SA); const float* SL = (const float*)(WSB + WS_SL); us* G = (us*)(WSB + WS_G);
    const int gt = blockIdx.x * 512 + otid(), gn = gridDim.x * 512;
    for (int i = gt; i < 256 * 2 * FF; i += gn) { const int f = i % FF, sr = i / FF, rr = sr & 1, s = sr >> 1;
        const bool first = (s & 31) == 0;
        const float l0 = first ? 0.f : AL[((size_t)(s - 1) * 2) * FF + f], l1 = first ? 0.f : AL[((size_t)(s - 1) * 2 + 1) * FF + f];
        const float a2 = AF[(size_t)sr * FF + f], a1 = rr ? AF[((size_t)s * 2) * FF + f] : l1, a0 = rr ? l1 : l0;
        const float g = silu_f(bdw[f] + wdw[f] * a0 + wdw[FF + f] * a1 + wdw[2 * FF + f] * a2) * LF[(size_t)sr * FF + f];
        G[((size_t)s * 64 + rr) * FF + f] = (us)f2bf(g); }
    const float* hist = INP(8) + (size_t)l * NBS * 2 * FF;
    for (int i = gt; i < NTS * FF; i += gn) { const int f = i % FF, r = i / FF, b = r >> 4, t = r & 15;
        const float a2 = SA[(size_t)r * FF + f];
        const float a1 = (t >= 1) ? SA[(size_t)(r - 1) * FF + f] : hist[((size_t)b * 2 + 1) * FF + f];
        const float a0 = (t >= 2) ? SA[(size_t)(r - 2) * FF + f] : hist[((size_t)b * 2 + t) * FF + f];
        const float g = silu_f(bdw[f] + wdw[f] * a0 + wdw[FF + f] * a1 + wdw[2 * FF + f] * a2) * SL[(size_t)r * FF + f];
        G[((size_t)NTP + r) * FF + f] = (us)f2bf(g); }
    float* oc = OUTB + O_PCONV + (size_t)l * NBP * 2 * FF;
    for (int i = gt; i < NBP * 2 * FF; i += gn) { const int f = i % FF, br = i / FF, b = br >> 1, rr = br & 1; oc[i] = AL[((size_t)(32 * b + 31) * 2 + rr) * FF + f]; }
    float* os = OUTB + O_SCONV + (size_t)l * NBS * 2 * FF;
    for (int i = gt; i < NBS * 2 * FF; i += gn) { const int f = i % FF, br = i / FF, b = br >> 1, rr = br & 1; os[i] = SA[((size_t)b * 16 + 14 + rr) * FF + f]; }
}
__device__ __forceinline__ void small_gemm(LAS unsigned char* lds, const us* A  , const us* Bt, int K, us* Y, float* YSQ) {
    const int tid = otid(), lane = tid & 63, wid = tid >> 6, cg4 = wid & 3, kh = wid >> 2, rl = lane & 15, kq = lane >> 4;
    LAS float* xch = (LAS float*)lds;
    for (int it = blockIdx.x; it < 256; it += gridDim.x) {
        const int rb = it >> 4, cb = it & 15;
        const us* ap = A + (size_t)(rb * 16 + rl) * K + kh * (K / 2) + 8 * kq; const us* bp = Bt + (size_t)(cb * 64 + cg4 * 16 + rl) * K + kh * (K / 2) + 8 * kq;
        f32x4 acc = {0.f, 0.f, 0.f, 0.f};
#pragma unroll 8
        for (int k = 0; k < K / 2; k += 32) acc = MFMA16(*(const bf16x8*)(ap + k), *(const bf16x8*)(bp + k), acc);
        if (kh == 1) *(LAS f32x4*)(xch + (cg4 * 64 + lane) * 4) = acc;
        __syncthreads();
        if (kh == 0) {
            acc = acc + *(LAS const f32x4*)(xch + (cg4 * 64 + lane) * 4);
            const int col = cb * 64 + cg4 * 16 + rl;
#pragma unroll
            for (int r = 0; r < 4; ++r) { const int row = rb * 16 + 4 * kq + r; Y[(size_t)row * DM + col] = (us)f2bf(acc[r]);
                float ss = acc[r] * acc[r]; ss += __shfl_xor(ss, 1); ss += __shfl_xor(ss, 2); ss += __shfl_xor(ss, 4); ss += __shfl_xor(ss, 8);
                if (rl == 0) xch[1024 + cg4 * 16 + 4 * kq + r] = ss; }
        }
        __syncthreads();
        if (tid < 16) YSQ[(size_t)(rb * 16 + tid) * 16 + cb] = (xch[1024 + tid] + xch[1024 + 16 + tid]) + (xch[1024 + 32 + tid] + xch[1024 + 48 + tid]);
        __syncthreads();
    }
}
constexpr int LDS_BYTES = 147456;
constexpr int NPHASE = 19;
#define XB_TMO      128
#define XB_XCNT(j)  (256  + 64 * (j))
#define XB_XSUB(j)  (1280 + 64 * (j))
#define XB_XGEN(j)  (2304 + 64 * (j))
#define XB_TOP      3328
#define XB_TOPGEN   3392
#define XCD_BAR_WORDS 3456
#define XB_SPIN_CAP (1u << 18)

__device__ __forceinline__ unsigned xb_ld(unsigned* p)              { return __hip_atomic_load(p, __ATOMIC_RELAXED, __HIP_MEMORY_SCOPE_AGENT); }
__device__ __forceinline__ unsigned xb_add(unsigned* p, unsigned v) { return __hip_atomic_fetch_add(p, v, __ATOMIC_RELAXED, __HIP_MEMORY_SCOPE_AGENT); }
__device__ __forceinline__ unsigned xb_xcc_id() { return (unsigned)__builtin_amdgcn_s_getreg((3 << 11) | 20) & 0xFu; }
#define XB_SPIN(cond, bar) do { unsigned _sp = 0; while (cond) { __builtin_amdgcn_s_sleep(1); \
    if ((++_sp & 255u) == 0u) { if (xb_ld(&(bar)[XB_TMO])) break; if (_sp > XB_SPIN_CAP) { atomicAdd(&(bar)[XB_TMO], 1u); break; } } } } while (0)

struct XcdBarrier {
    unsigned* bar; unsigned x;
    volatile LAS unsigned* st;
};

__device__ __forceinline__ XcdBarrier xcd_barrier_post(unsigned* bar, volatile LAS unsigned* st) {
    XcdBarrier b; b.bar = bar; b.x = xb_xcc_id(); b.st = st;
    if (threadIdx.x == 0) (void)xb_add(&bar[XB_XCNT(b.x)], 1u);
    return b;
}
__device__ __forceinline__ void xcd_barrier_complete(unsigned* bar, unsigned x, unsigned& nloc, unsigned& nx) {
    const unsigned G = gridDim.x * gridDim.y * gridDim.z;
    unsigned sum, cnt, mine, sp = 0u;
    for (;;) {
        sum = 0u; cnt = 0u; mine = 0u;
#pragma unroll
        for (unsigned j = 0; j < 16; ++j) { const unsigned c = xb_ld(&bar[XB_XCNT(j)]); sum += c; cnt += (c > 0u) ? 1u : 0u; mine = (j == x) ? c : mine; }
        if (sum == G) break;
        __builtin_amdgcn_s_sleep(1);
        if ((++sp & 255u) == 0u) { if (xb_ld(&bar[XB_TMO])) break; if (sp > XB_SPIN_CAP) { atomicAdd(&bar[XB_TMO], 1u); break; } }
    }
    nloc = mine > 0u ? mine : 1u; nx = cnt > 0u ? cnt : 1u;
}

__device__ __forceinline__ void xcd_barrier(const XcdBarrier& b) {
    asm volatile("s_waitcnt vmcnt(0)" ::: "memory");
    __syncthreads();
    if (threadIdx.x == 0) {
        unsigned* bar = b.bar;
        __builtin_amdgcn_s_waitcnt(0);
        unsigned nloc = b.st[0], nx = b.st[1];
        if (nloc == 0u) { xcd_barrier_complete(bar, b.x, nloc, nx); b.st[0] = nloc; b.st[1] = nx; }
        const unsigned old = xb_add(&bar[XB_XSUB(b.x)], 1u);
        const unsigned gen = old / nloc;
        if (old + 1u == (gen + 1u) * nloc) {
            __builtin_amdgcn_fence(__ATOMIC_RELEASE, "agent");
            asm volatile("s_waitcnt vmcnt(0)" ::: "memory");
            const unsigned og = xb_add(&bar[XB_TOP], 1u);
            const unsigned tg = og / nx;
            if (og + 1u == (tg + 1u) * nx) xb_add(&bar[XB_TOPGEN], 1u);
            else XB_SPIN(xb_ld(&bar[XB_TOPGEN]) == tg, bar);
            __builtin_amdgcn_fence(__ATOMIC_ACQUIRE, "agent");
            xb_add(&bar[XB_XGEN(b.x)], 1u);
            asm volatile("s_waitcnt vmcnt(0)" ::: "memory");
        } else {
            XB_SPIN(xb_ld(&bar[XB_XGEN(b.x)]) == gen, bar);
            __builtin_amdgcn_fence(__ATOMIC_ACQUIRE, "agent");
            asm volatile("s_waitcnt vmcnt(0)" ::: "memory");
        }
    }
    __syncthreads();
}


__global__ void __launch_bounds__(512, 2) mega(P p) {
    extern __shared__ __attribute__((aligned(16))) unsigned char lds_raw[];
    LAS unsigned char* lds = (LAS unsigned char*)lds_raw;
    volatile LAS unsigned* xst = (volatile LAS unsigned*)(lds + LDS_BYTES - 16);
    if (threadIdx.x < 4) xst[threadIdx.x] = 0u;
    __syncthreads();
    if (p.coop) { cg::grid_group grid = cg::this_grid(); grid.sync();
        (void)xcd_barrier_post((unsigned*)(WSB + WS_CTL), xst); }
#define XB ((us*)(WSB + WS_XB))
#define RS ((float*)(WSB + WS_RS))
#define X (OUTB + O_Y)
#define Y ((us*)(WSB + WS_Y))
#define YSQ ((float*)(WSB + WS_YSQ))
    for (int ph = p.ph_lo; ph < p.ph_hi; ++ph) {
#ifdef RPT_MASK
      for (int rep = 0; rep < ((ph > 0 && ((RPT_MASK >> ((ph - 1) % 9)) & 1)) || (ph == 0 && (RPT_MASK & 0x200)) ? 2 : 1); ++rep) {
#else
      {
#endif
        if (ph == 0) {
            prep_phase(p, lds);
            row_pass<false, true, true>(INP(0), INP(1), NT, nullptr, nullptr, nullptr, nullptr, XB, RS, INP(10), INP(9), INP(11), OUTB + O_PLF, OUTB + O_SLF, (LAS float*)lds);
            row_pass<false, false, true>(INP(2), INP(2), NMEMROWS, nullptr, nullptr, nullptr, nullptr, (us*)(WSB + WS_MEMB), (float*)(WSB + WS_RSMEM), nullptr, nullptr, nullptr, nullptr, nullptr, (LAS float*)lds);
        } else {
            const int l = (ph - 1) / 9, s = (ph - 1) % 9;
            if (s == 0) {
                { pg8::Gemm g{XB, (const us*)(WSB + WS_WIN) + (size_t)l * NIN * DM, NT, NIN, DM}; pg8::StaticOrder S; S.init(NT, NIN, gridDim.x, blockIdx.x);
                  pg8::EpiIn E{0, l, WSB, OUTB};
                  pg8::gemm_phase<pg8::EpiIn, pg8::StaticOrder, true, true>(lds, g, S, E); }
                if (l == 0) {
#pragma unroll 1
                    for (int ll = 0; ll < 2; ++ll) {
                        pg8::Gemm g{(const us*)(WSB + WS_MEMB), (const us*)(WSB + WS_WMEM) + (size_t)ll * 512 * DM, NMEMROWS, 512, DM}; pg8::StaticOrder S; S.init(NMEMROWS, 512, gridDim.x, (blockIdx.x + 80 + 16 * ll) % gridDim.x);
                        pg8::EpiIn E{1, ll, WSB, OUTB};
                        pg8::gemm_phase<pg8::EpiIn, pg8::StaticOrder, true, true>(lds, g, S, E); }
                }
            } else if (s == 1) { attn_phase(p, lds, l);
            } else if (s == 2) { gnorm_phase(p, l);
            } else if (s == 3 || s == 7) {
                const us* A = (s == 3) ? (const us*)(WSB + WS_CAT) : (const us*)(WSB + WS_G); const int K = (s == 3) ? DM : FF;
                const us* Bt = (s == 3) ? (const us*)(WSB + WS_WOUT) + (size_t)l * DM * DM : (const us*)(WSB + WS_WDOWN) + (size_t)l * DM * FF;
                { pg8::Gemm g{A, Bt, NTP, DM, K}; pg8::StaticOrder S; S.init(NTP, DM, gridDim.x, blockIdx.x); pg8::EpiY E{WSB};
                  pg8::gemm_phase<pg8::EpiY, pg8::StaticOrder, true, true>(lds, g, S, E); }
                small_gemm(lds, A + (size_t)NTP * K, Bt, K, Y + (size_t)NTP * DM, YSQ + (size_t)NTP * 16);
            } else if (s == 4) {
                const float* xp = (l == 0) ? INP(0) : X; const float* xs = (l == 0) ? INP(1) : X + (size_t)NTP * DM;
                row_pass<true, false, true>(xp, xs, NT, X, Y, YSQ, INP(19) + (size_t)l * DM, XB, RS, nullptr, nullptr, nullptr, nullptr, nullptr, (LAS float*)lds);
            } else if (s == 5) {
                pg8::Gemm g{XB, (const us*)(WSB + WS_WUP) + (size_t)l * NUP * DM, NT, NUP, DM}; pg8::StaticOrder S; S.init(NT, NUP, gridDim.x, blockIdx.x);
                pg8::EpiUp E{WSB, INP(22) + (size_t)l * 3 * FF, INP(23) + (size_t)l * FF};
                pg8::gemm_phase<pg8::EpiUp, pg8::StaticOrder, true, true>(lds, g, S, E);
            } else if (s == 6) { fixup_phase(p, l);
            } else {
                if (l == 0) row_pass<true, true, true>(X, X + (size_t)NTP * DM, NT, X, Y, YSQ, INP(25), XB, RS, INP(10) + (size_t)DM * INC, INP(9) + DM, INP(11) + 8, OUTB + O_PLF + (size_t)NTP * 8, OUTB + O_SLF + (size_t)NTS * 8, (LAS float*)lds);
                else row_pass<true, false, false>(X, X + (size_t)NTP * DM, NT, X, Y, YSQ, INP(25) + DM, nullptr, nullptr, nullptr, nullptr, nullptr, nullptr, nullptr, (LAS float*)lds);
            }
        }
      }
        if (p.coop && ph + 1 < p.ph_hi) { XcdBarrier xb_; xb_.bar = (unsigned*)(WSB + WS_CTL); xb_.x = xb_xcc_id(); xb_.st = xst; xcd_barrier(xb_); }
    }
}

#undef XB
#undef RS
#undef X
#undef Y
#undef YSQ
extern "C" void kernel_launch(void* const* d_in, const int* in_sizes, int n_in, void* d_out, int out_size, void* d_ws, size_t ws_size, hipStream_t stream) {
    static int grid = 0;
    if (grid == 0) {
        if (n_in != 26 || out_size != (int)O_END || ws_size < WS_END) { fprintf(stderr, "kernel_launch: unexpected sizes n_in %d out %d ws %zu (need %zu)\n", n_in, out_size, ws_size, (size_t)WS_END); grid = -1; return; }
        int dev = 0, cus = 0, per_cu = 0;
        (void)hipGetDevice(&dev); (void)hipDeviceGetAttribute(&cus, hipDeviceAttributeMultiprocessorCount, dev);
        if (hipFuncSetAttribute((const void*)mega, hipFuncAttributeMaxDynamicSharedMemorySize, LDS_BYTES) != hipSuccess) { fprintf(stderr, "kernel_launch: hipFuncSetAttribute failed\n"); grid = -1; return; }
        (void)hipOccupancyMaxActiveBlocksPerMultiprocessor(&per_cu, (const void*)mega, 512, LDS_BYTES);
        (void)hipGetLastError();
        if (per_cu < 1) fprintf(stderr, "kernel_launch: occupancy query says %d blocks per CU\n", per_cu);
        grid = cus > 0 ? cus : 256;
    }
    if (grid < 0) return;
    if (hipMemsetAsync((char*)d_ws + WS_CTL, 0, 16384, stream) != hipSuccess) { fprintf(stderr, "kernel_launch: memset failed\n"); return; }
    P p{};
    for (int i = 0; i < 26; ++i) p.in[i] = (const float*)d_in[i];
    p.out = (float*)d_out; p.ws = (unsigned char*)d_ws; p.pad = 0;
#ifndef MK_MULTI
    p.ph_lo = 0; p.ph_hi = NPHASE; p.coop = 1;
    void* args[] = {&p};
    hipError_t e = hipLaunchCooperativeKernel((void*)mega, dim3(grid), dim3(512), args, LDS_BYTES, stream);
    if (e != hipSuccess) fprintf(stderr, "kernel_launch: cooperative launch failed: %s (grid %d)\n", hipGetErrorString(e), grid);
#else
    for (int ph = 0; ph < NPHASE; ++ph) { p.ph_lo = ph; p.ph_hi = ph + 1; p.coop = 0; hipLaunchKernelGGL(mega, dim3(grid), dim3(512), LDS_BYTES, stream, p); }
#endif
}
```

```cpp
#include <hip/hip_runtime.h>
#include <hip/hip_cooperative_groups.h>
#include <cstdio>
#include <cstdint>
namespace cg = cooperative_groups;
#define LAS __attribute__((address_space(3)))
typedef unsigned short us;
typedef float f32x16 __attribute__((ext_vector_type(16)));
typedef short s16x4 __attribute__((ext_vector_type(4)));

constexpr int DM = 1024, NTP = 16384, NTS = 256, NT = NTP + NTS, SEQ = 2048, NBP = 8, NBS = 16, PAST = 1024;
constexpr int INC = 2312, NIN = 2304, FF = 2816, NUP = 5632, NMEMROWS = 2048;
constexpr float LOG2E = 1.4426950408889634f, C2 = 0.125f * 1.4426950408889634f, EPS = 1e-6f;

constexpr size_t O_Y = 0, O_YS = 16777216, O_PK = 17039360, O_PV = 33816576, O_PLF = 50593792, O_PMK = 50855936, O_PMV = 51904512,
                 O_PCONV = 52953088, O_SK = 53043200, O_SV = 53305344, O_SLF = 53567488, O_SGV = 53571584, O_SCONV = 53702656, O_END = 53882880;
constexpr size_t MiB = 1u << 20;
constexpr size_t WS_WIN = 0;
constexpr size_t WS_WOUT = 10 * MiB;
constexpr size_t WS_WUP = 14 * MiB;
constexpr size_t WS_WDOWN = 36 * MiB;
constexpr size_t WS_WMEM = 47 * MiB;
constexpr size_t WS_XB = 49 * MiB;
constexpr size_t WS_MEMB = 82 * MiB;
constexpr size_t WS_MKV = 86 * MiB;
constexpr size_t WS_RS = 90 * MiB;
constexpr size_t WS_RSMEM = 90 * MiB + 128 * 1024;
constexpr size_t WS_YSQ = 91 * MiB;
constexpr size_t WS_AF = 93 * MiB;
constexpr size_t WS_LF = 99 * MiB;
constexpr size_t WS_AL = 105 * MiB;
constexpr size_t WS_SA = 111 * MiB;
constexpr size_t WS_SL = 114 * MiB;
constexpr size_t WS_Y = 117 * MiB;
constexpr size_t WS_ACT = 183 * MiB;
constexpr size_t WS_QB = WS_ACT;
constexpr size_t WS_KB = WS_ACT + 17 * MiB;
constexpr size_t WS_VB = WS_ACT + 34 * MiB;
constexpr size_t WS_UB = WS_ACT + 51 * MiB;
constexpr size_t WS_ZB = WS_ACT + 60 * MiB;
constexpr size_t WS_QMB = WS_ACT + 69 * MiB;
constexpr size_t WS_CAT = WS_ACT + 78 * MiB;
constexpr size_t WS_G = WS_ACT;
constexpr size_t WS_CTL = WS_ACT + 111 * MiB;
constexpr size_t WS_END = WS_ACT + 112 * MiB;

__device__ __forceinline__ unsigned f2bf(float f) { unsigned u = __builtin_bit_cast(unsigned, f); return (u + 0x7fffu + ((u >> 16) & 1u)) >> 16; }
__device__ __forceinline__ unsigned pk2(float lo, float hi) { return f2bf(lo) | (f2bf(hi) << 16); }
__device__ __forceinline__ float bf2f(unsigned h) { return __builtin_bit_cast(float, h << 16); }
__device__ __forceinline__ float gelu_tanh(float x) { const float y = 0.7978845608028654f * (x + 0.044715f * x * x * x); return x / (1.f + __expf(-2.f * y)); }
__device__ __forceinline__ float silu_f(float x) { return x / (1.f + __expf(-x)); }
__device__ __forceinline__ float wave_sum(float v) {
#pragma unroll
    for (int o = 1; o < 64; o <<= 1) v += __shfl_xor(v, o);
    return v;
}
__device__ __forceinline__ int opq0() { int z; asm volatile("s_mov_b32 %0, 0" : "=s"(z)); return z; }
__device__ __forceinline__ int otid() { int t = threadIdx.x; asm volatile("" : "+v"(t)); return t; }
namespace pg8 {
#define PG8_LAS __attribute__((address_space(3)))
typedef unsigned short bf16_t;
typedef short bf16x8 __attribute__((ext_vector_type(8)));
typedef float f32x4 __attribute__((ext_vector_type(4)));
typedef unsigned u32x4 __attribute__((ext_vector_type(4)));
constexpr int BM = 256, BK = 64, HALF = 128, HTB = HALF * BK * 2  , STAGE_BYTES = 8 * HTB, NXCD = 8, WGM = 8;

__host__ __device__ __forceinline__ int lds_byte(int r, int c) { const int st = (r >> 4) * 2 + (c >> 5), rr = r & 15, cc = c & 31, ob = rr * 64 + cc * 2; return st * 1024 + (ob ^ (((ob >> 9) & 1) << 5)); }
__host__ __device__ __forceinline__ void stage_rc(int b, int& R, int& C) { const int st = b / 1024, sb = b % 1024, swz = sb ^ (((sb >> 9) & 1) << 5); R = (st >> 1) * 16 + swz / 64; C = (st & 1) * 32 + (swz % 64) / 2; }
__host__ __device__ __forceinline__ int perm32(int rho) { const int n = rho >> 4, i = rho & 15; return 8 * (i >> 2) + 4 * n + (i & 3); }

struct Unit { int pm, pn; };
struct Gemm { const bf16_t* A; const bf16_t* Bt; int M, N, K; };

struct StaticOrder {
    int nM, nN, nwg, G, c;
    __host__ __device__ void init(int M, int N, int G_, int c_) { nM = M / BM; nN = N / BM; nwg = nM * nN; G = G_; c = c_; }
    __host__ __device__ bool next(int i, Unit& u) const {
        const long L = (long)i * G + c; if (L >= nwg) return false;
        int wgid = (int)L; { const int q = nwg / NXCD, r = nwg % NXCD, xcd = wgid % NXCD, off = wgid / NXCD; wgid = (xcd < r ? xcd * (q + 1) : r * (q + 1) + (xcd - r) * q) + off; }
        const int nig = WGM * nN, gid = wgid / nig, fm = gid * WGM, gsz = (nM - fm) < WGM ? (nM - fm) : WGM;
        u.pm = fm + ((wgid % nig) % gsz); u.pn = (wgid % nig) / gsz; return true;
    }
    __device__ __forceinline__ void a_ready(const Unit&) const {}
    __device__ __forceinline__ void done(const Unit&) const {}
};
__device__ __forceinline__ unsigned cvt_pk_bf16(float lo, float hi) { unsigned r; asm volatile("v_cvt_pk_bf16_f32 %0, %1, %2" : "=v"(r) : "v"(lo), "v"(hi)); return r; }
struct EpiIn {
    static constexpr bool PERM = true, AFTER_DRAIN = false;
    int mode, l; unsigned char* ws; float* out;
    __device__ __forceinline__ void operator()(const f32x4 (&acc)[2][2][4][2], const Unit& u, int wr, int wc, int fr_, int fq_) const {
        int fr = fr_, fq = fq_; asm volatile("" : "+v"(fr), "+v"(fq));
        const int pn = u.pn;
        bf16_t* const QB = (bf16_t*)(ws + WS_QB); bf16_t* const KB = (bf16_t*)(ws + WS_KB); bf16_t* const VB = (bf16_t*)(ws + WS_VB); bf16_t* const UB = (bf16_t*)(ws + WS_UB);
        bf16_t* const ZB = (bf16_t*)(ws + WS_ZB); bf16_t* const QMB = (bf16_t*)(ws + WS_QMB); bf16_t* const MKV = (bf16_t*)(ws + WS_MKV) + (size_t)l * NMEMROWS * 512;
        float* const oKp = out + O_PK + (size_t)l * NTP * 512; float* const oVp = out + O_PV + (size_t)l * NTP * 512; float* const oKs = out + O_SK + (size_t)l * NTS * 512; float* const oVs = out + O_SV + (size_t)l * NTS * 512;
        float* const oMK = out + O_PMK + (size_t)l * NMEMROWS * 256; float* const oMV = out + O_PMV + (size_t)l * NMEMROWS * 256;
        bf16_t* bdst; int bp; int bc; float mult = 1.f; int act = 0; float* fP = nullptr; float* fS = nullptr; int fp_ = 0, fc = 0;
        if (mode == 0) {
            if (pn < 2) { bdst = QB; bp = 512; bc = pn * 256; mult = C2; }
            else if (pn < 4) { bdst = KB; bp = 512; bc = (pn - 2) * 256; fP = oKp; fS = oKs; fp_ = 512; fc = bc; }
            else if (pn < 6) { bdst = VB; bp = 512; bc = (pn - 4) * 256; fP = oVp; fS = oVs; fp_ = 512; fc = bc; }
            else if (pn == 6) { bdst = UB; bp = 256; bc = 0; act = 1; }
            else if (pn == 7) { bdst = ZB; bp = 256; bc = 0; act = 1; }
            else { bdst = QMB; bp = 256; bc = 0; mult = C2; }
        } else { bdst = MKV; bp = 512; bc = pn * 256; fP = pn ? oMV : oMK; fS = fP; fp_ = 256; fc = 0; }
#pragma unroll
        for (int ai = 0; ai < 2; ++ai)
#pragma unroll
            for (int m = 0; m < 4; ++m) {
                const int row = u.pm * BM + ai * HALF + wr * 64 + m * 16 + fr;
                const float s = mult;
                float* frow = nullptr;
                if (fP) frow = (mode == 0 && row >= NTP) ? fS + (size_t)(row - NTP) * fp_ + fc : fP + (size_t)row * fp_ + fc;
#pragma unroll
                for (int bj = 0; bj < 2; ++bj) {
                    const int lc = bj * HALF + wc * 32 + 8 * fq;
                    f32x4 v0 = acc[ai][bj][m][0] * s, v1 = acc[ai][bj][m][1] * s;
                    if (act) { v0 = (f32x4){gelu_tanh(v0[0]), gelu_tanh(v0[1]), gelu_tanh(v0[2]), gelu_tanh(v0[3])}; v1 = (f32x4){gelu_tanh(v1[0]), gelu_tanh(v1[1]), gelu_tanh(v1[2]), gelu_tanh(v1[3])}; }
                    if (frow) { *(f32x4*)(frow + lc) = v0; *(f32x4*)(frow + lc + 4) = v1; }
                    u32x4 w; w.x = cvt_pk_bf16(v0[0], v0[1]); w.y = cvt_pk_bf16(v0[2], v0[3]); w.z = cvt_pk_bf16(v1[0], v1[1]); w.w = cvt_pk_bf16(v1[2], v1[3]);
                    *(u32x4*)(bdst + (size_t)row * bp + bc + lc) = w;
                }
            }
    }
};
struct EpiY {
    static constexpr bool PERM = true, AFTER_DRAIN = false;
    unsigned char* ws;
    __device__ __forceinline__ void operator()(const f32x4 (&acc)[2][2][4][2], const Unit& u, int wr, int wc, int fr_, int fq_) const {
        int fr = fr_, fq = fq_; asm volatile("" : "+v"(fr), "+v"(fq));
        bf16_t* const Y = (bf16_t*)(ws + WS_Y); float* const YSQ = (float*)(ws + WS_YSQ);
#pragma unroll
        for (int ai = 0; ai < 2; ++ai)
#pragma unroll
            for (int m = 0; m < 4; ++m) {
                const int row = u.pm * BM + ai * HALF + wr * 64 + m * 16 + fr;
                float ss = 0.f;
#pragma unroll
                for (int bj = 0; bj < 2; ++bj) {
                    const int c = u.pn * BM + bj * HALF + wc * 32 + 8 * fq;
                    const f32x4 v0 = acc[ai][bj][m][0], v1 = acc[ai][bj][m][1];
                    u32x4 w; w.x = cvt_pk_bf16(v0[0], v0[1]); w.y = cvt_pk_bf16(v0[2], v0[3]); w.z = cvt_pk_bf16(v1[0], v1[1]); w.w = cvt_pk_bf16(v1[2], v1[3]);
                    *(u32x4*)(Y + (size_t)row * DM + c) = w;
                    ss += (v0[0] * v0[0] + v0[1] * v0[1]) + (v0[2] * v0[2] + v0[3] * v0[3]) + (v1[0] * v1[0] + v1[1] * v1[1]) + (v1[2] * v1[2] + v1[3] * v1[3]);
                }
                ss += __shfl_xor(ss, 16); ss += __shfl_xor(ss, 32);
                if (fq == 0) YSQ[(size_t)row * 16 + u.pn * 4 + wc] = ss;
            }
    }
};
struct EpiUp {
    static constexpr bool PERM = true, AFTER_DRAIN = false;
    unsigned char* ws; const float* wdw; const float* bdw; const float* hist; float* osc;
    __device__ __forceinline__ void operator()(const f32x4 (&acc)[2][2][4][2], const Unit& u, int wr, int wc, int fr_, int fq_) const {
        int fr = fr_, fq = fq_; asm volatile("" : "+v"(fr), "+v"(fq));
        const int f0 = u.pn * 128 + wc * 32 + 8 * fq;
        bf16_t* const G = (bf16_t*)(ws + WS_G);
        float* const AF = (float*)(ws + WS_AF); float* const LF = (float*)(ws + WS_LF); float* const AL = (float*)(ws + WS_AL);
        const int lane = fq * 16 + fr;
        const int src1 = (lane & 48) | ((fr - 1) & 15), src2 = (lane & 48) | ((fr - 2) & 15);
        if (u.pm == NTP / BM) {
#pragma unroll
            for (int n = 0; n < 2; ++n) {
                const int fn = f0 + 4 * n;
                const f32x4 w0 = *(const f32x4*)(wdw + fn), w1 = *(const f32x4*)(wdw + FF + fn), w2 = *(const f32x4*)(wdw + 2 * FF + fn), bb = *(const f32x4*)(bdw + fn);
#pragma unroll
                for (int ai = 0; ai < 2; ++ai)
#pragma unroll
                    for (int m = 0; m < 4; ++m) {
                        const int b = 8 * ai + 4 * wr + m, row = NTP + 16 * b + fr;
                        const f32x4 a = acc[ai][0][m][n], li = acc[ai][1][m][n]; f32x4 gv, h0 = {0.f, 0.f, 0.f, 0.f}, h1 = {0.f, 0.f, 0.f, 0.f};
                        if (fr < 2) { h0 = *(const f32x4*)(hist + ((size_t)b * 2) * FF + fn); h1 = *(const f32x4*)(hist + ((size_t)b * 2 + 1) * FF + fn); }
#pragma unroll
                        for (int e = 0; e < 4; ++e) {
                            const float p1 = __shfl(a[e], src1), p2 = __shfl(a[e], src2);
                            const float a1 = (fr == 0) ? h1[e] : p1, a0 = (fr == 0) ? h0[e] : ((fr == 1) ? h1[e] : p2);
                            gv[e] = silu_f(bb[e] + w0[e] * a0 + w1[e] * a1 + w2[e] * a[e]) * li[e];
                        }
                        unsigned long long w = (unsigned long long)cvt_pk_bf16(gv[0], gv[1]) | ((unsigned long long)cvt_pk_bf16(gv[2], gv[3]) << 32);
                        *(unsigned long long*)(G + (size_t)row * FF + fn) = w;
                        if (fr >= 14) *(f32x4*)(osc + ((size_t)b * 2 + (fr - 14)) * FF + fn) = a;
                        __builtin_amdgcn_sched_barrier(0);
                    }
            }
            return;
        }
#pragma unroll
        for (int n = 0; n < 2; ++n) {
            const int fn = f0 + 4 * n;
            const f32x4 w0 = *(const f32x4*)(wdw + fn), w1 = *(const f32x4*)(wdw + FF + fn), w2 = *(const f32x4*)(wdw + 2 * FF + fn), bb = *(const f32x4*)(bdw + fn);
#pragma unroll
            for (int ai = 0; ai < 2; ++ai) {
                const int strip = u.pm * 4 + ai * 2 + wr;
                f32x4 ap = {0.f, 0.f, 0.f, 0.f};
#pragma unroll
                for (int m = 0; m < 4; ++m) {
                    const int row = u.pm * BM + ai * HALF + wr * 64 + m * 16 + fr;
                    const f32x4 a = acc[ai][0][m][n], li = acc[ai][1][m][n]; f32x4 gv;
#pragma unroll
                    for (int e = 0; e < 4; ++e) {
                        const float s1 = (fr == 15) ? ap[e] : a[e], s2 = (fr >= 14) ? ap[e] : a[e];
                        const float a1 = __shfl(s1, src1), a0 = __shfl(s2, src2);
                        gv[e] = silu_f(bb[e] + w0[e] * a0 + w1[e] * a1 + w2[e] * a[e]) * li[e];
                    }
                    if (m == 0 && fr < 2) {
                        *(f32x4*)(AF + ((size_t)strip * 2 + fr) * FF + fn) = a; *(f32x4*)(LF + ((size_t)strip * 2 + fr) * FF + fn) = li;
                    } else {
                        unsigned long long w = (unsigned long long)cvt_pk_bf16(gv[0], gv[1]) | ((unsigned long long)cvt_pk_bf16(gv[2], gv[3]) << 32);
                        *(unsigned long long*)(G + (size_t)row * FF + fn) = w;
                    }
                    if (m == 3 && fr >= 14) *(f32x4*)(AL + ((size_t)strip * 2 + (fr - 14)) * FF + fn) = a;
                    ap = a;
                    __builtin_amdgcn_sched_barrier(0);
                }
            }
        }
    }
};
template <class Epi, class Sched, bool ALIGN_EPI = false, bool SP2 = false>
__device__ __forceinline__ void gemm_phase(PG8_LAS unsigned char* lds, const Gemm g, const Sched& S, const Epi& E) {
    const int tid = otid(), wid = __builtin_amdgcn_readfirstlane(tid >> 6), lane = tid & 63, wr = wid >> 2, wc = wid & 3, fr = lane & 15, fq = lane >> 4;
    const int K = g.K, nt = K / BK;
    unsigned voffA[2], voffB[2];
#pragma unroll
    for (int i = 0; i < 2; ++i) { int R, C; stage_rc(tid * 16 + i * 8192, R, C); const int Rb = Epi::PERM ? ((R & ~31) + perm32(R & 31)) : R;
        voffA[i] = (unsigned)(R * K + C) * 2u; voffB[i] = (unsigned)(Rb * K + C) * 2u; }
    const size_t kstep = (size_t)(BK * 2);
    const size_t hstep = (size_t)HALF * K * 2;
    const size_t tstep = 2 * hstep;
    const unsigned ldsw = (unsigned)wid * 1024u;
    const int aoff = lds_byte(wr * 64 + fr, fq * 8), boff = lds_byte(wc * 32 + fr, fq * 8);
#define PG8_SA(b, h) (((b) * 2 + (h)) * HTB)
#define PG8_SB(b, h) ((4 + (b) * 2 + (h)) * HTB)
#define PG8_STAGE(bufoff, gbase, voff) do { _Pragma("unroll") for (int _i = 0; _i < 2; ++_i) \
        __builtin_amdgcn_global_load_lds((const unsigned*)((const char*)(gbase) + (voff)[_i]), (PG8_LAS unsigned*)(lds + (bufoff) + ldsw + _i * 8192), 16, 0, 0); } while (0)
#define PG8_LDA(dst, b, h) do { _Pragma("unroll") for (int m = 0; m < 4; ++m) _Pragma("unroll") for (int k = 0; k < 2; ++k) dst[m][k] = *(const PG8_LAS bf16x8*)(lds + PG8_SA(b, h) + aoff + m * 2048 + k * 1024); } while (0)
#define PG8_LDB(dst, b, h) do { _Pragma("unroll") for (int n = 0; n < 2; ++n) _Pragma("unroll") for (int k = 0; k < 2; ++k) dst[n][k] = *(const PG8_LAS bf16x8*)(lds + PG8_SB(b, h) + boff + n * 2048 + k * 1024); } while (0)
#define PG8_MMA(ai, bj, At, Bt) do { __builtin_amdgcn_s_setprio(1); _Pragma("unroll") for (int m = 0; m < 4; ++m) _Pragma("unroll") for (int n = 0; n < 2; ++n) _Pragma("unroll") for (int k = 0; k < 2; ++k) \
        acc[ai][bj][m][n] = __builtin_amdgcn_mfma_f32_16x16x32_bf16(Bt[n][k], At[m][k], acc[ai][bj][m][n], 0, 0, 0); __builtin_amdgcn_s_setprio(0); } while (0)
#define PG8_WAIT_V(n) asm volatile("s_waitcnt vmcnt(" #n ")" ::: "memory")
#define PG8_WAIT_L(n) asm volatile("s_waitcnt lgkmcnt(" #n ")" ::: "memory")
#define PG8_BAR __builtin_amdgcn_s_barrier()
#define PG8_SCHED __builtin_amdgcn_sched_barrier(0)
    Unit cur, nxt; int ui = 0;
    if (!S.next(0, cur)) return;
    f32x4 acc[2][2][4][2];
#pragma unroll
    for (int a = 0; a < 2; ++a)
#pragma unroll
        for (int b = 0; b < 2; ++b)
#pragma unroll
            for (int m = 0; m < 4; ++m)
#pragma unroll
                for (int n = 0; n < 2; ++n) acc[a][b][m][n] = (f32x4){0.f, 0.f, 0.f, 0.f};
    bf16x8 At[4][2], B0[2][2], B1[2][2];
    const char* cA = (const char*)g.A + (size_t)cur.pm * tstep; const char* cB = (const char*)g.Bt + (size_t)cur.pn * tstep;
    S.a_ready(cur);
    if constexpr (SP2) {
        PG8_STAGE(PG8_SB(0, 0), cB, voffB); PG8_STAGE(PG8_SB(0, 1), cB + hstep, voffB); PG8_STAGE(PG8_SA(0, 0), cA, voffA); PG8_STAGE(PG8_SA(0, 1), cA + hstep, voffA);
        if (wr == 1) PG8_BAR;
        PG8_WAIT_V(2); PG8_BAR;
        PG8_STAGE(PG8_SB(1, 0), cB + kstep, voffB); PG8_STAGE(PG8_SA(1, 0), cA + kstep, voffA); PG8_STAGE(PG8_SB(1, 1), cB + hstep + kstep, voffB);
        PG8_WAIT_V(6); PG8_BAR;
    } else {
        PG8_STAGE(PG8_SB(0, 0), cB, voffB); PG8_STAGE(PG8_SA(0, 0), cA, voffA); PG8_STAGE(PG8_SB(0, 1), cB + hstep, voffB); PG8_STAGE(PG8_SA(0, 1), cA + hstep, voffA);
        if (wr == 1) PG8_BAR;
        PG8_WAIT_V(4); PG8_BAR;
        PG8_STAGE(PG8_SB(1, 0), cB + kstep, voffB); PG8_STAGE(PG8_SA(1, 0), cA + kstep, voffA); PG8_STAGE(PG8_SB(1, 1), cB + hstep + kstep, voffB);
        PG8_WAIT_V(6); PG8_BAR;
    }
    for (;;) {
        const bool has_next = S.next(ui + 1, nxt);
        const char* nA = has_next ? (const char*)g.A + (size_t)nxt.pm * tstep : cA; const char* nB = has_next ? (const char*)g.Bt + (size_t)nxt.pn * tstep : cB;
        for (int t = 0; t < nt; t += 2) {
            const bool last = (t == nt - 2);
            const char* a1 = cA + (size_t)(t + 1) * kstep;
            const char* a2 = last ? nA : cA + (size_t)(t + 2) * kstep; const char* b2 = last ? nB : cB + (size_t)(t + 2) * kstep;
            const char* a3 = a2 + kstep; const char* b3 = b2 + kstep;
            if (last && has_next) S.a_ready(nxt);
            if constexpr (SP2) {
            PG8_LDB(B0, 0, 0); PG8_LDB(B1, 0, 1); PG8_SCHED; PG8_LDA(At, 0, 0); PG8_STAGE(PG8_SA(1, 1), a1 + hstep, voffA);
            PG8_WAIT_V(8); PG8_WAIT_L(0); PG8_BAR; PG8_MMA(0, 0, At, B0); PG8_MMA(0, 1, At, B1); PG8_BAR; PG8_SCHED;
            PG8_LDA(At, 0, 1); PG8_STAGE(PG8_SB(0, 0), b2, voffB); PG8_STAGE(PG8_SB(0, 1), b2 + hstep, voffB); PG8_STAGE(PG8_SA(0, 0), a2, voffA);
            PG8_WAIT_V(8); PG8_WAIT_L(0); PG8_BAR; PG8_MMA(1, 0, At, B0); PG8_MMA(1, 1, At, B1); PG8_BAR; PG8_SCHED;
            PG8_LDB(B0, 1, 0); PG8_LDB(B1, 1, 1); PG8_SCHED; PG8_LDA(At, 1, 0); PG8_STAGE(PG8_SA(0, 1), a2 + hstep, voffA);
            PG8_WAIT_V(8); PG8_WAIT_L(0); PG8_BAR; PG8_MMA(0, 0, At, B0); PG8_MMA(0, 1, At, B1); PG8_BAR; PG8_SCHED;
            PG8_LDA(At, 1, 1); PG8_STAGE(PG8_SB(1, 0), b3, voffB); PG8_STAGE(PG8_SB(1, 1), b3 + hstep, voffB); PG8_STAGE(PG8_SA(1, 0), a3, voffA);
            PG8_WAIT_V(8); PG8_WAIT_L(0); PG8_BAR; PG8_MMA(1, 0, At, B0); PG8_MMA(1, 1, At, B1); PG8_BAR; PG8_SCHED;
            } else {
            PG8_LDB(B0, 0, 0); PG8_SCHED; PG8_LDA(At, 0, 0); PG8_STAGE(PG8_SA(1, 1), a1 + hstep, voffA);
            PG8_WAIT_L(8); PG8_BAR; PG8_WAIT_L(0); PG8_MMA(0, 0, At, B0); PG8_BAR; PG8_SCHED;
            PG8_LDB(B1, 0, 1); PG8_STAGE(PG8_SB(0, 0), b2, voffB);
            PG8_BAR; PG8_WAIT_L(0); PG8_MMA(0, 1, At, B1); PG8_BAR;
            PG8_LDA(At, 0, 1); PG8_STAGE(PG8_SA(0, 0), a2, voffA);
            PG8_BAR; PG8_WAIT_L(0); PG8_MMA(1, 0, At, B0); PG8_BAR; PG8_SCHED;
            PG8_STAGE(PG8_SB(0, 1), b2 + hstep, voffB);
            PG8_WAIT_V(6); PG8_BAR; PG8_MMA(1, 1, At, B1); PG8_BAR;
            PG8_LDB(B0, 1, 0); PG8_SCHED; PG8_LDA(At, 1, 0); PG8_STAGE(PG8_SA(0, 1), a2 + hstep, voffA);
            PG8_WAIT_L(8); PG8_BAR; PG8_WAIT_L(0); PG8_MMA(0, 0, At, B0); PG8_BAR; PG8_SCHED;
            PG8_LDB(B1, 1, 1); PG8_STAGE(PG8_SB(1, 0), b3, voffB);
            PG8_BAR; PG8_WAIT_L(0); PG8_MMA(0, 1, At, B1); PG8_BAR;
            PG8_LDA(At, 1, 1); PG8_STAGE(PG8_SA(1, 0), a3, voffA);
            PG8_BAR; PG8_WAIT_L(0); PG8_MMA(1, 0, At, B0); PG8_BAR; PG8_SCHED;
            PG8_STAGE(PG8_SB(1, 1), b3 + hstep, voffB);
            PG8_WAIT_V(6); PG8_BAR; PG8_MMA(1, 1, At, B1); PG8_BAR;
            }
        }
        if constexpr (ALIGN_EPI) { if (wr == 0) PG8_BAR; }
        if constexpr (!Epi::AFTER_DRAIN) { E(acc, cur, wr, wc, fr, fq); S.done(cur); }
        if (!has_next) break;
#pragma unroll
        for (int a = 0; a < 2; ++a)
#pragma unroll
            for (int b = 0; b < 2; ++b)
#pragma unroll
                for (int m = 0; m < 4; ++m)
#pragma unroll
                    for (int n = 0; n < 2; ++n) acc[a][b][m][n] = (f32x4){0.f, 0.f, 0.f, 0.f};
        cur = nxt; cA = nA; cB = nB; ++ui;
        if constexpr (ALIGN_EPI) { if (wr == 1) PG8_BAR; }
    }
    PG8_WAIT_V(0);
    if constexpr (!ALIGN_EPI) { if (wr == 0) PG8_BAR; }
    PG8_BAR;
    if constexpr (Epi::AFTER_DRAIN) { E.fused(acc, cur, wr, wc, fr, fq, lds, wid, lane); S.done(cur); }
#undef PG8_SA
#undef PG8_SB
#undef PG8_STAGE
#undef PG8_LDA
#undef PG8_LDB
#undef PG8_MMA
#undef PG8_WAIT_V
#undef PG8_WAIT_L
#undef PG8_BAR
#undef PG8_SCHED
}
}
using pg8::bf16x8; using pg8::f32x4; using pg8::u32x4;
struct P {
    const float* in[26]; float* out; unsigned char* ws; int ph_lo, ph_hi, coop, pad;
};
#define INP(i) (p.in[(i) + opq0()])
#define WSB (p.ws + opq0())
#define OUTB (p.out + opq0())
#define MFMA32(a, b, c) __builtin_amdgcn_mfma_f32_32x32x16_bf16(a, b, c, 0, 0, 0)
#define MFMA16(a, b, c) __builtin_amdgcn_mfma_f32_16x16x32_bf16(a, b, c, 0, 0, 0)
typedef short v4i16_t __attribute__((ext_vector_type(4)));
__device__ __forceinline__ s16x4 trr(LAS const unsigned char* p) { return __builtin_bit_cast(s16x4, __builtin_amdgcn_ds_read_tr16_b64_v4i16((LAS v4i16_t*)p)); }

__device__ __forceinline__ void prep_tile(const float* src, int srcN, int K, const float* gain, us* dst, int kt, int n0dst, int n0src, LAS float* tile) {
    const int tid = otid();
#pragma unroll
    for (int i = 0; i < 8; ++i) { const int k = i * 8 + (tid >> 6), n = tid & 63; float v = src[(size_t)(kt * 64 + k) * srcN + n0src + n]; if (gain) v *= gain[kt * 64 + k]; tile[k * 65 + n] = v; }
    __syncthreads();
    const int n = tid >> 3, k8 = (tid & 7) * 8;
    u32x4 o; o.x = pk2(tile[(k8 + 0) * 65 + n], tile[(k8 + 1) * 65 + n]); o.y = pk2(tile[(k8 + 2) * 65 + n], tile[(k8 + 3) * 65 + n]);
    o.z = pk2(tile[(k8 + 4) * 65 + n], tile[(k8 + 5) * 65 + n]); o.w = pk2(tile[(k8 + 6) * 65 + n], tile[(k8 + 7) * 65 + n]);
    *(u32x4*)(dst + (size_t)(n0dst + n) * K + kt * 64 + k8) = o;
    __syncthreads();
}
__device__ __forceinline__ void prep_phase(const P& p, LAS unsigned char* lds) {
    LAS float* tile = (LAS float*)lds;
    constexpr int I_IN = 16 * 36, I_OUT = 16 * 16, I_UP = 16 * 88, I_DN = 44 * 16, I_MEM = 16 * 8, I_L = I_IN + I_OUT + I_UP + I_DN + I_MEM;
    for (int it = blockIdx.x; it < 2 * I_L; it += gridDim.x) {
        const int l = it / I_L; int r = it % I_L;
        if (r < I_IN) { const int kt = r / 36, nt = r % 36, nd = nt * 64; prep_tile(INP(10) + (size_t)l * DM * INC, INC, DM, INP(9) + l * DM, (us*)(WSB + WS_WIN) + (size_t)l * NIN * DM, kt, nd, nd < 1536 ? nd : nd + 8, tile); continue; } r -= I_IN;
        if (r < I_OUT) { const int kt = r / 16, nt = r % 16; prep_tile(INP(18) + (size_t)l * DM * DM, DM, DM, nullptr, (us*)(WSB + WS_WOUT) + (size_t)l * DM * DM, kt, nt * 64, nt * 64, tile); continue; } r -= I_OUT;
        if (r < I_UP) { const int kt = r / 88, nt = r % 88, nd = nt * 64, j = nd >> 8, w = nd & 255; prep_tile(INP(21) + (size_t)l * DM * NUP, NUP, DM, INP(20) + l * DM, (us*)(WSB + WS_WUP) + (size_t)l * NUP * DM, kt, nd, (w >> 7) * FF + 128 * j + (w & 127), tile); continue; } r -= I_UP;
        if (r < I_DN) { const int kt = r / 16, nt = r % 16; prep_tile(INP(24) + (size_t)l * FF * DM, DM, FF, nullptr, (us*)(WSB + WS_WDOWN) + (size_t)l * DM * FF, kt, nt * 64, nt * 64, tile); continue; } r -= I_DN;
        { const int kt = r / 8, nt = r % 8; prep_tile(INP(16) + (size_t)l * DM * 512, 512, DM, INP(15) + l * DM, (us*)(WSB + WS_WMEM) + (size_t)l * 512 * DM, kt, nt * 64, nt * 64, tile); }
    }
}

template <bool HAS_Y, bool DO_FG, bool WRITE_B>
__device__ __forceinline__ void row_pass(const float* xP, const float* xS, int nrows, float* xdst, const us* Y, const float* YSQ, const float* gpost,
                                         us* XB, float* RS, const float* win_l, const float* gpre, const float* bfg, float* lfP, float* lfS, LAS float* wfg) {
    const int tid_ = otid(), lane = tid_ & 63, wid = tid_ >> 6;
    if (DO_FG) {
        __syncthreads();
#pragma unroll
        for (int i = 0; i < 2; ++i) { const int k = tid_ + 512 * i; const float g = gpre[k];
            const f32x4 wa = *(const f32x4*)(win_l + (size_t)k * INC + 1536), wb = *(const f32x4*)(win_l + (size_t)k * INC + 1540);
            wfg[0 * 1028 + k] = g * wa[0]; wfg[1 * 1028 + k] = g * wa[1]; wfg[2 * 1028 + k] = g * wa[2]; wfg[3 * 1028 + k] = g * wa[3];
            wfg[4 * 1028 + k] = g * wb[0]; wfg[5 * 1028 + k] = g * wb[1]; wfg[6 * 1028 + k] = g * wb[2]; wfg[7 * 1028 + k] = g * wb[3]; }
        __syncthreads();
    }
    for (int row = blockIdx.x * 8 + wid; row < nrows; row += gridDim.x * 8) {
        const float* xr = (row < NTP) ? xP + (size_t)row * DM : xS + (size_t)(row - NTP) * DM;
        f32x4 v[4];
#pragma unroll
        for (int j = 0; j < 4; ++j) v[j] = *(const f32x4*)(xr + 4 * lane + 256 * j);
        if (HAS_Y) {
            const f32x4* q = (const f32x4*)(YSQ + (size_t)row * 16); const f32x4 a = q[0], b = q[1], c = q[2], d = q[3];
            const float ss = ((a[0] + a[1]) + (a[2] + a[3])) + ((b[0] + b[1]) + (b[2] + b[3])) + ((c[0] + c[1]) + (c[2] + c[3])) + ((d[0] + d[1]) + (d[2] + d[3]));
            const float ry = rsqrtf(ss * (1.f / DM) + EPS);
#pragma unroll
            for (int j = 0; j < 4; ++j) { const unsigned long long yw = *(const unsigned long long*)(Y + (size_t)row * DM + 4 * lane + 256 * j);
                const f32x4 y = {bf2f((unsigned)yw & 0xffffu), bf2f(((unsigned)yw) >> 16), bf2f((unsigned)(yw >> 32) & 0xffffu), bf2f((unsigned)(yw >> 48))}; const f32x4 g = *(const f32x4*)(gpost + 4 * lane + 256 * j); v[j] = v[j] + y * ry * g; }
        }
        if (xdst) {
#pragma unroll
            for (int j = 0; j < 4; ++j) *(f32x4*)(xdst + (size_t)row * DM + 4 * lane + 256 * j) = v[j];
        }
        if (WRITE_B) {
            float s = 0.f;
#pragma unroll
            for (int j = 0; j < 4; ++j) s += (v[j][0] * v[j][0] + v[j][1] * v[j][1]) + (v[j][2] * v[j][2] + v[j][3] * v[j][3]);
            const float rs = rsqrtf(wave_sum(s) * (1.f / DM) + EPS);
#pragma unroll
            for (int j = 0; j < 4; ++j) { unsigned long long o = (unsigned long long)pk2(v[j][0] * rs, v[j][1] * rs) | ((unsigned long long)pk2(v[j][2] * rs, v[j][3] * rs) << 32); *(unsigned long long*)(XB + (size_t)row * DM + 4 * lane + 256 * j) = o; }
            if (DO_FG) {
                float f[8];
#pragma unroll
                for (int h = 0; h < 8; ++h) { f[h] = 0.f;
#pragma unroll
                    for (int j = 0; j < 4; ++j) { const f32x4 w = *(LAS const f32x4*)(wfg + h * 1028 + 4 * lane + 256 * j); f[h] += (v[j][0] * w[0] + v[j][1] * w[1]) + (v[j][2] * w[2] + v[j][3] * w[3]); } }
#pragma unroll
                for (int h = 0; h < 8; ++h) f[h] = wave_sum(f[h]);
                if (lane < 8) {
                    float z = 0.f;
#pragma unroll
                    for (int h = 0; h < 8; ++h) if (lane == h) z = f[h];
                    z = z * rs + bfg[lane];
                    const float lf = fminf(z, 0.f) - log1pf(__expf(-fabsf(z)));
                    if (row < NTP) lfP[(size_t)row * 8 + lane] = lf; else lfS[(size_t)(row - NTP) * 8 + lane] = lf;
                }
            }
        }
    }
}

constexpr int KPB = 144, VPB = 192, FL_V0 = 64 * KPB, FL_BUF = 64 * KPB + 64 * VPB, FL_BIAS = 2 * FL_BUF, FL_MISC = FL_BIAS + 2048 * 4;
__device__ __forceinline__ void flash_unit(LAS unsigned char* lds, const us* Q, int qp, const us* K, int kp, const us* V, int vp, us* O, int op, int ntiles, int band, bool use_bias) {
    const int tid = otid(), lane = tid & 63, wid = tid >> 6, r32 = lane & 31, hi = lane >> 5;
    bf16x8 qf[4];
#pragma unroll
    for (int d0 = 0; d0 < 4; ++d0) qf[d0] = *(const bf16x8*)(Q + (size_t)(wid * 32 + r32) * qp + d0 * 16 + hi * 8);
    const int srow = tid >> 3, sch = tid & 7;
    const us* kg = K + (size_t)srow * kp + sch * 8; const us* vg = V + (size_t)srow * vp + sch * 8;
    u32x4 kreg = *(const u32x4*)kg, vreg = *(const u32x4*)vg;
    *(LAS u32x4*)(lds + srow * KPB + sch * 16) = kreg; *(LAS u32x4*)(lds + FL_V0 + srow * VPB + sch * 16) = vreg;
    __syncthreads();
    f32x16 o0 = {}, o1 = {}; float mrun = -1e30f, lrun = 0.f;
    const int qrel = wid * 32 + r32;
    LAS const float* bias = (LAS const float*)(lds + FL_BIAS);
    for (int t = 0; t < ntiles; ++t) {
        const int cur = (t & 1) * FL_BUF, nxt = FL_BUF - cur;
        if (t + 1 < ntiles) { kreg = *(const u32x4*)(kg + (size_t)(t + 1) * 64 * kp); vreg = *(const u32x4*)(vg + (size_t)(t + 1) * 64 * vp); }
        const int jb = band ? t - (ntiles - band) : -1;
        const bool skip = (jb >= 0) && (64 * jb > wid * 32 + 31);
        if (!skip) {
            f32x16 p0 = {}, p1 = {};
            if (use_bias) {
                LAS const float* bp = bias + 64 * t + 4 * hi;
#pragma unroll
                for (int g = 0; g < 4; ++g) { const f32x4 b0 = *(LAS const f32x4*)(bp + 8 * g), b1 = *(LAS const f32x4*)(bp + 32 + 8 * g);
#pragma unroll
                    for (int i = 0; i < 4; ++i) { p0[4 * g + i] = b0[i]; p1[4 * g + i] = b1[i]; } }
            }
            LAS const unsigned char* kb = lds + cur + r32 * KPB + hi * 16;
#pragma unroll
            for (int d0 = 0; d0 < 4; ++d0) {
                const bf16x8 a0 = *(LAS const bf16x8*)(kb + d0 * 32), a1 = *(LAS const bf16x8*)(kb + 32 * KPB + d0 * 32);
                p0 = MFMA32(a0, qf[d0], p0); p1 = MFMA32(a1, qf[d0], p1);
            }
            if (jb >= 0) {
                const int qb4 = qrel - 64 * jb - 4 * hi; const int NEGB = __builtin_bit_cast(int, -1e30f);
#pragma unroll
                for (int r = 0; r < 16; ++r) { const int t0 = qb4 - ((r & 3) + 8 * (r >> 2)), m0 = t0 >> 31, m1 = (t0 - 32) >> 31;
                    const float x0 = p0[r], x1 = p1[r]; p0[r] = __int_as_float((__float_as_int(x0) & ~m0) | (NEGB & m0)); p1[r] = __int_as_float((__float_as_int(x1) & ~m1) | (NEGB & m1)); }
            }
            float mx = fmaxf(p0[0], p1[0]);
#pragma unroll
            for (int r = 1; r < 16; ++r) mx = fmaxf(mx, fmaxf(p0[r], p1[r]));
            mx = fmaxf(mx, __shfl_xor(mx, 32));
            const float mn = fmaxf(mrun, mx), alpha = __builtin_amdgcn_exp2f(mrun - mn); mrun = mn;
            lrun *= alpha; o0 = o0 * alpha; o1 = o1 * alpha;
            float ls = 0.f;
#pragma unroll
            for (int r = 0; r < 16; ++r) { p0[r] = __builtin_amdgcn_exp2f(p0[r] - mn); p1[r] = __builtin_amdgcn_exp2f(p1[r] - mn); ls += p0[r] + p1[r]; }
            lrun += ls;
            u32x4 pw[4];
#pragma unroll
            for (int s = 0; s < 2; ++s) {
                pw[s] = (u32x4){pg8::cvt_pk_bf16(p0[8 * s], p0[8 * s + 1]), pg8::cvt_pk_bf16(p0[8 * s + 2], p0[8 * s + 3]), pg8::cvt_pk_bf16(p0[8 * s + 4], p0[8 * s + 5]), pg8::cvt_pk_bf16(p0[8 * s + 6], p0[8 * s + 7])};
                pw[2 + s] = (u32x4){pg8::cvt_pk_bf16(p1[8 * s], p1[8 * s + 1]), pg8::cvt_pk_bf16(p1[8 * s + 2], p1[8 * s + 3]), pg8::cvt_pk_bf16(p1[8 * s + 4], p1[8 * s + 5]), pg8::cvt_pk_bf16(p1[8 * s + 6], p1[8 * s + 7])};
            }
            LAS const unsigned char* vb = lds + cur + FL_V0 + (4 * hi + ((lane & 15) >> 2)) * VPB + (((lane >> 4) & 1) * 16 + (lane & 3) * 4) * 2;
#pragma unroll
            for (int ks = 0; ks < 4; ++ks) {
                const s16x4 l0 = trr(vb + (16 * ks) * VPB), h0 = trr(vb + (16 * ks + 8) * VPB), l1 = trr(vb + (16 * ks) * VPB + 64), h1 = trr(vb + (16 * ks + 8) * VPB + 64);
                const bf16x8 a0 = (bf16x8){l0[0], l0[1], l0[2], l0[3], h0[0], h0[1], h0[2], h0[3]}, a1 = (bf16x8){l1[0], l1[1], l1[2], l1[3], h1[0], h1[1], h1[2], h1[3]};
                const bf16x8 pf = __builtin_bit_cast(bf16x8, pw[ks]);
                o0 = MFMA32(a0, pf, o0); o1 = MFMA32(a1, pf, o1);
            }
        }
        if (t + 1 < ntiles) { *(LAS u32x4*)(lds + nxt + srow * KPB + sch * 16) = kreg; *(LAS u32x4*)(lds + nxt + FL_V0 + srow * VPB + sch * 16) = vreg; }
        __syncthreads();
    }
    lrun += __shfl_xor(lrun, 32);
    const float inv = 1.f / lrun;
    us* orow = O + (size_t)(wid * 32 + r32) * op;
#pragma unroll
    for (int g = 0; g < 4; ++g) {
        const int d0 = 8 * g + 4 * hi;
        unsigned long long w0 = (unsigned long long)pk2(o0[4 * g] * inv, o0[4 * g + 1] * inv) | ((unsigned long long)pk2(o0[4 * g + 2] * inv, o0[4 * g + 3] * inv) << 32);
        unsigned long long w1 = (unsigned long long)pk2(o1[4 * g] * inv, o1[4 * g + 1] * inv) | ((unsigned long long)pk2(o1[4 * g + 2] * inv, o1[4 * g + 3] * inv) << 32);
        *(unsigned long long*)(orow + d0) = w0; *(unsigned long long*)(orow + 32 + d0) = w1;
    }
}
template <class F> __device__ __forceinline__ void block_cumsum(LAS float* dst, LAS float* wtot, int n, F f) {
    const int tid = otid(), lane = tid & 63, wid = tid >> 6;
    float a[4];
#pragma unroll
    for (int i = 0; i < 4; ++i) { const int j = 4 * tid + i; a[i] = (j < n) ? f(j) : 0.f; }
    const float s = (a[0] + a[1]) + (a[2] + a[3]);
    float sc = s;
#pragma unroll
    for (int o = 1; o < 64; o <<= 1) { const float t = __shfl_up(sc, o); if (lane >= o) sc += t; }
    if (lane == 63) wtot[wid] = sc;
    __syncthreads();
    float off = 0.f;
    for (int w = 0; w < wid; ++w) off += wtot[w];
    float c = off + sc - s;
#pragma unroll
    for (int i = 0; i < 4; ++i) { c += a[i]; const int j = 4 * tid + i; if (j < 2048) dst[j] = -c * LOG2E; }
    __syncthreads();
}
constexpr int ZPB = 576, WPB = 272, SG_W = 128 * ZPB, SG_RS = SG_W + 128 * WPB;
__device__ __forceinline__ void sgu_unit(LAS unsigned char* lds, int R0, const us* ZB, const us* UB, us* CAT, const float* ws_l, const float* bs_l, const float* gs_l) {
    const int tid = otid(), lane = tid & 63, wid = tid >> 6, r32 = lane & 31, hi = lane >> 5;
#pragma unroll
    for (int i = 0; i < 8; ++i) { const int idx = tid + 512 * i, row = idx >> 5, ch = idx & 31; *(LAS u32x4*)(lds + row * ZPB + ch * 16) = *(const u32x4*)(ZB + (size_t)(R0 + row) * 256 + ch * 8); }
    __syncthreads();
    { const int row = tid >> 2, q = tid & 3; float ss = 0.f;
#pragma unroll
      for (int i = 0; i < 8; ++i) { const u32x4 w = *(LAS const u32x4*)(lds + row * ZPB + q * 128 + i * 16);
#pragma unroll
          for (int e = 0; e < 4; ++e) { const float a = bf2f(w[e] & 0xffffu), b = bf2f(w[e] >> 16); ss += a * a + b * b; } }
      ss += __shfl_xor(ss, 1); ss += __shfl_xor(ss, 2);
      if (q == 0) ((LAS float*)(lds + SG_RS))[row] = rsqrtf(ss * (1.f / 256.f) + EPS); }
    __syncthreads();
    LAS const float* rsz = (LAS const float*)(lds + SG_RS);
#pragma unroll 1
    for (int g = 0; g < 4; ++g) {
#pragma unroll
        for (int i = 0; i < 4; ++i) { const int idx = tid + 512 * i, row = idx >> 4, ch = idx & 15;
            const float* wp = ws_l + (size_t)g * 16384 + row * 128 + ch * 8; f32x4 a = *(const f32x4*)wp, b = *(const f32x4*)(wp + 4);
            const bool z = (ch >= 8) && (row < 64);
            u32x4 o;
            if (z) o = (u32x4){0u, 0u, 0u, 0u};
            else { const int j0 = ch * 8; o.x = pk2(a[0] * rsz[j0], a[1] * rsz[j0 + 1]); o.y = pk2(a[2] * rsz[j0 + 2], a[3] * rsz[j0 + 3]); o.z = pk2(b[0] * rsz[j0 + 4], b[1] * rsz[j0 + 5]); o.w = pk2(b[2] * rsz[j0 + 6], b[3] * rsz[j0 + 7]); }
            *(LAS u32x4*)(lds + SG_W + row * WPB + ch * 16) = o; }
        __syncthreads();
        const int ib = wid & 3, chh = wid >> 2, cbase = g * 64 + 32 * chh;
        f32x16 acc = {};
        LAS const unsigned char* ap = lds + SG_W + (32 * ib + r32) * WPB + hi * 16;
        LAS const unsigned char* bp = lds + (8 * hi + ((lane & 15) >> 2)) * ZPB + (cbase + 16 * ((lane >> 4) & 1) + 4 * (lane & 3)) * 2;
#pragma unroll
        for (int ks = 0; ks < 8; ++ks) {
            const bf16x8 a = *(LAS const bf16x8*)(ap + ks * 32);
            const s16x4 l0 = trr(bp + (16 * ks) * ZPB), h0 = trr(bp + (16 * ks + 4) * ZPB);
            const bf16x8 b = (bf16x8){l0[0], l0[1], l0[2], l0[3], h0[0], h0[1], h0[2], h0[3]};
            acc = MFMA32(a, b, acc);
        }
        const int c = cbase + r32; const float gs = gs_l[c];
#pragma unroll
        for (int r = 0; r < 16; ++r) { const int i = 32 * ib + (r & 3) + 8 * (r >> 2) + 4 * hi;
            const float mixed = gs * acc[r] + bs_l[g * 128 + i]; const float u = bf2f(UB[(size_t)(R0 + i) * 256 + c]);
            CAT[(size_t)(R0 + i) * DM + 512 + c] = (us)f2bf(u * mixed); }
        __syncthreads();
    }
}
__device__ __forceinline__ void sgu_sample_unit(LAS unsigned char* lds, int b, const us* ZB, const us* UB, us* CAT, const float* ws_l, const float* bs_l, const float* gs_l, float* outv) {
    const int tid = otid(), R0 = NTP + 16 * b;
    LAS float* z = (LAS float*)lds; LAS float* rsz = z + 16 * 256;
    for (int i = tid; i < 4096; i += 512) z[i] = bf2f(ZB[(size_t)R0 * 256 + i]);
    __syncthreads();
    { const int row = tid >> 5, q = tid & 31; float ss = 0.f;
      for (int i = 0; i < 8; ++i) { const float a = z[row * 256 + q + 32 * i]; ss += a * a; }
      ss += __shfl_xor(ss, 1); ss += __shfl_xor(ss, 2); ss += __shfl_xor(ss, 4); ss += __shfl_xor(ss, 8); ss += __shfl_xor(ss, 16);
      if (q == 0) rsz[row] = rsqrtf(ss * (1.f / 256.f) + EPS); }
    __syncthreads();
    for (int o = tid; o < 4096; o += 512) {
        const int i = o >> 8, c = o & 255, g = c >> 6; const float gs = gs_l[c];
        float acc = 0.f;
#pragma unroll
        for (int j = 0; j < 16; ++j) acc += ws_l[(size_t)g * 16384 + i * 128 + j] * rsz[j] * z[j * 256 + c];
        const float mixed = gs * acc + bs_l[g * 128 + i]; const float u = bf2f(UB[(size_t)(R0 + i) * 256 + c]);
        CAT[(size_t)(R0 + i) * DM + 512 + c] = (us)f2bf(u * mixed);
        outv[(size_t)(16 * b + i) * 256 + c] = z[i * 256 + c] * rsz[i] * gs;
    }
    __syncthreads();
}
constexpr int SA_SC = 4096, SA_NKMAX = 1056, SA_BIAS = SA_SC + SA_NKMAX * 17 * 4 + 896, SA_MISC = SA_BIAS + 2048 * 4, SA_RED = SA_MISC + 1024;
__device__ __forceinline__ void small_attn(LAS unsigned char* lds, const us* Q, int qp, const float* Kc, const float* Vc, int cp, int ncache, const float* Kn, const float* Vn, int np, int nnew,
                                           const float* lfc, const float* lfn, bool fox, us* O, int op) {
    const int tid = otid(), lane = tid & 63, wid = tid >> 6;
    const int nk = ncache + nnew, nkb = (nk + 15) >> 4;
    LAS float* SC = (LAS float*)(lds + SA_SC); LAS float* bias = (LAS float*)(lds + SA_BIAS); LAS float* misc = (LAS float*)(lds + SA_MISC); LAS float* red = (LAS float*)(lds + SA_RED);
    if (tid < 128) { const int row = tid >> 3, ch = tid & 7; *(LAS u32x4*)(lds + row * 144 + ch * 16) = *(const u32x4*)(Q + (size_t)row * qp + ch * 8); }
    if (fox) block_cumsum(bias, misc, nk, [&](int j) { return j < ncache ? lfc[(size_t)j * 8] : lfn[(size_t)(j - ncache) * 8]; });
    else __syncthreads();
    { const int kl = lane & 15, kq = lane >> 4;
#pragma unroll 3
      for (int kb = wid; kb < nkb; kb += 8) {
        const int key = kb * 16 + kl; const bool valid = key < nk; const int kk = valid ? key : 0;
        const float* src = (kk < ncache) ? Kc + (size_t)kk * cp : Kn + (size_t)(kk - ncache) * np;
        f32x4 acc = {0.f, 0.f, 0.f, 0.f};
#pragma unroll
        for (int s = 0; s < 2; ++s) {
            const f32x4 x0 = *(const f32x4*)(src + 32 * s + 8 * kq), x1 = *(const f32x4*)(src + 32 * s + 8 * kq + 4);
            const u32x4 bw = (u32x4){pk2(x0[0], x0[1]), pk2(x0[2], x0[3]), pk2(x1[0], x1[1]), pk2(x1[2], x1[3])};
            const bf16x8 a = *(LAS const bf16x8*)(lds + kl * 144 + (32 * s + 8 * kq) * 2);
            acc = MFMA16(a, __builtin_bit_cast(bf16x8, bw), acc);
        }
        const float bj = fox ? bias[key] : 0.f;
#pragma unroll
        for (int r = 0; r < 4; ++r) { const int qrow = 4 * kq + r; float sv = acc[r] + bj; if (!valid || (fox && key > ncache + qrow)) sv = -1e30f; SC[key * 17 + qrow] = sv; }
      } }
    __syncthreads();
#pragma unroll
    for (int rr = 0; rr < 2; ++rr) { const int row = 2 * wid + rr; float mx = -1e30f;
        for (int j = lane; j < nkb * 16; j += 64) mx = fmaxf(mx, SC[j * 17 + row]);
#pragma unroll
        for (int o = 1; o < 64; o <<= 1) mx = fmaxf(mx, __shfl_xor(mx, o));
        float sum = 0.f;
        for (int j = lane; j < nkb * 16; j += 64) { const float e = __builtin_amdgcn_exp2f(SC[j * 17 + row] - mx); SC[j * 17 + row] = e; sum += e; }
        sum = wave_sum(sum);
        if (lane == 0) misc[16 + row] = 1.f / sum; }
    __syncthreads();
    {
      const int d = lane, kpw = (nk + 7) >> 3, j0 = wid * kpw, j1 = min(nk, j0 + kpw), jc = min(j1, ncache);
      float acc[16];
#pragma unroll
      for (int i = 0; i < 16; ++i) acc[i] = 0.f;
#pragma unroll 8
      for (int j = j0; j < jc; ++j) { const float v = Vc[(size_t)j * cp + d]; LAS const float* pj = SC + j * 17;
#pragma unroll
          for (int i = 0; i < 16; ++i) acc[i] += pj[i] * v; }
      for (int j = max(j0, ncache); j < j1; ++j) { const float v = Vn[(size_t)(j - ncache) * np + d]; LAS const float* pj = SC + j * 17;
#pragma unroll
          for (int i = 0; i < 16; ++i) acc[i] += pj[i] * v; }
#pragma unroll
      for (int i = 0; i < 16; ++i) red[(wid * 16 + i) * 64 + d] = acc[i]; }
    __syncthreads();
    { const int d = lane, r0 = 2 * wid; float a0 = 0.f, a1 = 0.f;
#pragma unroll
      for (int w = 0; w < 8; ++w) { a0 += red[(w * 16 + r0) * 64 + d]; a1 += red[(w * 16 + r0 + 1) * 64 + d]; }
      O[(size_t)r0 * op + d] = (us)f2bf(a0 * misc[16 + r0]); O[(size_t)(r0 + 1) * op + d] = (us)f2bf(a1 * misc[17 + r0]); }
    __syncthreads();
}
#ifdef DBG_FOX
__device__ __forceinline__ void dbg_fox(const P& p, int l) {
    const us* QBp = (const us*)(WSB + WS_QB); const us* KBp = (const us*)(WSB + WS_KB); const us* VBp = (const us*)(WSB + WS_VB); us* CATp = (us*)(WSB + WS_CAT);
    const float* lf = OUTB + O_PLF + (size_t)l * NTP * 8;
    for (int id = blockIdx.x * 512 + otid(); id < 131072; id += gridDim.x * 512) {
        const int q = id & 2047, bh = id >> 11, b = bh >> 3, h = bh & 7;
        if ((FQM >> (q >> 8)) & 1) continue;
        float qv[64], o[64];
#pragma unroll
        for (int c8 = 0; c8 < 8; ++c8) { const u32x4 w = *(const u32x4*)(QBp + ((size_t)b * SEQ + q) * 512 + h * 64 + c8 * 8);
#pragma unroll
            for (int e = 0; e < 4; ++e) { qv[c8 * 8 + 2 * e] = bf2f(w[e] & 0xffffu); qv[c8 * 8 + 2 * e + 1] = bf2f(w[e] >> 16); } }
#pragma unroll
        for (int d = 0; d < 64; ++d) o[d] = 0.f;
        float m = -1e30f, ls = 0.f, c = 0.f;
        for (int j = 0; j <= q; ++j) {
            c += lf[((size_t)b * SEQ + j) * 8 + h] * LOG2E;
            const us* kr = KBp + ((size_t)b * SEQ + j) * 512 + h * 64; const us* vr = VBp + ((size_t)b * SEQ + j) * 512 + h * 64;
            float s = 0.f;
#pragma unroll
            for (int c8 = 0; c8 < 8; ++c8) { const u32x4 w = *(const u32x4*)(kr + c8 * 8);
#pragma unroll
                for (int e = 0; e < 4; ++e) { s += qv[c8 * 8 + 2 * e] * bf2f(w[e] & 0xffffu) + qv[c8 * 8 + 2 * e + 1] * bf2f(w[e] >> 16); } }
            s -= c;
            const float mn = fmaxf(m, s), al = __builtin_amdgcn_exp2f(m - mn), pj = __builtin_amdgcn_exp2f(s - mn); m = mn; ls = ls * al + pj;
#pragma unroll
            for (int c8 = 0; c8 < 8; ++c8) { const u32x4 w = *(const u32x4*)(vr + c8 * 8);
#pragma unroll
                for (int e = 0; e < 4; ++e) { o[c8 * 8 + 2 * e] = o[c8 * 8 + 2 * e] * al + pj * bf2f(w[e] & 0xffffu); o[c8 * 8 + 2 * e + 1] = o[c8 * 8 + 2 * e + 1] * al + pj * bf2f(w[e] >> 16); } }
        }
        const float inv = 1.f / ls;
#pragma unroll
        for (int c8 = 0; c8 < 8; ++c8) { u32x4 w;
#pragma unroll
            for (int e = 0; e < 4; ++e) w[e] = pk2(o[c8 * 8 + 2 * e] * inv, o[c8 * 8 + 2 * e + 1] * inv);
            *(u32x4*)(CATp + ((size_t)b * SEQ + q) * DM + h * 64 + c8 * 8) = w; }
    }
}
#endif
__device__ __forceinline__ void attn_phase(const P& p, LAS unsigned char* lds, int l) {
    const int G = gridDim.x, bx = blockIdx.x, vcu = (G % 8 == 0) ? (bx % 8) * (G / 8) + bx / 8 : bx;
#define A_QB ((const us*)(WSB + WS_QB))
#define A_KB ((const us*)(WSB + WS_KB))
#define A_VB ((const us*)(WSB + WS_VB))
#define A_UB ((const us*)(WSB + WS_UB))
#define A_ZB ((const us*)(WSB + WS_ZB))
#define A_QMB ((const us*)(WSB + WS_QMB))
#define A_MKV ((const us*)(WSB + WS_MKV) + (size_t)l * NMEMROWS * 512)
#define A_CAT ((us*)(WSB + WS_CAT))
#define A_WS (INP(12) + (size_t)l * 4 * 16384)
#define A_BS (INP(13) + (size_t)l * 512)
#define A_GS (INP(14) + (size_t)l * 256)
#ifdef DBG_FOX
    dbg_fox(p, l);
#endif
    for (int v = vcu; v < 256; v += G) {
        const int bh = v >> 2, s = v & 3, b = bh >> 3, h = bh & 7;
#pragma unroll 1
        for (int k = 0; k < 2; ++k) { const int qb = k ? 7 - s : s;
#ifdef DBG_FOX
            if (!((FQM >> qb) & 1)) continue;
#endif
            const float* lfP = OUTB + O_PLF + (size_t)l * NTP * 8 + (size_t)b * SEQ * 8 + h;
            block_cumsum((LAS float*)(lds + FL_BIAS), (LAS float*)(lds + FL_MISC), 256 * (qb + 1), [&](int j) { return lfP[(size_t)j * 8]; });
            flash_unit(lds, A_QB + ((size_t)b * SEQ + qb * 256) * 512 + h * 64, 512, A_KB + (size_t)b * SEQ * 512 + h * 64, 512, A_VB + (size_t)b * SEQ * 512 + h * 64, 512,
                       A_CAT + ((size_t)b * SEQ + qb * 256) * DM + h * 64, DM, 4 * (qb + 1), 4, true); }
    }
    for (int v = vcu; v < 256; v += G) { const int bh = v >> 3, qb = v & 7, b = bh >> 2, h = bh & 3; const us* mkv = A_MKV + (size_t)b * 256 * 512 + h * 64;
        flash_unit(lds, A_QMB + ((size_t)b * SEQ + qb * 256) * 256 + h * 64, 256, mkv, 512, mkv + 256, 512,
                   A_CAT + ((size_t)b * SEQ + qb * 256) * DM + 768 + h * 64, DM, 4, 0, false); }
    for (int v = G - 1 - vcu; v < 128; v += G) sgu_unit(lds, v * 128, A_ZB, A_UB, A_CAT, A_WS, A_BS, A_GS);
    for (int v = vcu; v < 128; v += G) { const int b = v >> 3, h = v & 7; const size_t co = ((size_t)(l * NBS + b) * PAST) * 512 + h * 64, no = ((size_t)l * NTS + 16 * b) * 512 + h * 64;
        small_attn(lds, A_QB + (size_t)(NTP + 16 * b) * 512 + h * 64, 512, INP(3) + co, INP(4) + co, 512, PAST, OUTB + O_SK + no, OUTB + O_SV + no, 512, 16,
                   INP(5) + ((size_t)(l * NBS + b) * PAST) * 8 + h, OUTB + O_SLF + (size_t)l * NTS * 8 + (size_t)(16 * b) * 8 + h, true, A_CAT + (size_t)(NTP + 16 * b) * DM + h * 64, DM); }
    for (int v = G - 1 - vcu; v < 64; v += G) { const int b = v >> 2, h = v & 3; const size_t co = ((size_t)(l * NBS + b) * 256) * 256 + h * 64;
        small_attn(lds, A_QMB + (size_t)(NTP + 16 * b) * 256 + h * 64, 256, INP(6) + co, INP(7) + co, 256, 256,
                   nullptr, nullptr, 0, 0, nullptr, nullptr, false, A_CAT + (size_t)(NTP + 16 * b) * DM + 768 + h * 64, DM); }
    for (int v = vcu - 128; v >= 0 && v < 16; v += G) sgu_sample_unit(lds, v, A_ZB, A_UB, A_CAT, A_WS, A_BS, A_GS, OUTB + O_SGV + (size_t)l * NTS * 256);
}
__device__ __forceinline__ void gnorm_phase(const P& p, int l) {
    const int tid_ = otid(), lane = tid_ & 63, wid = tid_ >> 6; us* CAT = (us*)(WSB + WS_CAT); const float* gg = INP(17) + (size_t)l * DM;
    for (int row = blockIdx.x * 8 + wid; row < NT; row += gridDim.x * 8) {
        u32x4* rp = (u32x4*)(CAT + (size_t)row * DM + 16 * lane); const u32x4 w0 = rp[0], w1 = rp[1];
        float v[16];
#pragma unroll
        for (int e = 0; e < 4; ++e) { v[2 * e] = bf2f(w0[e] & 0xffffu); v[2 * e + 1] = bf2f(w0[e] >> 16); v[8 + 2 * e] = bf2f(w1[e] & 0xffffu); v[8 + 2 * e + 1] = bf2f(w1[e] >> 16); }
        float ss = 0.f;
#pragma unroll
        for (int e = 0; e < 16; ++e) ss += v[e] * v[e];
        ss += __shfl_xor(ss, 1); ss += __shfl_xor(ss, 2); ss += __shfl_xor(ss, 4); ss += __shfl_xor(ss, 8);
        const float s16 = __shfl_xor(ss, 16); float wdt = 256.f; if (lane < 32) { ss += s16; wdt = 512.f; }
        const float r = rsqrtf(ss / wdt + EPS);
        const f32x4 g0 = *(const f32x4*)(gg + 16 * lane), g1 = *(const f32x4*)(gg + 16 * lane + 4), g2 = *(const f32x4*)(gg + 16 * lane + 8), g3 = *(const f32x4*)(gg + 16 * lane + 12);
        u32x4 o0, o1;
        o0.x = pk2(v[0] * r * g0[0], v[1] * r * g0[1]); o0.y = pk2(v[2] * r * g0[2], v[3] * r * g0[3]); o0.z = pk2(v[4] * r * g1[0], v[5] * r * g1[1]); o0.w = pk2(v[6] * r * g1[2], v[7] * r * g1[3]);
        o1.x = pk2(v[8] * r * g2[0], v[9] * r * g2[1]); o1.y = pk2(v[10] * r * g2[2], v[11] * r * g2[3]); o1.z = pk2(v[12] * r * g3[0], v[13] * r * g3[1]); o1.w = pk2(v[14] * r * g3[2], v[15] * r * g3[3]);
        rp[0] = o0; rp[1] = o1;
    }
}
__device__ __forceinline__ void fix_panel(const P& p, int l, int pm) {
    const float* wdw = INP(22) + (size_t)l * 3 * FF; const float* bdw = INP(23) + (size_t)l * FF;
    const float* AF = (const float*)(WSB + WS_AF); const float* LF = (const float*)(WSB + WS_LF); const float* AL = (const float*)(WSB + WS_AL); us* G = (us*)(WSB + WS_G);
#pragma unroll 2
    for (int i = otid(); i < 8 * (FF / 4); i += 512) { const int f = (i % (FF / 4)) * 4, q = i / (FF / 4), rr = q & 1, s = 4 * pm + (q >> 1), sr = 2 * s + rr;
        const bool first = (s & 31) == 0; const f32x4 z = {0.f, 0.f, 0.f, 0.f};
        const f32x4 l0 = first ? z : *(const f32x4*)(AL + ((size_t)(s - 1) * 2) * FF + f), l1 = first ? z : *(const f32x4*)(AL + ((size_t)(s - 1) * 2 + 1) * FF + f);
        const f32x4 a2 = *(const f32x4*)(AF + (size_t)sr * FF + f), a1 = rr ? *(const f32x4*)(AF + ((size_t)s * 2) * FF + f) : l1, a0 = rr ? l1 : l0;
        const f32x4 w0 = *(const f32x4*)(wdw + f), w1 = *(const f32x4*)(wdw + FF + f), w2 = *(const f32x4*)(wdw + 2 * FF + f), bb = *(const f32x4*)(bdw + f), li = *(const f32x4*)(LF + (size_t)sr * FF + f);
        f32x4 g;
#pragma unroll
        for (int e = 0; e < 4; ++e) g[e] = silu_f(bb[e] + w0[e] * a0[e] + w1[e] * a1[e] + w2[e] * a2[e]) * li[e];
        *(unsigned long long*)(G + ((size_t)s * 64 + rr) * FF + f) = (unsigned long long)pk2(g[0], g[1]) | ((unsigned long long)pk2(g[2], g[3]) << 32); }
}
__device__ __forceinline__ void conv_state_out(const P& p, int l) {
    const float* AL = (const float*)(WSB + WS_AL);
    const int gt = blockIdx.x * 512 + otid(), gn = gridDim.x * 512;
    float* oc = OUTB + O_PCONV + (size_t)l * NBP * 2 * FF;
    for (int i = gt; i < NBP * 2 * FF; i += gn) { const int f = i % FF, br = i / FF, b = br >> 1, rr = br & 1; oc[i] = AL[((size_t)(32 * b + 31) * 2 + rr) * FF + f]; }
}
__device__ __forceinline__ void small_gemm(LAS unsigned char* lds, const us* A  , const us* Bt, int K, us* Y, float* YSQ) {
    const int tid = otid(), lane = tid & 63, wid = tid >> 6, cg4 = wid & 3, kh = wid >> 2, rl = lane & 15, kq = lane >> 4;
    LAS float* xch = (LAS float*)lds;
    for (int it = blockIdx.x; it < 256; it += gridDim.x) {
        const int rb = it >> 4, cb = it & 15;
        const us* ap = A + (size_t)(rb * 16 + rl) * K + kh * (K / 2) + 8 * kq; const us* bp = Bt + (size_t)(cb * 64 + cg4 * 16 + rl) * K + kh * (K / 2) + 8 * kq;
        f32x4 acc = {0.f, 0.f, 0.f, 0.f};
#pragma unroll 8
        for (int k = 0; k < K / 2; k += 32) acc = MFMA16(*(const bf16x8*)(ap + k), *(const bf16x8*)(bp + k), acc);
        if (kh == 1) *(LAS f32x4*)(xch + (cg4 * 64 + lane) * 4) = acc;
        __syncthreads();
        if (kh == 0) {
            acc = acc + *(LAS const f32x4*)(xch + (cg4 * 64 + lane) * 4);
            const int col = cb * 64 + cg4 * 16 + rl;
#pragma unroll
            for (int r = 0; r < 4; ++r) { const int row = rb * 16 + 4 * kq + r; Y[(size_t)row * DM + col] = (us)f2bf(acc[r]);
                float ss = acc[r] * acc[r]; ss += __shfl_xor(ss, 1); ss += __shfl_xor(ss, 2); ss += __shfl_xor(ss, 4); ss += __shfl_xor(ss, 8);
                if (rl == 0) xch[1024 + cg4 * 16 + 4 * kq + r] = ss; }
        }
        __syncthreads();
        if (tid < 16) YSQ[(size_t)(rb * 16 + tid) * 16 + cb] = (xch[1024 + tid] + xch[1024 + 16 + tid]) + (xch[1024 + 32 + tid] + xch[1024 + 48 + tid]);
        __syncthreads();
    }
}
constexpr int LDS_BYTES = 147456;
constexpr int NPHASE = 17;
#define XB_TMO      128
#define XB_XCNT(j)  (256  + 64 * (j))
#define XB_XSUB(j)  (1280 + 64 * (j))
#define XB_XGEN(j)  (2304 + 64 * (j))
#define XB_TOP      3328
#define XB_TOPGEN   3392
#define XCD_BAR_WORDS 3456
#define XB_SPIN_CAP (1u << 18)

__device__ __forceinline__ unsigned xb_ld(unsigned* p)              { return __hip_atomic_load(p, __ATOMIC_RELAXED, __HIP_MEMORY_SCOPE_AGENT); }
__device__ __forceinline__ unsigned xb_add(unsigned* p, unsigned v) { return __hip_atomic_fetch_add(p, v, __ATOMIC_RELAXED, __HIP_MEMORY_SCOPE_AGENT); }
__device__ __forceinline__ unsigned xb_xcc_id() { return (unsigned)__builtin_amdgcn_s_getreg((3 << 11) | 20) & 0xFu; }
#define XB_SPIN(cond, bar) do { unsigned _sp = 0; while (cond) { __builtin_amdgcn_s_sleep(1); \
    if ((++_sp & 255u) == 0u) { if (xb_ld(&(bar)[XB_TMO])) break; if (_sp > XB_SPIN_CAP) { atomicAdd(&(bar)[XB_TMO], 1u); break; } } } } while (0)

struct XcdBarrier {
    unsigned* bar; unsigned x;
    volatile LAS unsigned* st;
};

__device__ __forceinline__ XcdBarrier xcd_barrier_post(unsigned* bar, volatile LAS unsigned* st) {
    XcdBarrier b; b.bar = bar; b.x = xb_xcc_id(); b.st = st;
    if (threadIdx.x == 0) (void)xb_add(&bar[XB_XCNT(b.x)], 1u);
    return b;
}
__device__ __forceinline__ void xcd_barrier_complete(unsigned* bar, unsigned x, unsigned& nloc, unsigned& nx) {
    const unsigned G = gridDim.x * gridDim.y * gridDim.z;
    unsigned sum, cnt, mine, sp = 0u;
    for (;;) {
        sum = 0u; cnt = 0u; mine = 0u;
#pragma unroll
        for (unsigned j = 0; j < 16; ++j) { const unsigned c = xb_ld(&bar[XB_XCNT(j)]); sum += c; cnt += (c > 0u) ? 1u : 0u; mine = (j == x) ? c : mine; }
        if (sum == G) break;
        __builtin_amdgcn_s_sleep(1);
        if ((++sp & 255u) == 0u) { if (xb_ld(&bar[XB_TMO])) break; if (sp > XB_SPIN_CAP) { atomicAdd(&bar[XB_TMO], 1u); break; } }
    }
    nloc = mine > 0u ? mine : 1u; nx = cnt > 0u ? cnt : 1u;
}

__device__ __forceinline__ void xcd_barrier(const XcdBarrier& b) {
    asm volatile("s_waitcnt vmcnt(0)" ::: "memory");
    __syncthreads();
    if (threadIdx.x == 0) {
        unsigned* bar = b.bar;
        __builtin_amdgcn_s_waitcnt(0);
        unsigned nloc = b.st[0], nx = b.st[1];
        if (nloc == 0u) { xcd_barrier_complete(bar, b.x, nloc, nx); b.st[0] = nloc; b.st[1] = nx; }
        const unsigned old = xb_add(&bar[XB_XSUB(b.x)], 1u);
        const unsigned gen = old / nloc;
        if (old + 1u == (gen + 1u) * nloc) {
            __builtin_amdgcn_fence(__ATOMIC_RELEASE, "agent");
            asm volatile("s_waitcnt vmcnt(0)" ::: "memory");
            const unsigned og = xb_add(&bar[XB_TOP], 1u);
            const unsigned tg = og / nx;
            if (og + 1u == (tg + 1u) * nx) xb_add(&bar[XB_TOPGEN], 1u);
            else XB_SPIN(xb_ld(&bar[XB_TOPGEN]) == tg, bar);
            __builtin_amdgcn_fence(__ATOMIC_ACQUIRE, "agent");
            xb_add(&bar[XB_XGEN(b.x)], 1u);
            asm volatile("s_waitcnt vmcnt(0)" ::: "memory");
        } else {
            XB_SPIN(xb_ld(&bar[XB_XGEN(b.x)]) == gen, bar);
            __builtin_amdgcn_fence(__ATOMIC_ACQUIRE, "agent");
            asm volatile("s_waitcnt vmcnt(0)" ::: "memory");
        }
    }
    __syncthreads();
}


__global__ void __launch_bounds__(512, 2) mega(P p) {
    extern __shared__ __attribute__((aligned(16))) unsigned char lds_raw[];
    LAS unsigned char* lds = (LAS unsigned char*)lds_raw;
    volatile LAS unsigned* xst = (volatile LAS unsigned*)(lds + LDS_BYTES - 16);
    if (threadIdx.x < 4) xst[threadIdx.x] = 0u;
    __syncthreads();
    if (p.coop) { cg::grid_group grid = cg::this_grid(); grid.sync();
        (void)xcd_barrier_post((unsigned*)(WSB + WS_CTL), xst); }
#define XB ((us*)(WSB + WS_XB))
#define RS ((float*)(WSB + WS_RS))
#define X (OUTB + O_Y)
#define Y ((us*)(WSB + WS_Y))
#define YSQ ((float*)(WSB + WS_YSQ))
    for (int ph = p.ph_lo; ph < p.ph_hi; ++ph) {
#ifdef RPT_MASK
      for (int rep = 0; rep < ((ph > 0 && ((RPT_MASK >> ((ph - 1) % 8)) & 1)) || (ph == 0 && (RPT_MASK & 0x200)) ? 2 : 1); ++rep) {
#else
      {
#endif
        if (ph == 0) {
            prep_phase(p, lds);
            row_pass<false, true, true>(INP(0), INP(1), NT, nullptr, nullptr, nullptr, nullptr, XB, RS, INP(10), INP(9), INP(11), OUTB + O_PLF, OUTB + O_SLF, (LAS float*)lds);
            row_pass<false, false, true>(INP(2), INP(2), NMEMROWS, nullptr, nullptr, nullptr, nullptr, (us*)(WSB + WS_MEMB), (float*)(WSB + WS_RSMEM), nullptr, nullptr, nullptr, nullptr, nullptr, (LAS float*)lds);
        } else {
            const int l = (ph - 1) / 8, s = (ph - 1) % 8;
            if (s == 0) {
                { pg8::Gemm g{XB, (const us*)(WSB + WS_WIN) + (size_t)l * NIN * DM, NT, NIN, DM}; pg8::StaticOrder S; S.init(NT, NIN, gridDim.x, blockIdx.x);
                  pg8::EpiIn E{0, l, WSB, OUTB};
                  pg8::gemm_phase<pg8::EpiIn, pg8::StaticOrder, true, true>(lds, g, S, E); }
                if (l == 0) {
#pragma unroll 1
                    for (int ll = 0; ll < 2; ++ll) {
                        pg8::Gemm g{(const us*)(WSB + WS_MEMB), (const us*)(WSB + WS_WMEM) + (size_t)ll * 512 * DM, NMEMROWS, 512, DM}; pg8::StaticOrder S; S.init(NMEMROWS, 512, gridDim.x, (blockIdx.x + 80 + 16 * ll) % gridDim.x);
                        pg8::EpiIn E{1, ll, WSB, OUTB};
                        pg8::gemm_phase<pg8::EpiIn, pg8::StaticOrder, true, true>(lds, g, S, E); }
                }
            } else if (s == 1) { attn_phase(p, lds, l);
            } else if (s == 2) { gnorm_phase(p, l);
            } else if (s == 3 || s == 6) {
                const us* A = (s == 3) ? (const us*)(WSB + WS_CAT) : (const us*)(WSB + WS_G); const int K = (s == 3) ? DM : FF;
                const us* Bt = (s == 3) ? (const us*)(WSB + WS_WOUT) + (size_t)l * DM * DM : (const us*)(WSB + WS_WDOWN) + (size_t)l * DM * FF;
                { pg8::Gemm g{A, Bt, NTP, DM, K}; pg8::StaticOrder S; S.init(NTP, DM, gridDim.x, blockIdx.x); pg8::EpiY E{WSB};
                  if (s == 6) { pg8::Unit uu; int lastpm = -1;
                      for (int i = 0; S.next(i, uu); ++i) if (uu.pm != lastpm) { fix_panel(p, l, uu.pm); lastpm = uu.pm; }
                      conv_state_out(p, l); __syncthreads(); }
                  pg8::gemm_phase<pg8::EpiY, pg8::StaticOrder, true, true>(lds, g, S, E); }
                small_gemm(lds, A + (size_t)NTP * K, Bt, K, Y + (size_t)NTP * DM, YSQ + (size_t)NTP * 16);
            } else if (s == 4) {
                const float* xp = (l == 0) ? INP(0) : X; const float* xs = (l == 0) ? INP(1) : X + (size_t)NTP * DM;
                row_pass<true, false, true>(xp, xs, NT, X, Y, YSQ, INP(19) + (size_t)l * DM, XB, RS, nullptr, nullptr, nullptr, nullptr, nullptr, (LAS float*)lds);
            } else if (s == 5) {
                pg8::Gemm g{XB, (const us*)(WSB + WS_WUP) + (size_t)l * NUP * DM, NT, NUP, DM}; pg8::StaticOrder S; S.init(NT, NUP, gridDim.x, blockIdx.x);
                pg8::EpiUp E{WSB, INP(22) + (size_t)l * 3 * FF, INP(23) + (size_t)l * FF, INP(8) + (size_t)l * NBS * 2 * FF, OUTB + O_SCONV + (size_t)l * NBS * 2 * FF};
                pg8::gemm_phase<pg8::EpiUp, pg8::StaticOrder, true, true>(lds, g, S, E);
            } else {
                if (l == 0) row_pass<true, true, true>(X, X + (size_t)NTP * DM, NT, X, Y, YSQ, INP(25), XB, RS, INP(10) + (size_t)DM * INC, INP(9) + DM, INP(11) + 8, OUTB + O_PLF + (size_t)NTP * 8, OUTB + O_SLF + (size_t)NTS * 8, (LAS float*)lds);
                else row_pass<true, false, false>(X, X + (size_t)NTP * DM, NT, X, Y, YSQ, INP(25) + DM, nullptr, nullptr, nullptr, nullptr, nullptr, nullptr, nullptr, (LAS float*)lds);
            }
        }
      }
        if (p.coop && ph + 1 < p.ph_hi) { XcdBarrier xb_; xb_.bar = (unsigned*)(WSB + WS_CTL); xb_.x = xb_xcc_id(); xb_.st = xst; xcd_barrier(xb_); }
    }
}

#undef XB
#undef RS
#undef X
#undef Y
#undef YSQ
extern "C" void kernel_launch(void* const* d_in, const int* in_sizes, int n_in, void* d_out, int out_size, void* d_ws, size_t ws_size, hipStream_t stream) {
    static int grid = 0;
    if (grid == 0) {
        if (n_in != 26 || out_size != (int)O_END || ws_size < WS_END) { fprintf(stderr, "kernel_launch: unexpected sizes n_in %d out %d ws %zu (need %zu)\n", n_in, out_size, ws_size, (size_t)WS_END); grid = -1; return; }
        int dev = 0, cus = 0, per_cu = 0;
        (void)hipGetDevice(&dev); (void)hipDeviceGetAttribute(&cus, hipDeviceAttributeMultiprocessorCount, dev);
        if (hipFuncSetAttribute((const void*)mega, hipFuncAttributeMaxDynamicSharedMemorySize, LDS_BYTES) != hipSuccess) { fprintf(stderr, "kernel_launch: hipFuncSetAttribute failed\n"); grid = -1; return; }
        (void)hipOccupancyMaxActiveBlocksPerMultiprocessor(&per_cu, (const void*)mega, 512, LDS_BYTES);
        (void)hipGetLastError();
        if (per_cu < 1) fprintf(stderr, "kernel_launch: occupancy query says %d blocks per CU\n", per_cu);
        grid = cus > 0 ? cus : 256;
    }
    if (grid < 0) return;
    if (hipMemsetAsync((char*)d_ws + WS_CTL, 0, 16384, stream) != hipSuccess) { fprintf(stderr, "kernel_launch: memset failed\n"); return; }
    P p{};
    for (int i = 0; i < 26; ++i) p.in[i] = (const float*)d_in[i];
    p.out = (float*)d_out; p.ws = (unsigned char*)d_ws; p.pad = 0;
#ifndef MK_MULTI
    p.ph_lo = 0; p.ph_hi = NPHASE; p.coop = 1;
    void* args[] = {&p};
    hipError_t e = hipLaunchCooperativeKernel((void*)mega, dim3(grid), dim3(512), args, LDS_BYTES, stream);
    if (e != hipSuccess) fprintf(stderr, "kernel_launch: cooperative launch failed: %s (grid %d)\n", hipGetErrorString(e), grid);
#else
    for (int ph = 0; ph < NPHASE; ++ph) { p.ph_lo = ph; p.ph_hi = ph + 1; p.coop = 0; hipLaunchKernelGGL(mega, dim3(grid), dim3(512), LDS_BYTES, stream, p); }
#endif
}
```

```cpp
#include <hip/hip_runtime.h>
#include <hip/hip_cooperative_groups.h>
#include <cstdio>
#include <cstdint>
namespace cg = cooperative_groups;
#define LAS __attribute__((address_space(3)))
typedef unsigned short us;
typedef float f32x16 __attribute__((ext_vector_type(16)));
typedef short s16x4 __attribute__((ext_vector_type(4)));

constexpr int DM = 1024, NTP = 16384, NTS = 256, NT = NTP + NTS, SEQ = 2048, NBP = 8, NBS = 16, PAST = 1024;
constexpr int INC = 2312, NIN = 2304, FF = 2816, NUP = 5632, NMEMROWS = 2048;
constexpr float LOG2E = 1.4426950408889634f, C2 = 0.125f * 1.4426950408889634f, EPS = 1e-6f;

constexpr size_t O_Y = 0, O_YS = 16777216, O_PK = 17039360, O_PV = 33816576, O_PLF = 50593792, O_PMK = 50855936, O_PMV = 51904512,
                 O_PCONV = 52953088, O_SK = 53043200, O_SV = 53305344, O_SLF = 53567488, O_SGV = 53571584, O_SCONV = 53702656, O_END = 53882880;
constexpr size_t MiB = 1u << 20;
constexpr size_t WS_WIN = 0;
constexpr size_t WS_WOUT = 10 * MiB;
constexpr size_t WS_WUP = 14 * MiB;
constexpr size_t WS_WDOWN = 36 * MiB;
constexpr size_t WS_WMEM = 47 * MiB;
constexpr size_t WS_XB = 49 * MiB;
constexpr size_t WS_MEMB = 82 * MiB;
constexpr size_t WS_MKV = 86 * MiB;
constexpr size_t WS_RS = 90 * MiB;
constexpr size_t WS_RSMEM = 90 * MiB + 128 * 1024;
constexpr size_t WS_YSQ = 91 * MiB;
constexpr size_t WS_AF = 93 * MiB;
constexpr size_t WS_LF = 99 * MiB;
constexpr size_t WS_AL = 105 * MiB;
constexpr size_t WS_SA = 111 * MiB;
constexpr size_t WS_SL = 114 * MiB;
constexpr size_t WS_Y = 117 * MiB;
constexpr size_t WS_ACT = 183 * MiB;
constexpr size_t WS_QB = WS_ACT;
constexpr size_t WS_KB = WS_ACT + 17 * MiB;
constexpr size_t WS_VB = WS_ACT + 34 * MiB;
constexpr size_t WS_UB = WS_ACT + 51 * MiB;
constexpr size_t WS_ZB = WS_ACT + 60 * MiB;
constexpr size_t WS_QMB = WS_ACT + 69 * MiB;
constexpr size_t WS_CAT = WS_ACT + 78 * MiB;
constexpr size_t WS_G = WS_ACT;
constexpr size_t WS_CTL = WS_ACT + 111 * MiB;
constexpr size_t WS_END = WS_ACT + 112 * MiB;

__device__ __forceinline__ unsigned f2bf(float f) { unsigned u = __builtin_bit_cast(unsigned, f); return (u + 0x7fffu + ((u >> 16) & 1u)) >> 16; }
__device__ __forceinline__ unsigned pk2(float lo, float hi) { return f2bf(lo) | (f2bf(hi) << 16); }
__device__ __forceinline__ float bf2f(unsigned h) { return __builtin_bit_cast(float, h << 16); }
__device__ __forceinline__ float gelu_tanh(float x) { const float y = 0.7978845608028654f * (x + 0.044715f * x * x * x); return x / (1.f + __expf(-2.f * y)); }
__device__ __forceinline__ float silu_f(float x) { return x / (1.f + __expf(-x)); }
__device__ __forceinline__ float wave_sum(float v) {
#pragma unroll
    for (int o = 1; o < 64; o <<= 1) v += __shfl_xor(v, o);
    return v;
}
__device__ __forceinline__ int opq0() { int z; asm volatile("s_mov_b32 %0, 0" : "=s"(z)); return z; }
__device__ __forceinline__ int otid() { int t = threadIdx.x; asm volatile("" : "+v"(t)); return t; }
namespace pg8 {
#define PG8_LAS __attribute__((address_space(3)))
typedef unsigned short bf16_t;
typedef short bf16x8 __attribute__((ext_vector_type(8)));
typedef float f32x4 __attribute__((ext_vector_type(4)));
typedef unsigned u32x4 __attribute__((ext_vector_type(4)));
constexpr int BM = 256, BK = 64, HALF = 128, HTB = HALF * BK * 2  , STAGE_BYTES = 8 * HTB, NXCD = 8, WGM = 8;

__host__ __device__ __forceinline__ int lds_byte(int r, int c) { const int st = (r >> 4) * 2 + (c >> 5), rr = r & 15, cc = c & 31, ob = rr * 64 + cc * 2; return st * 1024 + (ob ^ (((ob >> 9) & 1) << 5)); }
__host__ __device__ __forceinline__ void stage_rc(int b, int& R, int& C) { const int st = b / 1024, sb = b % 1024, swz = sb ^ (((sb >> 9) & 1) << 5); R = (st >> 1) * 16 + swz / 64; C = (st & 1) * 32 + (swz % 64) / 2; }
__host__ __device__ __forceinline__ int perm32(int rho) { const int n = rho >> 4, i = rho & 15; return 8 * (i >> 2) + 4 * n + (i & 3); }

struct Unit { int pm, pn; };
struct Gemm { const bf16_t* A; const bf16_t* Bt; int M, N, K; };

struct StaticOrder {
    int nM, nN, nwg, G, c;
    __host__ __device__ void init(int M, int N, int G_, int c_) { nM = M / BM; nN = N / BM; nwg = nM * nN; G = G_; c = c_; }
    __host__ __device__ bool next(int i, Unit& u) const {
        const long L = (long)i * G + c; if (L >= nwg) return false;
        int wgid = (int)L; { const int q = nwg / NXCD, r = nwg % NXCD, xcd = wgid % NXCD, off = wgid / NXCD; wgid = (xcd < r ? xcd * (q + 1) : r * (q + 1) + (xcd - r) * q) + off; }
        const int nig = WGM * nN, gid = wgid / nig, fm = gid * WGM, gsz = (nM - fm) < WGM ? (nM - fm) : WGM;
        u.pm = fm + ((wgid % nig) % gsz); u.pn = (wgid % nig) / gsz; return true;
    }
    __device__ __forceinline__ void a_ready(const Unit&) const {}
    __device__ __forceinline__ void done(const Unit&) const {}
};
__device__ __forceinline__ unsigned cvt_pk_bf16(float lo, float hi) { unsigned r; asm volatile("v_cvt_pk_bf16_f32 %0, %1, %2" : "=v"(r) : "v"(lo), "v"(hi)); return r; }
struct EpiIn {
    static constexpr bool PERM = true, AFTER_DRAIN = false;
    int mode, l; unsigned char* ws; float* out;
    __device__ __forceinline__ void operator()(const f32x4 (&acc)[2][2][4][2], const Unit& u, int wr, int wc, int fr_, int fq_) const {
        int fr = fr_, fq = fq_; asm volatile("" : "+v"(fr), "+v"(fq));
        const int pn = u.pn;
        bf16_t* const QB = (bf16_t*)(ws + WS_QB); bf16_t* const KB = (bf16_t*)(ws + WS_KB); bf16_t* const VB = (bf16_t*)(ws + WS_VB); bf16_t* const UB = (bf16_t*)(ws + WS_UB);
        bf16_t* const ZB = (bf16_t*)(ws + WS_ZB); bf16_t* const QMB = (bf16_t*)(ws + WS_QMB); bf16_t* const MKV = (bf16_t*)(ws + WS_MKV) + (size_t)l * NMEMROWS * 512;
        float* const oKp = out + O_PK + (size_t)l * NTP * 512; float* const oVp = out + O_PV + (size_t)l * NTP * 512; float* const oKs = out + O_SK + (size_t)l * NTS * 512; float* const oVs = out + O_SV + (size_t)l * NTS * 512;
        float* const oMK = out + O_PMK + (size_t)l * NMEMROWS * 256; float* const oMV = out + O_PMV + (size_t)l * NMEMROWS * 256;
        bf16_t* bdst; int bp; int bc; float mult = 1.f; int act = 0; float* fP = nullptr; float* fS = nullptr; int fp_ = 0, fc = 0;
        if (mode == 0) {
            if (pn < 2) { bdst = QB; bp = 512; bc = pn * 256; mult = C2; }
            else if (pn < 4) { bdst = KB; bp = 512; bc = (pn - 2) * 256; fP = oKp; fS = oKs; fp_ = 512; fc = bc; }
            else if (pn < 6) { bdst = VB; bp = 512; bc = (pn - 4) * 256; fP = oVp; fS = oVs; fp_ = 512; fc = bc; }
            else if (pn == 6) { bdst = UB; bp = 256; bc = 0; act = 1; }
            else if (pn == 7) { bdst = ZB; bp = 256; bc = 0; act = 1; }
            else { bdst = QMB; bp = 256; bc = 0; mult = C2; }
        } else { bdst = MKV; bp = 512; bc = pn * 256; fP = pn ? oMV : oMK; fS = fP; fp_ = 256; fc = 0; }
#pragma unroll
        for (int ai = 0; ai < 2; ++ai)
#pragma unroll
            for (int m = 0; m < 4; ++m) {
                const int row = u.pm * BM + ai * HALF + wr * 64 + m * 16 + fr;
                const float s = mult;
                float* frow = nullptr;
                if (fP) frow = (mode == 0 && row >= NTP) ? fS + (size_t)(row - NTP) * fp_ + fc : fP + (size_t)row * fp_ + fc;
#pragma unroll
                for (int bj = 0; bj < 2; ++bj) {
                    const int lc = bj * HALF + wc * 32 + 8 * fq;
                    f32x4 v0 = acc[ai][bj][m][0] * s, v1 = acc[ai][bj][m][1] * s;
                    if (act) { v0 = (f32x4){gelu_tanh(v0[0]), gelu_tanh(v0[1]), gelu_tanh(v0[2]), gelu_tanh(v0[3])}; v1 = (f32x4){gelu_tanh(v1[0]), gelu_tanh(v1[1]), gelu_tanh(v1[2]), gelu_tanh(v1[3])}; }
                    if (frow) { *(f32x4*)(frow + lc) = v0; *(f32x4*)(frow + lc + 4) = v1; }
                    u32x4 w; w.x = cvt_pk_bf16(v0[0], v0[1]); w.y = cvt_pk_bf16(v0[2], v0[3]); w.z = cvt_pk_bf16(v1[0], v1[1]); w.w = cvt_pk_bf16(v1[2], v1[3]);
                    *(u32x4*)(bdst + (size_t)row * bp + bc + lc) = w;
                }
            }
    }
};
struct EpiY {
    static constexpr bool PERM = true, AFTER_DRAIN = false;
    unsigned char* ws;
    __device__ __forceinline__ void operator()(const f32x4 (&acc)[2][2][4][2], const Unit& u, int wr, int wc, int fr_, int fq_) const {
        int fr = fr_, fq = fq_; asm volatile("" : "+v"(fr), "+v"(fq));
        bf16_t* const Y = (bf16_t*)(ws + WS_Y); float* const YSQ = (float*)(ws + WS_YSQ);
#pragma unroll
        for (int ai = 0; ai < 2; ++ai)
#pragma unroll
            for (int m = 0; m < 4; ++m) {
                const int row = u.pm * BM + ai * HALF + wr * 64 + m * 16 + fr;
                float ss = 0.f;
#pragma unroll
                for (int bj = 0; bj < 2; ++bj) {
                    const int c = u.pn * BM + bj * HALF + wc * 32 + 8 * fq;
                    const f32x4 v0 = acc[ai][bj][m][0], v1 = acc[ai][bj][m][1];
                    u32x4 w; w.x = cvt_pk_bf16(v0[0], v0[1]); w.y = cvt_pk_bf16(v0[2], v0[3]); w.z = cvt_pk_bf16(v1[0], v1[1]); w.w = cvt_pk_bf16(v1[2], v1[3]);
                    *(u32x4*)(Y + (size_t)row * DM + c) = w;
                    ss += (v0[0] * v0[0] + v0[1] * v0[1]) + (v0[2] * v0[2] + v0[3] * v0[3]) + (v1[0] * v1[0] + v1[1] * v1[1]) + (v1[2] * v1[2] + v1[3] * v1[3]);
                }
                ss += __shfl_xor(ss, 16); ss += __shfl_xor(ss, 32);
                if (fq == 0) YSQ[(size_t)row * 16 + u.pn * 4 + wc] = ss;
            }
    }
};
struct EpiUp {
    static constexpr bool PERM = true, AFTER_DRAIN = false;
    unsigned char* ws; const float* wdw; const float* bdw; const float* hist; float* osc;
    __device__ __forceinline__ void operator()(const f32x4 (&acc)[2][2][4][2], const Unit& u, int wr, int wc, int fr_, int fq_) const {
        int fr = fr_, fq = fq_; asm volatile("" : "+v"(fr), "+v"(fq));
        const int f0 = u.pn * 128 + wc * 32 + 8 * fq;
        bf16_t* const G = (bf16_t*)(ws + WS_G);
        float* const AF = (float*)(ws + WS_AF); float* const LF = (float*)(ws + WS_LF); float* const AL = (float*)(ws + WS_AL);
        const int lane = fq * 16 + fr;
        const int src1 = (lane & 48) | ((fr - 1) & 15), src2 = (lane & 48) | ((fr - 2) & 15);
        if (u.pm == NTP / BM) {
#pragma unroll
            for (int n = 0; n < 2; ++n) {
                const int fn = f0 + 4 * n;
                const f32x4 w0 = *(const f32x4*)(wdw + fn), w1 = *(const f32x4*)(wdw + FF + fn), w2 = *(const f32x4*)(wdw + 2 * FF + fn), bb = *(const f32x4*)(bdw + fn);
#pragma unroll
                for (int ai = 0; ai < 2; ++ai)
#pragma unroll
                    for (int m = 0; m < 4; ++m) {
                        const int b = 8 * ai + 4 * wr + m, row = NTP + 16 * b + fr;
                        const f32x4 a = acc[ai][0][m][n], li = acc[ai][1][m][n]; f32x4 gv, h0 = {0.f, 0.f, 0.f, 0.f}, h1 = {0.f, 0.f, 0.f, 0.f};
                        if (fr < 2) { h0 = *(const f32x4*)(hist + ((size_t)b * 2) * FF + fn); h1 = *(const f32x4*)(hist + ((size_t)b * 2 + 1) * FF + fn); }
#pragma unroll
                        for (int e = 0; e < 4; ++e) {
                            const float p1 = __shfl(a[e], src1), p2 = __shfl(a[e], src2);
                            const float a1 = (fr == 0) ? h1[e] : p1, a0 = (fr == 0) ? h0[e] : ((fr == 1) ? h1[e] : p2);
                            gv[e] = silu_f(bb[e] + w0[e] * a0 + w1[e] * a1 + w2[e] * a[e]) * li[e];
                        }
                        unsigned long long w = (unsigned long long)cvt_pk_bf16(gv[0], gv[1]) | ((unsigned long long)cvt_pk_bf16(gv[2], gv[3]) << 32);
                        *(unsigned long long*)(G + (size_t)row * FF + fn) = w;
                        if (fr >= 14) *(f32x4*)(osc + ((size_t)b * 2 + (fr - 14)) * FF + fn) = a;
                        __builtin_amdgcn_sched_barrier(0);
                    }
            }
            return;
        }
#pragma unroll
        for (int n = 0; n < 2; ++n) {
            const int fn = f0 + 4 * n;
            const f32x4 w0 = *(const f32x4*)(wdw + fn), w1 = *(const f32x4*)(wdw + FF + fn), w2 = *(const f32x4*)(wdw + 2 * FF + fn), bb = *(const f32x4*)(bdw + fn);
#pragma unroll
            for (int ai = 0; ai < 2; ++ai) {
                const int strip = u.pm * 4 + ai * 2 + wr;
                f32x4 ap = {0.f, 0.f, 0.f, 0.f};
#pragma unroll
                for (int m = 0; m < 4; ++m) {
                    const int row = u.pm * BM + ai * HALF + wr * 64 + m * 16 + fr;
                    const f32x4 a = acc[ai][0][m][n], li = acc[ai][1][m][n]; f32x4 gv;
#pragma unroll
                    for (int e = 0; e < 4; ++e) {
                        const float s1 = (fr == 15) ? ap[e] : a[e], s2 = (fr >= 14) ? ap[e] : a[e];
                        const float a1 = __shfl(s1, src1), a0 = __shfl(s2, src2);
                        gv[e] = silu_f(bb[e] + w0[e] * a0 + w1[e] * a1 + w2[e] * a[e]) * li[e];
                    }
                    if (m == 0 && fr < 2) {
                        *(f32x4*)(AF + ((size_t)strip * 2 + fr) * FF + fn) = a; *(f32x4*)(LF + ((size_t)strip * 2 + fr) * FF + fn) = li;
                    } else {
                        unsigned long long w = (unsigned long long)cvt_pk_bf16(gv[0], gv[1]) | ((unsigned long long)cvt_pk_bf16(gv[2], gv[3]) << 32);
                        *(unsigned long long*)(G + (size_t)row * FF + fn) = w;
                    }
                    if (m == 3 && fr >= 14) *(f32x4*)(AL + ((size_t)strip * 2 + (fr - 14)) * FF + fn) = a;
                    ap = a;
                    __builtin_amdgcn_sched_barrier(0);
                }
            }
        }
    }
};
template <class Epi, class Sched, bool ALIGN_EPI = false, bool SP2 = false>
__device__ __forceinline__ void gemm_phase(PG8_LAS unsigned char* lds, const Gemm g, const Sched& S, const Epi& E) {
    const int tid = otid(), wid = __builtin_amdgcn_readfirstlane(tid >> 6), lane = tid & 63, wr = wid >> 2, wc = wid & 3, fr = lane & 15, fq = lane >> 4;
    const int K = g.K, nt = K / BK;
    unsigned voffA[2], voffB[2];
#pragma unroll
    for (int i = 0; i < 2; ++i) { int R, C; stage_rc(tid * 16 + i * 8192, R, C); const int Rb = Epi::PERM ? ((R & ~31) + perm32(R & 31)) : R;
        voffA[i] = (unsigned)(R * K + C) * 2u; voffB[i] = (unsigned)(Rb * K + C) * 2u; }
    const size_t kstep = (size_t)(BK * 2);
    const size_t hstep = (size_t)HALF * K * 2;
    const size_t tstep = 2 * hstep;
    const unsigned ldsw = (unsigned)wid * 1024u;
    const int aoff = lds_byte(wr * 64 + fr, fq * 8), boff = lds_byte(wc * 32 + fr, fq * 8);
#define PG8_SA(b, h) (((b) * 2 + (h)) * HTB)
#define PG8_SB(b, h) ((4 + (b) * 2 + (h)) * HTB)
#define PG8_STAGE(bufoff, gbase, voff) do { _Pragma("unroll") for (int _i = 0; _i < 2; ++_i) \
        __builtin_amdgcn_global_load_lds((const unsigned*)((const char*)(gbase) + (voff)[_i]), (PG8_LAS unsigned*)(lds + (bufoff) + ldsw + _i * 8192), 16, 0, 0); } while (0)
#define PG8_LDA(dst, b, h) do { _Pragma("unroll") for (int m = 0; m < 4; ++m) _Pragma("unroll") for (int k = 0; k < 2; ++k) dst[m][k] = *(const PG8_LAS bf16x8*)(lds + PG8_SA(b, h) + aoff + m * 2048 + k * 1024); } while (0)
#define PG8_LDB(dst, b, h) do { _Pragma("unroll") for (int n = 0; n < 2; ++n) _Pragma("unroll") for (int k = 0; k < 2; ++k) dst[n][k] = *(const PG8_LAS bf16x8*)(lds + PG8_SB(b, h) + boff + n * 2048 + k * 1024); } while (0)
#define PG8_MMA(ai, bj, At, Bt) do { __builtin_amdgcn_s_setprio(1); _Pragma("unroll") for (int m = 0; m < 4; ++m) _Pragma("unroll") for (int n = 0; n < 2; ++n) _Pragma("unroll") for (int k = 0; k < 2; ++k) \
        acc[ai][bj][m][n] = __builtin_amdgcn_mfma_f32_16x16x32_bf16(Bt[n][k], At[m][k], acc[ai][bj][m][n], 0, 0, 0); __builtin_amdgcn_s_setprio(0); } while (0)
#define PG8_WAIT_V(n) asm volatile("s_waitcnt vmcnt(" #n ")" ::: "memory")
#define PG8_WAIT_L(n) asm volatile("s_waitcnt lgkmcnt(" #n ")" ::: "memory")
#define PG8_BAR __builtin_amdgcn_s_barrier()
#define PG8_SCHED __builtin_amdgcn_sched_barrier(0)
    Unit cur, nxt; int ui = 0;
    if (!S.next(0, cur)) return;
    f32x4 acc[2][2][4][2];
#pragma unroll
    for (int a = 0; a < 2; ++a)
#pragma unroll
        for (int b = 0; b < 2; ++b)
#pragma unroll
            for (int m = 0; m < 4; ++m)
#pragma unroll
                for (int n = 0; n < 2; ++n) acc[a][b][m][n] = (f32x4){0.f, 0.f, 0.f, 0.f};
    bf16x8 At[4][2], B0[2][2], B1[2][2];
    const char* cA = (const char*)g.A + (size_t)cur.pm * tstep; const char* cB = (const char*)g.Bt + (size_t)cur.pn * tstep;
    S.a_ready(cur);
    if constexpr (SP2) {
        PG8_STAGE(PG8_SB(0, 0), cB, voffB); PG8_STAGE(PG8_SB(0, 1), cB + hstep, voffB); PG8_STAGE(PG8_SA(0, 0), cA, voffA); PG8_STAGE(PG8_SA(0, 1), cA + hstep, voffA);
        if (wr == 1) PG8_BAR;
        PG8_WAIT_V(2); PG8_BAR;
        PG8_STAGE(PG8_SB(1, 0), cB + kstep, voffB); PG8_STAGE(PG8_SA(1, 0), cA + kstep, voffA); PG8_STAGE(PG8_SB(1, 1), cB + hstep + kstep, voffB);
        PG8_WAIT_V(6); PG8_BAR;
    } else {
        PG8_STAGE(PG8_SB(0, 0), cB, voffB); PG8_STAGE(PG8_SA(0, 0), cA, voffA); PG8_STAGE(PG8_SB(0, 1), cB + hstep, voffB); PG8_STAGE(PG8_SA(0, 1), cA + hstep, voffA);
        if (wr == 1) PG8_BAR;
        PG8_WAIT_V(4); PG8_BAR;
        PG8_STAGE(PG8_SB(1, 0), cB + kstep, voffB); PG8_STAGE(PG8_SA(1, 0), cA + kstep, voffA); PG8_STAGE(PG8_SB(1, 1), cB + hstep + kstep, voffB);
        PG8_WAIT_V(6); PG8_BAR;
    }
    for (;;) {
        const bool has_next = S.next(ui + 1, nxt);
        const char* nA = has_next ? (const char*)g.A + (size_t)nxt.pm * tstep : cA; const char* nB = has_next ? (const char*)g.Bt + (size_t)nxt.pn * tstep : cB;
        for (int t = 0; t < nt; t += 2) {
            const bool last = (t == nt - 2);
            const char* a1 = cA + (size_t)(t + 1) * kstep;
            const char* a2 = last ? nA : cA + (size_t)(t + 2) * kstep; const char* b2 = last ? nB : cB + (size_t)(t + 2) * kstep;
            const char* a3 = a2 + kstep; const char* b3 = b2 + kstep;
            if (last && has_next) S.a_ready(nxt);
            if constexpr (SP2) {
            PG8_LDB(B0, 0, 0); PG8_LDB(B1, 0, 1); PG8_SCHED; PG8_LDA(At, 0, 0); PG8_STAGE(PG8_SA(1, 1), a1 + hstep, voffA);
            PG8_WAIT_V(8); PG8_WAIT_L(0); PG8_BAR; PG8_MMA(0, 0, At, B0); PG8_MMA(0, 1, At, B1); PG8_BAR; PG8_SCHED;
            PG8_LDA(At, 0, 1); PG8_STAGE(PG8_SB(0, 0), b2, voffB); PG8_STAGE(PG8_SB(0, 1), b2 + hstep, voffB); PG8_STAGE(PG8_SA(0, 0), a2, voffA);
            PG8_WAIT_V(8); PG8_WAIT_L(0); PG8_BAR; PG8_MMA(1, 0, At, B0); PG8_MMA(1, 1, At, B1); PG8_BAR; PG8_SCHED;
            PG8_LDB(B0, 1, 0); PG8_LDB(B1, 1, 1); PG8_SCHED; PG8_LDA(At, 1, 0); PG8_STAGE(PG8_SA(0, 1), a2 + hstep, voffA);
            PG8_WAIT_V(8); PG8_WAIT_L(0); PG8_BAR; PG8_MMA(0, 0, At, B0); PG8_MMA(0, 1, At, B1); PG8_BAR; PG8_SCHED;
            PG8_LDA(At, 1, 1); PG8_STAGE(PG8_SB(1, 0), b3, voffB); PG8_STAGE(PG8_SB(1, 1), b3 + hstep, voffB); PG8_STAGE(PG8_SA(1, 0), a3, voffA);
            PG8_WAIT_V(8); PG8_WAIT_L(0); PG8_BAR; PG8_MMA(1, 0, At, B0); PG8_MMA(1, 1, At, B1); PG8_BAR; PG8_SCHED;
            } else {
            PG8_LDB(B0, 0, 0); PG8_SCHED; PG8_LDA(At, 0, 0); PG8_STAGE(PG8_SA(1, 1), a1 + hstep, voffA);
            PG8_WAIT_L(8); PG8_BAR; PG8_WAIT_L(0); PG8_MMA(0, 0, At, B0); PG8_BAR; PG8_SCHED;
            PG8_LDB(B1, 0, 1); PG8_STAGE(PG8_SB(0, 0), b2, voffB);
            PG8_BAR; PG8_WAIT_L(0); PG8_MMA(0, 1, At, B1); PG8_BAR;
            PG8_LDA(At, 0, 1); PG8_STAGE(PG8_SA(0, 0), a2, voffA);
            PG8_BAR; PG8_WAIT_L(0); PG8_MMA(1, 0, At, B0); PG8_BAR; PG8_SCHED;
            PG8_STAGE(PG8_SB(0, 1), b2 + hstep, voffB);
            PG8_WAIT_V(6); PG8_BAR; PG8_MMA(1, 1, At, B1); PG8_BAR;
            PG8_LDB(B0, 1, 0); PG8_SCHED; PG8_LDA(At, 1, 0); PG8_STAGE(PG8_SA(0, 1), a2 + hstep, voffA);
            PG8_WAIT_L(8); PG8_BAR; PG8_WAIT_L(0); PG8_MMA(0, 0, At, B0); PG8_BAR; PG8_SCHED;
            PG8_LDB(B1, 1, 1); PG8_STAGE(PG8_SB(1, 0), b3, voffB);
            PG8_BAR; PG8_WAIT_L(0); PG8_MMA(0, 1, At, B1); PG8_BAR;
            PG8_LDA(At, 1, 1); PG8_STAGE(PG8_SA(1, 0), a3, voffA);
            PG8_BAR; PG8_WAIT_L(0); PG8_MMA(1, 0, At, B0); PG8_BAR; PG8_SCHED;
            PG8_STAGE(PG8_SB(1, 1), b3 + hstep, voffB);
            PG8_WAIT_V(6); PG8_BAR; PG8_MMA(1, 1, At, B1); PG8_BAR;
            }
        }
        if constexpr (ALIGN_EPI) { if (wr == 0) PG8_BAR; }
        if constexpr (!Epi::AFTER_DRAIN) { E(acc, cur, wr, wc, fr, fq); S.done(cur); }
        if (!has_next) break;
#pragma unroll
        for (int a = 0; a < 2; ++a)
#pragma unroll
            for (int b = 0; b < 2; ++b)
#pragma unroll
                for (int m = 0; m < 4; ++m)
#pragma unroll
                    for (int n = 0; n < 2; ++n) acc[a][b][m][n] = (f32x4){0.f, 0.f, 0.f, 0.f};
        cur = nxt; cA = nA; cB = nB; ++ui;
        if constexpr (ALIGN_EPI) { if (wr == 1) PG8_BAR; }
    }
    PG8_WAIT_V(0);
    if constexpr (!ALIGN_EPI) { if (wr == 0) PG8_BAR; }
    PG8_BAR;
    if constexpr (Epi::AFTER_DRAIN) { E.fused(acc, cur, wr, wc, fr, fq, lds, wid, lane); S.done(cur); }
#undef PG8_SA
#undef PG8_SB
#undef PG8_STAGE
#undef PG8_LDA
#undef PG8_LDB
#undef PG8_MMA
#undef PG8_WAIT_V
#undef PG8_WAIT_L
#undef PG8_BAR
#undef PG8_SCHED
}
}
using pg8::bf16x8; using pg8::f32x4; using pg8::u32x4;
struct P {
    const float* in[26]; float* out; unsigned char* ws; int ph_lo, ph_hi, coop, pad;
};
#define INP(i) (p.in[(i) + opq0()])
#define WSB (p.ws + opq0())
#define OUTB (p.out + opq0())
#define MFMA32(a, b, c) __builtin_amdgcn_mfma_f32_32x32x16_bf16(a, b, c, 0, 0, 0)
#define MFMA16(a, b, c) __builtin_amdgcn_mfma_f32_16x16x32_bf16(a, b, c, 0, 0, 0)
typedef short v4i16_t __attribute__((ext_vector_type(4)));
__device__ __forceinline__ s16x4 trr(LAS const unsigned char* p) { return __builtin_bit_cast(s16x4, __builtin_amdgcn_ds_read_tr16_b64_v4i16((LAS v4i16_t*)p)); }

__device__ __forceinline__ void prep_tile(const float* src, int srcN, int K, const float* gain, us* dst, int kt, int n0dst, int n0src, LAS float* tile) {
    const int tid = otid();
    f32x4 v[4];
#pragma unroll
    for (int i = 0; i < 4; ++i) { const int k = (tid >> 4) + 32 * i, n4 = (tid & 15) * 4; v[i] = *(const f32x4*)(src + (size_t)(kt * 128 + k) * srcN + n0src + n4); if (gain) v[i] = v[i] * gain[kt * 128 + k]; }
#pragma unroll
    for (int i = 0; i < 4; ++i) { const int k = (tid >> 4) + 32 * i, n4 = (tid & 15) * 4; tile[k * 65 + n4] = v[i][0]; tile[k * 65 + n4 + 1] = v[i][1]; tile[k * 65 + n4 + 2] = v[i][2]; tile[k * 65 + n4 + 3] = v[i][3]; }
    __syncthreads();
    const int n = tid >> 3, k16 = (tid & 7) * 16;
    u32x4 o0, o1;
    o0.x = pk2(tile[(k16 + 0) * 65 + n], tile[(k16 + 1) * 65 + n]); o0.y = pk2(tile[(k16 + 2) * 65 + n], tile[(k16 + 3) * 65 + n]);
    o0.z = pk2(tile[(k16 + 4) * 65 + n], tile[(k16 + 5) * 65 + n]); o0.w = pk2(tile[(k16 + 6) * 65 + n], tile[(k16 + 7) * 65 + n]);
    o1.x = pk2(tile[(k16 + 8) * 65 + n], tile[(k16 + 9) * 65 + n]); o1.y = pk2(tile[(k16 + 10) * 65 + n], tile[(k16 + 11) * 65 + n]);
    o1.z = pk2(tile[(k16 + 12) * 65 + n], tile[(k16 + 13) * 65 + n]); o1.w = pk2(tile[(k16 + 14) * 65 + n], tile[(k16 + 15) * 65 + n]);
    us* dp = dst + (size_t)(n0dst + n) * K + kt * 128 + k16;
    *(u32x4*)dp = o0; *(u32x4*)(dp + 8) = o1;
    __syncthreads();
}
__device__ __forceinline__ void prep_phase(const P& p, LAS unsigned char* lds) {
    LAS float* tile = (LAS float*)lds;
    constexpr int I_IN = 8 * 36, I_OUT = 8 * 16, I_UP = 8 * 88, I_DN = 22 * 16, I_MEM = 8 * 8, I_L = I_IN + I_OUT + I_UP + I_DN + I_MEM;
    for (int it = blockIdx.x; it < 2 * I_L; it += gridDim.x) {
        const int l = it / I_L; int r = it % I_L;
        if (r < I_IN) { const int kt = r / 36, nt = r % 36, nd = nt * 64; prep_tile(INP(10) + (size_t)l * DM * INC, INC, DM, INP(9) + l * DM, (us*)(WSB + WS_WIN) + (size_t)l * NIN * DM, kt, nd, nd < 1536 ? nd : nd + 8, tile); continue; } r -= I_IN;
        if (r < I_OUT) { const int kt = r / 16, nt = r % 16; prep_tile(INP(18) + (size_t)l * DM * DM, DM, DM, nullptr, (us*)(WSB + WS_WOUT) + (size_t)l * DM * DM, kt, nt * 64, nt * 64, tile); continue; } r -= I_OUT;
        if (r < I_UP) { const int kt = r / 88, nt = r % 88, nd = nt * 64, j = nd >> 8, w = nd & 255; prep_tile(INP(21) + (size_t)l * DM * NUP, NUP, DM, INP(20) + l * DM, (us*)(WSB + WS_WUP) + (size_t)l * NUP * DM, kt, nd, (w >> 7) * FF + 128 * j + (w & 127), tile); continue; } r -= I_UP;
        if (r < I_DN) { const int kt = r / 16, nt = r % 16; prep_tile(INP(24) + (size_t)l * FF * DM, DM, FF, nullptr, (us*)(WSB + WS_WDOWN) + (size_t)l * DM * FF, kt, nt * 64, nt * 64, tile); continue; } r -= I_DN;
        { const int kt = r / 8, nt = r % 8; prep_tile(INP(16) + (size_t)l * DM * 512, 512, DM, INP(15) + l * DM, (us*)(WSB + WS_WMEM) + (size_t)l * 512 * DM, kt, nt * 64, nt * 64, tile); }
    }
}

template <bool HAS_Y, bool DO_FG, bool WRITE_B>
__device__ __forceinline__ void row_pass(const float* xP, const float* xS, int nrows, float* xdst, const us* Y, const float* YSQ, const float* gpost,
                                         us* XB, float* RS, const float* win_l, const float* gpre, const float* bfg, float* lfP, float* lfS, LAS float* wfg) {
    const int tid_ = otid(), lane = tid_ & 63, wid = tid_ >> 6;
    if (DO_FG) {
        __syncthreads();
#pragma unroll
        for (int i = 0; i < 2; ++i) { const int k = tid_ + 512 * i; const float g = gpre[k];
            const f32x4 wa = *(const f32x4*)(win_l + (size_t)k * INC + 1536), wb = *(const f32x4*)(win_l + (size_t)k * INC + 1540);
            wfg[0 * 1028 + k] = g * wa[0]; wfg[1 * 1028 + k] = g * wa[1]; wfg[2 * 1028 + k] = g * wa[2]; wfg[3 * 1028 + k] = g * wa[3];
            wfg[4 * 1028 + k] = g * wb[0]; wfg[5 * 1028 + k] = g * wb[1]; wfg[6 * 1028 + k] = g * wb[2]; wfg[7 * 1028 + k] = g * wb[3]; }
        __syncthreads();
    }
    for (int row = blockIdx.x * 8 + wid; row < nrows; row += gridDim.x * 8) {
        const float* xr = (row < NTP) ? xP + (size_t)row * DM : xS + (size_t)(row - NTP) * DM;
        f32x4 v[4];
#pragma unroll
        for (int j = 0; j < 4; ++j) v[j] = *(const f32x4*)(xr + 4 * lane + 256 * j);
        if (HAS_Y) {
            const f32x4* q = (const f32x4*)(YSQ + (size_t)row * 16); const f32x4 a = q[0], b = q[1], c = q[2], d = q[3];
            const float ss = ((a[0] + a[1]) + (a[2] + a[3])) + ((b[0] + b[1]) + (b[2] + b[3])) + ((c[0] + c[1]) + (c[2] + c[3])) + ((d[0] + d[1]) + (d[2] + d[3]));
            const float ry = rsqrtf(ss * (1.f / DM) + EPS);
#pragma unroll
            for (int j = 0; j < 4; ++j) { const unsigned long long yw = *(const unsigned long long*)(Y + (size_t)row * DM + 4 * lane + 256 * j);
                const f32x4 y = {bf2f((unsigned)yw & 0xffffu), bf2f(((unsigned)yw) >> 16), bf2f((unsigned)(yw >> 32) & 0xffffu), bf2f((unsigned)(yw >> 48))}; const f32x4 g = *(const f32x4*)(gpost + 4 * lane + 256 * j); v[j] = v[j] + y * ry * g; }
        }
        if (xdst) {
#pragma unroll
            for (int j = 0; j < 4; ++j) *(f32x4*)(xdst + (size_t)row * DM + 4 * lane + 256 * j) = v[j];
        }
        if (WRITE_B) {
            float s = 0.f;
#pragma unroll
            for (int j = 0; j < 4; ++j) s += (v[j][0] * v[j][0] + v[j][1] * v[j][1]) + (v[j][2] * v[j][2] + v[j][3] * v[j][3]);
            const float rs = rsqrtf(wave_sum(s) * (1.f / DM) + EPS);
#pragma unroll
            for (int j = 0; j < 4; ++j) { unsigned long long o = (unsigned long long)pk2(v[j][0] * rs, v[j][1] * rs) | ((unsigned long long)pk2(v[j][2] * rs, v[j][3] * rs) << 32); *(unsigned long long*)(XB + (size_t)row * DM + 4 * lane + 256 * j) = o; }
            if (DO_FG) {
                float f[8];
#pragma unroll
                for (int h = 0; h < 8; ++h) { f[h] = 0.f;
#pragma unroll
                    for (int j = 0; j < 4; ++j) { const f32x4 w = *(LAS const f32x4*)(wfg + h * 1028 + 4 * lane + 256 * j); f[h] += (v[j][0] * w[0] + v[j][1] * w[1]) + (v[j][2] * w[2] + v[j][3] * w[3]); } }
#pragma unroll
                for (int h = 0; h < 8; ++h) f[h] = wave_sum(f[h]);
                if (lane < 8) {
                    float z = 0.f;
#pragma unroll
                    for (int h = 0; h < 8; ++h) if (lane == h) z = f[h];
                    z = z * rs + bfg[lane];
                    const float lf = fminf(z, 0.f) - log1pf(__expf(-fabsf(z)));
                    if (row < NTP) lfP[(size_t)row * 8 + lane] = lf; else lfS[(size_t)(row - NTP) * 8 + lane] = lf;
                }
            }
        }
    }
}

constexpr int KPB = 144, VPB = 192, FL_V0 = 64 * KPB, FL_BUF = 64 * KPB + 64 * VPB, FL_BIAS = 2 * FL_BUF, FL_MISC = FL_BIAS + 2048 * 4;
__device__ __forceinline__ void flash_unit(LAS unsigned char* lds, const us* Q, int qp, const us* K, int kp, const us* V, int vp, us* O, int op, int ntiles, int band, bool use_bias) {
    const int tid = otid(), lane = tid & 63, wid = tid >> 6, r32 = lane & 31, hi = lane >> 5;
    bf16x8 qf[4];
#pragma unroll
    for (int d0 = 0; d0 < 4; ++d0) qf[d0] = *(const bf16x8*)(Q + (size_t)(wid * 32 + r32) * qp + d0 * 16 + hi * 8);
    const int srow = tid >> 3, sch = tid & 7;
    const us* kg = K + (size_t)srow * kp + sch * 8; const us* vg = V + (size_t)srow * vp + sch * 8;
    u32x4 kreg = *(const u32x4*)kg, vreg = *(const u32x4*)vg;
    *(LAS u32x4*)(lds + srow * KPB + sch * 16) = kreg; *(LAS u32x4*)(lds + FL_V0 + srow * VPB + sch * 16) = vreg;
    __syncthreads();
    f32x16 o0 = {}, o1 = {}; float mrun = -1e30f, lrun = 0.f;
    const int qrel = wid * 32 + r32;
    LAS const float* bias = (LAS const float*)(lds + FL_BIAS);
    for (int t = 0; t < ntiles; ++t) {
        const int cur = (t & 1) * FL_BUF, nxt = FL_BUF - cur;
        if (t + 1 < ntiles) { kreg = *(const u32x4*)(kg + (size_t)(t + 1) * 64 * kp); vreg = *(const u32x4*)(vg + (size_t)(t + 1) * 64 * vp); }
        const int jb = band ? t - (ntiles - band) : -1;
        const bool skip = (jb >= 0) && (64 * jb > wid * 32 + 31);
        if (!skip) {
            f32x16 p0 = {}, p1 = {};
            if (use_bias) {
                LAS const float* bp = bias + 64 * t + 4 * hi;
#pragma unroll
                for (int g = 0; g < 4; ++g) { const f32x4 b0 = *(LAS const f32x4*)(bp + 8 * g), b1 = *(LAS const f32x4*)(bp + 32 + 8 * g);
#pragma unroll
                    for (int i = 0; i < 4; ++i) { p0[4 * g + i] = b0[i]; p1[4 * g + i] = b1[i]; } }
            }
            LAS const unsigned char* kb = lds + cur + r32 * KPB + hi * 16;
#pragma unroll
            for (int d0 = 0; d0 < 4; ++d0) {
                const bf16x8 a0 = *(LAS const bf16x8*)(kb + d0 * 32), a1 = *(LAS const bf16x8*)(kb + 32 * KPB + d0 * 32);
                p0 = MFMA32(a0, qf[d0], p0); p1 = MFMA32(a1, qf[d0], p1);
            }
            if (jb >= 0) {
                const int qb4 = qrel - 64 * jb - 4 * hi; const int NEGB = __builtin_bit_cast(int, -1e30f);
#pragma unroll
                for (int r = 0; r < 16; ++r) { const int t0 = qb4 - ((r & 3) + 8 * (r >> 2)), m0 = t0 >> 31, m1 = (t0 - 32) >> 31;
                    const float x0 = p0[r], x1 = p1[r]; p0[r] = __int_as_float((__float_as_int(x0) & ~m0) | (NEGB & m0)); p1[r] = __int_as_float((__float_as_int(x1) & ~m1) | (NEGB & m1)); }
            }
            float mx = fmaxf(p0[0], p1[0]);
#pragma unroll
            for (int r = 1; r < 16; ++r) mx = fmaxf(mx, fmaxf(p0[r], p1[r]));
            mx = fmaxf(mx, __shfl_xor(mx, 32));
            const float mn = fmaxf(mrun, mx), alpha = __builtin_amdgcn_exp2f(mrun - mn); mrun = mn;
            lrun *= alpha; o0 = o0 * alpha; o1 = o1 * alpha;
            float ls = 0.f;
#pragma unroll
            for (int r = 0; r < 16; ++r) { p0[r] = __builtin_amdgcn_exp2f(p0[r] - mn); p1[r] = __builtin_amdgcn_exp2f(p1[r] - mn); ls += p0[r] + p1[r]; }
            lrun += ls;
            u32x4 pw[4];
#pragma unroll
            for (int s = 0; s < 2; ++s) {
                pw[s] = (u32x4){pg8::cvt_pk_bf16(p0[8 * s], p0[8 * s + 1]), pg8::cvt_pk_bf16(p0[8 * s + 2], p0[8 * s + 3]), pg8::cvt_pk_bf16(p0[8 * s + 4], p0[8 * s + 5]), pg8::cvt_pk_bf16(p0[8 * s + 6], p0[8 * s + 7])};
                pw[2 + s] = (u32x4){pg8::cvt_pk_bf16(p1[8 * s], p1[8 * s + 1]), pg8::cvt_pk_bf16(p1[8 * s + 2], p1[8 * s + 3]), pg8::cvt_pk_bf16(p1[8 * s + 4], p1[8 * s + 5]), pg8::cvt_pk_bf16(p1[8 * s + 6], p1[8 * s + 7])};
            }
            LAS const unsigned char* vb = lds + cur + FL_V0 + (4 * hi + ((lane & 15) >> 2)) * VPB + (((lane >> 4) & 1) * 16 + (lane & 3) * 4) * 2;
#pragma unroll
            for (int ks = 0; ks < 4; ++ks) {
                const s16x4 l0 = trr(vb + (16 * ks) * VPB), h0 = trr(vb + (16 * ks + 8) * VPB), l1 = trr(vb + (16 * ks) * VPB + 64), h1 = trr(vb + (16 * ks + 8) * VPB + 64);
                const bf16x8 a0 = (bf16x8){l0[0], l0[1], l0[2], l0[3], h0[0], h0[1], h0[2], h0[3]}, a1 = (bf16x8){l1[0], l1[1], l1[2], l1[3], h1[0], h1[1], h1[2], h1[3]};
                const bf16x8 pf = __builtin_bit_cast(bf16x8, pw[ks]);
                o0 = MFMA32(a0, pf, o0); o1 = MFMA32(a1, pf, o1);
            }
        }
        if (t + 1 < ntiles) { *(LAS u32x4*)(lds + nxt + srow * KPB + sch * 16) = kreg; *(LAS u32x4*)(lds + nxt + FL_V0 + srow * VPB + sch * 16) = vreg; }
        __syncthreads();
    }
    lrun += __shfl_xor(lrun, 32);
    const float inv = 1.f / lrun;
    us* orow = O + (size_t)(wid * 32 + r32) * op;
#pragma unroll
    for (int g = 0; g < 4; ++g) {
        const int d0 = 8 * g + 4 * hi;
        unsigned long long w0 = (unsigned long long)pk2(o0[4 * g] * inv, o0[4 * g + 1] * inv) | ((unsigned long long)pk2(o0[4 * g + 2] * inv, o0[4 * g + 3] * inv) << 32);
        unsigned long long w1 = (unsigned long long)pk2(o1[4 * g] * inv, o1[4 * g + 1] * inv) | ((unsigned long long)pk2(o1[4 * g + 2] * inv, o1[4 * g + 3] * inv) << 32);
        *(unsigned long long*)(orow + d0) = w0; *(unsigned long long*)(orow + 32 + d0) = w1;
    }
}
template <class F> __device__ __forceinline__ void block_cumsum(LAS float* dst, LAS float* wtot, int n, F f) {
    const int tid = otid(), lane = tid & 63, wid = tid >> 6;
    float a[4];
#pragma unroll
    for (int i = 0; i < 4; ++i) { const int j = 4 * tid + i; a[i] = (j < n) ? f(j) : 0.f; }
    const float s = (a[0] + a[1]) + (a[2] + a[3]);
    float sc = s;
#pragma unroll
    for (int o = 1; o < 64; o <<= 1) { const float t = __shfl_up(sc, o); if (lane >= o) sc += t; }
    if (lane == 63) wtot[wid] = sc;
    __syncthreads();
    float off = 0.f;
    for (int w = 0; w < wid; ++w) off += wtot[w];
    float c = off + sc - s;
#pragma unroll
    for (int i = 0; i < 4; ++i) { c += a[i]; const int j = 4 * tid + i; if (j < 2048) dst[j] = -c * LOG2E; }
    __syncthreads();
}
constexpr int ZPB = 576, WPB = 272, SG_W = 128 * ZPB, SG_RS = SG_W + 128 * WPB;
__device__ __forceinline__ void sgu_unit(LAS unsigned char* lds, int R0, const us* ZB, const us* UB, us* CAT, const float* ws_l, const float* bs_l, const float* gs_l) {
    const int tid = otid(), lane = tid & 63, wid = tid >> 6, r32 = lane & 31, hi = lane >> 5;
#pragma unroll
    for (int i = 0; i < 8; ++i) { const int idx = tid + 512 * i, row = idx >> 5, ch = idx & 31; *(LAS u32x4*)(lds + row * ZPB + ch * 16) = *(const u32x4*)(ZB + (size_t)(R0 + row) * 256 + ch * 8); }
    __syncthreads();
    { const int row = tid >> 2, q = tid & 3; float ss = 0.f;
#pragma unroll
      for (int i = 0; i < 8; ++i) { const u32x4 w = *(LAS const u32x4*)(lds + row * ZPB + q * 128 + i * 16);
#pragma unroll
          for (int e = 0; e < 4; ++e) { const float a = bf2f(w[e] & 0xffffu), b = bf2f(w[e] >> 16); ss += a * a + b * b; } }
      ss += __shfl_xor(ss, 1); ss += __shfl_xor(ss, 2);
      if (q == 0) ((LAS float*)(lds + SG_RS))[row] = rsqrtf(ss * (1.f / 256.f) + EPS); }
    __syncthreads();
    LAS const float* rsz = (LAS const float*)(lds + SG_RS);
#pragma unroll 1
    for (int g = 0; g < 4; ++g) {
#pragma unroll
        for (int i = 0; i < 4; ++i) { const int idx = tid + 512 * i, row = idx >> 4, ch = idx & 15;
            const float* wp = ws_l + (size_t)g * 16384 + row * 128 + ch * 8; f32x4 a = *(const f32x4*)wp, b = *(const f32x4*)(wp + 4);
            const bool z = (ch >= 8) && (row < 64);
            u32x4 o;
            if (z) o = (u32x4){0u, 0u, 0u, 0u};
            else { const int j0 = ch * 8; o.x = pk2(a[0] * rsz[j0], a[1] * rsz[j0 + 1]); o.y = pk2(a[2] * rsz[j0 + 2], a[3] * rsz[j0 + 3]); o.z = pk2(b[0] * rsz[j0 + 4], b[1] * rsz[j0 + 5]); o.w = pk2(b[2] * rsz[j0 + 6], b[3] * rsz[j0 + 7]); }
            *(LAS u32x4*)(lds + SG_W + row * WPB + ch * 16) = o; }
        __syncthreads();
        const int ib = wid & 3, chh = wid >> 2, cbase = g * 64 + 32 * chh;
        f32x16 acc = {};
        LAS const unsigned char* ap = lds + SG_W + (32 * ib + r32) * WPB + hi * 16;
        LAS const unsigned char* bp = lds + (8 * hi + ((lane & 15) >> 2)) * ZPB + (cbase + 16 * ((lane >> 4) & 1) + 4 * (lane & 3)) * 2;
#pragma unroll
        for (int ks = 0; ks < 8; ++ks) {
            const bf16x8 a = *(LAS const bf16x8*)(ap + ks * 32);
            const s16x4 l0 = trr(bp + (16 * ks) * ZPB), h0 = trr(bp + (16 * ks + 4) * ZPB);
            const bf16x8 b = (bf16x8){l0[0], l0[1], l0[2], l0[3], h0[0], h0[1], h0[2], h0[3]};
            acc = MFMA32(a, b, acc);
        }
        const int c = cbase + r32; const float gs = gs_l[c];
#pragma unroll
        for (int r = 0; r < 16; ++r) { const int i = 32 * ib + (r & 3) + 8 * (r >> 2) + 4 * hi;
            const float mixed = gs * acc[r] + bs_l[g * 128 + i]; const float u = bf2f(UB[(size_t)(R0 + i) * 256 + c]);
            CAT[(size_t)(R0 + i) * DM + 512 + c] = (us)f2bf(u * mixed); }
        __syncthreads();
    }
}
__device__ __forceinline__ void sgu_sample_unit(LAS unsigned char* lds, int b, const us* ZB, const us* UB, us* CAT, const float* ws_l, const float* bs_l, const float* gs_l, float* outv) {
    const int tid = otid(), R0 = NTP + 16 * b;
    LAS float* z = (LAS float*)lds; LAS float* rsz = z + 16 * 256;
    for (int i = tid; i < 4096; i += 512) z[i] = bf2f(ZB[(size_t)R0 * 256 + i]);
    __syncthreads();
    { const int row = tid >> 5, q = tid & 31; float ss = 0.f;
      for (int i = 0; i < 8; ++i) { const float a = z[row * 256 + q + 32 * i]; ss += a * a; }
      ss += __shfl_xor(ss, 1); ss += __shfl_xor(ss, 2); ss += __shfl_xor(ss, 4); ss += __shfl_xor(ss, 8); ss += __shfl_xor(ss, 16);
      if (q == 0) rsz[row] = rsqrtf(ss * (1.f / 256.f) + EPS); }
    __syncthreads();
    for (int o = tid; o < 4096; o += 512) {
        const int i = o >> 8, c = o & 255, g = c >> 6; const float gs = gs_l[c];
        float acc = 0.f;
#pragma unroll
        for (int j = 0; j < 16; ++j) acc += ws_l[(size_t)g * 16384 + i * 128 + j] * rsz[j] * z[j * 256 + c];
        const float mixed = gs * acc + bs_l[g * 128 + i]; const float u = bf2f(UB[(size_t)(R0 + i) * 256 + c]);
        CAT[(size_t)(R0 + i) * DM + 512 + c] = (us)f2bf(u * mixed);
        outv[(size_t)(16 * b + i) * 256 + c] = z[i * 256 + c] * rsz[i] * gs;
    }
    __syncthreads();
}
constexpr int SA_SC = 4096, SA_NKMAX = 1056, SA_BIAS = SA_SC + SA_NKMAX * 17 * 4 + 896, SA_MISC = SA_BIAS + 2048 * 4, SA_RED = SA_MISC + 1024;
__device__ __forceinline__ void small_attn(LAS unsigned char* lds, const us* Q, int qp, const float* Kc, const float* Vc, int cp, int ncache, const float* Kn, const float* Vn, int np, int nnew,
                                           const float* lfc, const float* lfn, bool fox, us* O, int op) {
    const int tid = otid(), lane = tid & 63, wid = tid >> 6;
    const int nk = ncache + nnew, nkb = (nk + 15) >> 4;
    LAS float* SC = (LAS float*)(lds + SA_SC); LAS float* bias = (LAS float*)(lds + SA_BIAS); LAS float* misc = (LAS float*)(lds + SA_MISC); LAS float* red = (LAS float*)(lds + SA_RED);
    if (tid < 128) { const int row = tid >> 3, ch = tid & 7; *(LAS u32x4*)(lds + row * 144 + ch * 16) = *(const u32x4*)(Q + (size_t)row * qp + ch * 8); }
    if (fox) block_cumsum(bias, misc, nk, [&](int j) { return j < ncache ? lfc[(size_t)j * 8] : lfn[(size_t)(j - ncache) * 8]; });
    else __syncthreads();
    { const int kl = lane & 15, kq = lane >> 4;
#pragma unroll 5
      for (int kb = wid; kb < nkb; kb += 8) {
        const int key = kb * 16 + kl; const bool valid = key < nk; const int kk = valid ? key : 0;
        const float* src = (kk < ncache) ? Kc + (size_t)kk * cp : Kn + (size_t)(kk - ncache) * np;
        f32x4 acc = {0.f, 0.f, 0.f, 0.f};
#pragma unroll
        for (int s = 0; s < 2; ++s) {
            const f32x4 x0 = *(const f32x4*)(src + 32 * s + 8 * kq), x1 = *(const f32x4*)(src + 32 * s + 8 * kq + 4);
            const u32x4 bw = (u32x4){pk2(x0[0], x0[1]), pk2(x0[2], x0[3]), pk2(x1[0], x1[1]), pk2(x1[2], x1[3])};
            const bf16x8 a = *(LAS const bf16x8*)(lds + kl * 144 + (32 * s + 8 * kq) * 2);
            acc = MFMA16(a, __builtin_bit_cast(bf16x8, bw), acc);
        }
        const float bj = fox ? bias[key] : 0.f;
#pragma unroll
        for (int r = 0; r < 4; ++r) { const int qrow = 4 * kq + r; float sv = acc[r] + bj; if (!valid || (fox && key > ncache + qrow)) sv = -1e30f; SC[key * 17 + qrow] = sv; }
      } }
    __syncthreads();
#pragma unroll
    for (int rr = 0; rr < 2; ++rr) { const int row = 2 * wid + rr; float mx = -1e30f;
        for (int j = lane; j < nkb * 16; j += 64) mx = fmaxf(mx, SC[j * 17 + row]);
#pragma unroll
        for (int o = 1; o < 64; o <<= 1) mx = fmaxf(mx, __shfl_xor(mx, o));
        float sum = 0.f;
        for (int j = lane; j < nkb * 16; j += 64) { const float e = __builtin_amdgcn_exp2f(SC[j * 17 + row] - mx); SC[j * 17 + row] = e; sum += e; }
        sum = wave_sum(sum);
        if (lane == 0) misc[16 + row] = 1.f / sum; }
    __syncthreads();
    {
      const int d = lane, kpw = (nk + 7) >> 3, j0 = wid * kpw, j1 = min(nk, j0 + kpw), jc = min(j1, ncache);
      float acc[16];
#pragma unroll
      for (int i = 0; i < 16; ++i) acc[i] = 0.f;
#pragma unroll 16
      for (int j = j0; j < jc; ++j) { const float v = Vc[(size_t)j * cp + d]; LAS const float* pj = SC + j * 17;
#pragma unroll
          for (int i = 0; i < 16; ++i) acc[i] += pj[i] * v; }
      for (int j = max(j0, ncache); j < j1; ++j) { const float v = Vn[(size_t)(j - ncache) * np + d]; LAS const float* pj = SC + j * 17;
#pragma unroll
          for (int i = 0; i < 16; ++i) acc[i] += pj[i] * v; }
#pragma unroll
      for (int i = 0; i < 16; ++i) red[(wid * 16 + i) * 64 + d] = acc[i]; }
    __syncthreads();
    { const int d = lane, r0 = 2 * wid; float a0 = 0.f, a1 = 0.f;
#pragma unroll
      for (int w = 0; w < 8; ++w) { a0 += red[(w * 16 + r0) * 64 + d]; a1 += red[(w * 16 + r0 + 1) * 64 + d]; }
      O[(size_t)r0 * op + d] = (us)f2bf(a0 * misc[16 + r0]); O[(size_t)(r0 + 1) * op + d] = (us)f2bf(a1 * misc[17 + r0]); }
    __syncthreads();
}
#ifdef DBG_FOX
__device__ __forceinline__ void dbg_fox(const P& p, int l) {
    const us* QBp = (const us*)(WSB + WS_QB); const us* KBp = (const us*)(WSB + WS_KB); const us* VBp = (const us*)(WSB + WS_VB); us* CATp = (us*)(WSB + WS_CAT);
    const float* lf = OUTB + O_PLF + (size_t)l * NTP * 8;
    for (int id = blockIdx.x * 512 + otid(); id < 131072; id += gridDim.x * 512) {
        const int q = id & 2047, bh = id >> 11, b = bh >> 3, h = bh & 7;
        if ((FQM >> (q >> 8)) & 1) continue;
        float qv[64], o[64];
#pragma unroll
        for (int c8 = 0; c8 < 8; ++c8) { const u32x4 w = *(const u32x4*)(QBp + ((size_t)b * SEQ + q) * 512 + h * 64 + c8 * 8);
#pragma unroll
            for (int e = 0; e < 4; ++e) { qv[c8 * 8 + 2 * e] = bf2f(w[e] & 0xffffu); qv[c8 * 8 + 2 * e + 1] = bf2f(w[e] >> 16); } }
#pragma unroll
        for (int d = 0; d < 64; ++d) o[d] = 0.f;
        float m = -1e30f, ls = 0.f, c = 0.f;
        for (int j = 0; j <= q; ++j) {
            c += lf[((size_t)b * SEQ + j) * 8 + h] * LOG2E;
            const us* kr = KBp + ((size_t)b * SEQ + j) * 512 + h * 64; const us* vr = VBp + ((size_t)b * SEQ + j) * 512 + h * 64;
            float s = 0.f;
#pragma unroll
            for (int c8 = 0; c8 < 8; ++c8) { const u32x4 w = *(const u32x4*)(kr + c8 * 8);
#pragma unroll
                for (int e = 0; e < 4; ++e) { s += qv[c8 * 8 + 2 * e] * bf2f(w[e] & 0xffffu) + qv[c8 * 8 + 2 * e + 1] * bf2f(w[e] >> 16); } }
            s -= c;
            const float mn = fmaxf(m, s), al = __builtin_amdgcn_exp2f(m - mn), pj = __builtin_amdgcn_exp2f(s - mn); m = mn; ls = ls * al + pj;
#pragma unroll
            for (int c8 = 0; c8 < 8; ++c8) { const u32x4 w = *(const u32x4*)(vr + c8 * 8);
#pragma unroll
                for (int e = 0; e < 4; ++e) { o[c8 * 8 + 2 * e] = o[c8 * 8 + 2 * e] * al + pj * bf2f(w[e] & 0xffffu); o[c8 * 8 + 2 * e + 1] = o[c8 * 8 + 2 * e + 1] * al + pj * bf2f(w[e] >> 16); } }
        }
        const float inv = 1.f / ls;
#pragma unroll
        for (int c8 = 0; c8 < 8; ++c8) { u32x4 w;
#pragma unroll
            for (int e = 0; e < 4; ++e) w[e] = pk2(o[c8 * 8 + 2 * e] * inv, o[c8 * 8 + 2 * e + 1] * inv);
            *(u32x4*)(CATp + ((size_t)b * SEQ + q) * DM + h * 64 + c8 * 8) = w; }
    }
}
#endif
__device__ __forceinline__ void attn_phase(const P& p, LAS unsigned char* lds, int l) {
    const int G = gridDim.x, bx = blockIdx.x, vcu = (G % 8 == 0) ? (bx % 8) * (G / 8) + bx / 8 : bx;
#define A_QB ((const us*)(WSB + WS_QB))
#define A_KB ((const us*)(WSB + WS_KB))
#define A_VB ((const us*)(WSB + WS_VB))
#define A_UB ((const us*)(WSB + WS_UB))
#define A_ZB ((const us*)(WSB + WS_ZB))
#define A_QMB ((const us*)(WSB + WS_QMB))
#define A_MKV ((const us*)(WSB + WS_MKV) + (size_t)l * NMEMROWS * 512)
#define A_CAT ((us*)(WSB + WS_CAT))
#define A_WS (INP(12) + (size_t)l * 4 * 16384)
#define A_BS (INP(13) + (size_t)l * 512)
#define A_GS (INP(14) + (size_t)l * 256)
#ifdef DBG_FOX
    dbg_fox(p, l);
#endif
    for (int v = vcu; v < 256; v += G) {
        const int bh = v >> 2, s = v & 3, b = bh >> 3, h = bh & 7;
#pragma unroll 1
        for (int k = 0; k < 2; ++k) { const int qb = k ? 7 - s : s;
#ifdef DBG_FOX
            if (!((FQM >> qb) & 1)) continue;
#endif
            const float* lfP = OUTB + O_PLF + (size_t)l * NTP * 8 + (size_t)b * SEQ * 8 + h;
            block_cumsum((LAS float*)(lds + FL_BIAS), (LAS float*)(lds + FL_MISC), 256 * (qb + 1), [&](int j) { return lfP[(size_t)j * 8]; });
            flash_unit(lds, A_QB + ((size_t)b * SEQ + qb * 256) * 512 + h * 64, 512, A_KB + (size_t)b * SEQ * 512 + h * 64, 512, A_VB + (size_t)b * SEQ * 512 + h * 64, 512,
                       A_CAT + ((size_t)b * SEQ + qb * 256) * DM + h * 64, DM, 4 * (qb + 1), 4, true); }
    }
    for (int v = vcu; v < 256; v += G) { const int bh = v >> 3, qb = v & 7, b = bh >> 2, h = bh & 3; const us* mkv = A_MKV + (size_t)b * 256 * 512 + h * 64;
        flash_unit(lds, A_QMB + ((size_t)b * SEQ + qb * 256) * 256 + h * 64, 256, mkv, 512, mkv + 256, 512,
                   A_CAT + ((size_t)b * SEQ + qb * 256) * DM + 768 + h * 64, DM, 4, 0, false); }
    for (int v = G - 1 - vcu; v < 128; v += G) sgu_unit(lds, v * 128, A_ZB, A_UB, A_CAT, A_WS, A_BS, A_GS);
    for (int v = vcu; v < 128; v += G) { const int b = v >> 3, h = v & 7; const size_t co = ((size_t)(l * NBS + b) * PAST) * 512 + h * 64, no = ((size_t)l * NTS + 16 * b) * 512 + h * 64;
        small_attn(lds, A_QB + (size_t)(NTP + 16 * b) * 512 + h * 64, 512, INP(3) + co, INP(4) + co, 512, PAST, OUTB + O_SK + no, OUTB + O_SV + no, 512, 16,
                   INP(5) + ((size_t)(l * NBS + b) * PAST) * 8 + h, OUTB + O_SLF + (size_t)l * NTS * 8 + (size_t)(16 * b) * 8 + h, true, A_CAT + (size_t)(NTP + 16 * b) * DM + h * 64, DM); }
    for (int v = G - 1 - vcu; v < 64; v += G) { const int b = v >> 2, h = v & 3; const size_t co = ((size_t)(l * NBS + b) * 256) * 256 + h * 64;
        small_attn(lds, A_QMB + (size_t)(NTP + 16 * b) * 256 + h * 64, 256, INP(6) + co, INP(7) + co, 256, 256,
                   nullptr, nullptr, 0, 0, nullptr, nullptr, false, A_CAT + (size_t)(NTP + 16 * b) * DM + 768 + h * 64, DM); }
    for (int v = vcu - 128; v >= 0 && v < 16; v += G) sgu_sample_unit(lds, v, A_ZB, A_UB, A_CAT, A_WS, A_BS, A_GS, OUTB + O_SGV + (size_t)l * NTS * 256);
}
__device__ __forceinline__ void gnorm_phase(const P& p, int l) {
    const int tid_ = otid(), lane = tid_ & 63, wid = tid_ >> 6; us* CAT = (us*)(WSB + WS_CAT); const float* gg = INP(17) + (size_t)l * DM;
    for (int row = blockIdx.x * 8 + wid; row < NT; row += gridDim.x * 8) {
        u32x4* rp = (u32x4*)(CAT + (size_t)row * DM + 16 * lane); const u32x4 w0 = rp[0], w1 = rp[1];
        float v[16];
#pragma unroll
        for (int e = 0; e < 4; ++e) { v[2 * e] = bf2f(w0[e] & 0xffffu); v[2 * e + 1] = bf2f(w0[e] >> 16); v[8 + 2 * e] = bf2f(w1[e] & 0xffffu); v[8 + 2 * e + 1] = bf2f(w1[e] >> 16); }
        float ss = 0.f;
#pragma unroll
        for (int e = 0; e < 16; ++e) ss += v[e] * v[e];
        ss += __shfl_xor(ss, 1); ss += __shfl_xor(ss, 2); ss += __shfl_xor(ss, 4); ss += __shfl_xor(ss, 8);
        const float s16 = __shfl_xor(ss, 16); float wdt = 256.f; if (lane < 32) { ss += s16; wdt = 512.f; }
        const float r = rsqrtf(ss / wdt + EPS);
        const f32x4 g0 = *(const f32x4*)(gg + 16 * lane), g1 = *(const f32x4*)(gg + 16 * lane + 4), g2 = *(const f32x4*)(gg + 16 * lane + 8), g3 = *(const f32x4*)(gg + 16 * lane + 12);
        u32x4 o0, o1;
        o0.x = pk2(v[0] * r * g0[0], v[1] * r * g0[1]); o0.y = pk2(v[2] * r * g0[2], v[3] * r * g0[3]); o0.z = pk2(v[4] * r * g1[0], v[5] * r * g1[1]); o0.w = pk2(v[6] * r * g1[2], v[7] * r * g1[3]);
        o1.x = pk2(v[8] * r * g2[0], v[9] * r * g2[1]); o1.y = pk2(v[10] * r * g2[2], v[11] * r * g2[3]); o1.z = pk2(v[12] * r * g3[0], v[13] * r * g3[1]); o1.w = pk2(v[14] * r * g3[2], v[15] * r * g3[3]);
        rp[0] = o0; rp[1] = o1;
    }
}
__device__ __forceinline__ void fix_panel(const P& p, int l, int pm) {
    const float* wdw = INP(22) + (size_t)l * 3 * FF; const float* bdw = INP(23) + (size_t)l * FF;
    const float* AF = (const float*)(WSB + WS_AF); const float* LF = (const float*)(WSB + WS_LF); const float* AL = (const float*)(WSB + WS_AL); us* G = (us*)(WSB + WS_G);
#pragma unroll 2
    for (int i = otid(); i < 8 * (FF / 4); i += 512) { const int f = (i % (FF / 4)) * 4, q = i / (FF / 4), rr = q & 1, s = 4 * pm + (q >> 1), sr = 2 * s + rr;
        const bool first = (s & 31) == 0; const f32x4 z = {0.f, 0.f, 0.f, 0.f};
        const f32x4 l0 = first ? z : *(const f32x4*)(AL + ((size_t)(s - 1) * 2) * FF + f), l1 = first ? z : *(const f32x4*)(AL + ((size_t)(s - 1) * 2 + 1) * FF + f);
        const f32x4 a2 = *(const f32x4*)(AF + (size_t)sr * FF + f), a1 = rr ? *(const f32x4*)(AF + ((size_t)s * 2) * FF + f) : l1, a0 = rr ? l1 : l0;
        const f32x4 w0 = *(const f32x4*)(wdw + f), w1 = *(const f32x4*)(wdw + FF + f), w2 = *(const f32x4*)(wdw + 2 * FF + f), bb = *(const f32x4*)(bdw + f), li = *(const f32x4*)(LF + (size_t)sr * FF + f);
        f32x4 g;
#pragma unroll
        for (int e = 0; e < 4; ++e) g[e] = silu_f(bb[e] + w0[e] * a0[e] + w1[e] * a1[e] + w2[e] * a2[e]) * li[e];
        *(unsigned long long*)(G + ((size_t)s * 64 + rr) * FF + f) = (unsigned long long)pk2(g[0], g[1]) | ((unsigned long long)pk2(g[2], g[3]) << 32); }
}
__device__ __forceinline__ void conv_state_out(const P& p, int l) {
    const float* AL = (const float*)(WSB + WS_AL);
    const int gt = blockIdx.x * 512 + otid(), gn = gridDim.x * 512;
    float* oc = OUTB + O_PCONV + (size_t)l * NBP * 2 * FF;
    for (int i = gt; i < NBP * 2 * FF; i += gn) { const int f = i % FF, br = i / FF, b = br >> 1, rr = br & 1; oc[i] = AL[((size_t)(32 * b + 31) * 2 + rr) * FF + f]; }
}
__device__ __forceinline__ void small_gemm(LAS unsigned char* lds, const us* A  , const us* Bt, int K, us* Y, float* YSQ) {
    const int tid = otid(), lane = tid & 63, wid = tid >> 6, cg4 = wid & 3, kh = wid >> 2, rl = lane & 15, kq = lane >> 4;
    LAS float* xch = (LAS float*)lds;
    for (int it = blockIdx.x; it < 256; it += gridDim.x) {
        const int rb = it >> 4, cb = it & 15;
        const us* ap = A + (size_t)(rb * 16 + rl) * K + kh * (K / 2) + 8 * kq; const us* bp = Bt + (size_t)(cb * 64 + cg4 * 16 + rl) * K + kh * (K / 2) + 8 * kq;
        f32x4 acc = {0.f, 0.f, 0.f, 0.f};
#pragma unroll 8
        for (int k = 0; k < K / 2; k += 32) acc = MFMA16(*(const bf16x8*)(ap + k), *(const bf16x8*)(bp + k), acc);
        if (kh == 1) *(LAS f32x4*)(xch + (cg4 * 64 + lane) * 4) = acc;
        __syncthreads();
        if (kh == 0) {
            acc = acc + *(LAS const f32x4*)(xch + (cg4 * 64 + lane) * 4);
            const int col = cb * 64 + cg4 * 16 + rl;
#pragma unroll
            for (int r = 0; r < 4; ++r) { const int row = rb * 16 + 4 * kq + r; Y[(size_t)row * DM + col] = (us)f2bf(acc[r]);
                float ss = acc[r] * acc[r]; ss += __shfl_xor(ss, 1); ss += __shfl_xor(ss, 2); ss += __shfl_xor(ss, 4); ss += __shfl_xor(ss, 8);
                if (rl == 0) xch[1024 + cg4 * 16 + 4 * kq + r] = ss; }
        }
        __syncthreads();
        if (tid < 16) YSQ[(size_t)(rb * 16 + tid) * 16 + cb] = (xch[1024 + tid] + xch[1024 + 16 + tid]) + (xch[1024 + 32 + tid] + xch[1024 + 48 + tid]);
        __syncthreads();
    }
}
constexpr int LDS_BYTES = 147456;
constexpr int NPHASE = 17;
#define XB_TMO      128
#define XB_XCNT(j)  (256  + 64 * (j))
#define XB_XSUB(j)  (1280 + 64 * (j))
#define XB_XGEN(j)  (2304 + 64 * (j))
#define XB_TOP      3328
#define XB_TOPGEN   3392
#define XCD_BAR_WORDS 3456
#define XB_SPIN_CAP (1u << 18)

__device__ __forceinline__ unsigned xb_ld(unsigned* p)              { return __hip_atomic_load(p, __ATOMIC_RELAXED, __HIP_MEMORY_SCOPE_AGENT); }
__device__ __forceinline__ unsigned xb_add(unsigned* p, unsigned v) { return __hip_atomic_fetch_add(p, v, __ATOMIC_RELAXED, __HIP_MEMORY_SCOPE_AGENT); }
__device__ __forceinline__ unsigned xb_xcc_id() { return (unsigned)__builtin_amdgcn_s_getreg((3 << 11) | 20) & 0xFu; }
#define XB_SPIN(cond, bar) do { unsigned _sp = 0; while (cond) { __builtin_amdgcn_s_sleep(1); \
    if ((++_sp & 255u) == 0u) { if (xb_ld(&(bar)[XB_TMO])) break; if (_sp > XB_SPIN_CAP) { atomicAdd(&(bar)[XB_TMO], 1u); break; } } } } while (0)

struct XcdBarrier {
    unsigned* bar; unsigned x;
    volatile LAS unsigned* st;
};

__device__ __forceinline__ XcdBarrier xcd_barrier_post(unsigned* bar, volatile LAS unsigned* st) {
    XcdBarrier b; b.bar = bar; b.x = xb_xcc_id(); b.st = st;
    if (threadIdx.x == 0) (void)xb_add(&bar[XB_XCNT(b.x)], 1u);
    return b;
}
__device__ __forceinline__ void xcd_barrier_complete(unsigned* bar, unsigned x, unsigned& nloc, unsigned& nx) {
    const unsigned G = gridDim.x * gridDim.y * gridDim.z;
    unsigned sum, cnt, mine, sp = 0u;
    for (;;) {
        sum = 0u; cnt = 0u; mine = 0u;
#pragma unroll
        for (unsigned j = 0; j < 16; ++j) { const unsigned c = xb_ld(&bar[XB_XCNT(j)]); sum += c; cnt += (c > 0u) ? 1u : 0u; mine = (j == x) ? c : mine; }
        if (sum == G) break;
        __builtin_amdgcn_s_sleep(1);
        if ((++sp & 255u) == 0u) { if (xb_ld(&bar[XB_TMO])) break; if (sp > XB_SPIN_CAP) { atomicAdd(&bar[XB_TMO], 1u); break; } }
    }
    nloc = mine > 0u ? mine : 1u; nx = cnt > 0u ? cnt : 1u;
}

__device__ __forceinline__ void xcd_barrier(const XcdBarrier& b) {
    asm volatile("s_waitcnt vmcnt(0)" ::: "memory");
    __syncthreads();
    if (threadIdx.x == 0) {
        unsigned* bar = b.bar;
        __builtin_amdgcn_s_waitcnt(0);
        unsigned nloc = b.st[0], nx = b.st[1];
        if (nloc == 0u) { xcd_barrier_complete(bar, b.x, nloc, nx); b.st[0] = nloc; b.st[1] = nx; }
        const unsigned old = xb_add(&bar[XB_XSUB(b.x)], 1u);
        const unsigned gen = old / nloc;
        if (old + 1u == (gen + 1u) * nloc) {
            __builtin_amdgcn_fence(__ATOMIC_RELEASE, "agent");
            asm volatile("s_waitcnt vmcnt(0)" ::: "memory");
            const unsigned og = xb_add(&bar[XB_TOP], 1u);
            const unsigned tg = og / nx;
            if (og + 1u == (tg + 1u) * nx) xb_add(&bar[XB_TOPGEN], 1u);
            else XB_SPIN(xb_ld(&bar[XB_TOPGEN]) == tg, bar);
            __builtin_amdgcn_fence(__ATOMIC_ACQUIRE, "agent");
            xb_add(&bar[XB_XGEN(b.x)], 1u);
            asm volatile("s_waitcnt vmcnt(0)" ::: "memory");
        } else {
            XB_SPIN(xb_ld(&bar[XB_XGEN(b.x)]) == gen, bar);
            __builtin_amdgcn_fence(__ATOMIC_ACQUIRE, "agent");
            asm volatile("s_waitcnt vmcnt(0)" ::: "memory");
        }
    }
    __syncthreads();
}


__global__ void __launch_bounds__(512, 2) mega(P p) {
    extern __shared__ __attribute__((aligned(16))) unsigned char lds_raw[];
    LAS unsigned char* lds = (LAS unsigned char*)lds_raw;
    volatile LAS unsigned* xst = (volatile LAS unsigned*)(lds + LDS_BYTES - 16);
    if (threadIdx.x < 4) xst[threadIdx.x] = 0u;
    __syncthreads();
    if (p.coop) { cg::grid_group grid = cg::this_grid(); grid.sync();
        (void)xcd_barrier_post((unsigned*)(WSB + WS_CTL), xst); }
#define XB ((us*)(WSB + WS_XB))
#define RS ((float*)(WSB + WS_RS))
#define X (OUTB + O_Y)
#define Y ((us*)(WSB + WS_Y))
#define YSQ ((float*)(WSB + WS_YSQ))
    for (int ph = p.ph_lo; ph < p.ph_hi; ++ph) {
#ifdef RPT_MASK
      for (int rep = 0; rep < ((ph > 0 && ((RPT_MASK >> ((ph - 1) % 8)) & 1)) || (ph == 0 && (RPT_MASK & 0x200)) ? 2 : 1); ++rep) {
#else
      {
#endif
        if (ph == 0) {
            prep_phase(p, lds);
            row_pass<false, true, true>(INP(0), INP(1), NT, nullptr, nullptr, nullptr, nullptr, XB, RS, INP(10), INP(9), INP(11), OUTB + O_PLF, OUTB + O_SLF, (LAS float*)lds);
            row_pass<false, false, true>(INP(2), INP(2), NMEMROWS, nullptr, nullptr, nullptr, nullptr, (us*)(WSB + WS_MEMB), (float*)(WSB + WS_RSMEM), nullptr, nullptr, nullptr, nullptr, nullptr, (LAS float*)lds);
        } else {
            const int l = (ph - 1) / 8, s = (ph - 1) % 8;
            if (s == 0) {
                { pg8::Gemm g{XB, (const us*)(WSB + WS_WIN) + (size_t)l * NIN * DM, NT, NIN, DM}; pg8::StaticOrder S; S.init(NT, NIN, gridDim.x, blockIdx.x);
                  pg8::EpiIn E{0, l, WSB, OUTB};
                  pg8::gemm_phase<pg8::EpiIn, pg8::StaticOrder, true, true>(lds, g, S, E); }
                if (l == 0) {
#pragma unroll 1
                    for (int ll = 0; ll < 2; ++ll) {
                        pg8::Gemm g{(const us*)(WSB + WS_MEMB), (const us*)(WSB + WS_WMEM) + (size_t)ll * 512 * DM, NMEMROWS, 512, DM}; pg8::StaticOrder S; S.init(NMEMROWS, 512, gridDim.x, (blockIdx.x + 80 + 16 * ll) % gridDim.x);
                        pg8::EpiIn E{1, ll, WSB, OUTB};
                        pg8::gemm_phase<pg8::EpiIn, pg8::StaticOrder, true, true>(lds, g, S, E); }
                }
            } else if (s == 1) { attn_phase(p, lds, l);
            } else if (s == 2) { gnorm_phase(p, l);
            } else if (s == 3 || s == 6) {
                const us* A = (s == 3) ? (const us*)(WSB + WS_CAT) : (const us*)(WSB + WS_G); const int K = (s == 3) ? DM : FF;
                const us* Bt = (s == 3) ? (const us*)(WSB + WS_WOUT) + (size_t)l * DM * DM : (const us*)(WSB + WS_WDOWN) + (size_t)l * DM * FF;
                { pg8::Gemm g{A, Bt, NTP, DM, K}; pg8::StaticOrder S; S.init(NTP, DM, gridDim.x, blockIdx.x); pg8::EpiY E{WSB};
                  if (s == 6) { pg8::Unit uu; int lastpm = -1;
                      for (int i = 0; S.next(i, uu); ++i) if (uu.pm != lastpm) { fix_panel(p, l, uu.pm); lastpm = uu.pm; }
                      conv_state_out(p, l); __syncthreads(); }
                  pg8::gemm_phase<pg8::EpiY, pg8::StaticOrder, true, true>(lds, g, S, E); }
                small_gemm(lds, A + (size_t)NTP * K, Bt, K, Y + (size_t)NTP * DM, YSQ + (size_t)NTP * 16);
            } else if (s == 4) {
                const float* xp = (l == 0) ? INP(0) : X; const float* xs = (l == 0) ? INP(1) : X + (size_t)NTP * DM;
                row_pass<true, false, true>(xp, xs, NT, X, Y, YSQ, INP(19) + (size_t)l * DM, XB, RS, nullptr, nullptr, nullptr, nullptr, nullptr, (LAS float*)lds);
            } else if (s == 5) {
                pg8::Gemm g{XB, (const us*)(WSB + WS_WUP) + (size_t)l * NUP * DM, NT, NUP, DM}; pg8::StaticOrder S; S.init(NT, NUP, gridDim.x, blockIdx.x);
                pg8::EpiUp E{WSB, INP(22) + (size_t)l * 3 * FF, INP(23) + (size_t)l * FF, INP(8) + (size_t)l * NBS * 2 * FF, OUTB + O_SCONV + (size_t)l * NBS * 2 * FF};
                pg8::gemm_phase<pg8::EpiUp, pg8::StaticOrder, true, true>(lds, g, S, E);
            } else {
                if (l == 0) row_pass<true, true, true>(X, X + (size_t)NTP * DM, NT, X, Y, YSQ, INP(25), XB, RS, INP(10) + (size_t)DM * INC, INP(9) + DM, INP(11) + 8, OUTB + O_PLF + (size_t)NTP * 8, OUTB + O_SLF + (size_t)NTS * 8, (LAS float*)lds);
                else row_pass<true, false, false>(X, X + (size_t)NTP * DM, NT, X, Y, YSQ, INP(25) + DM, nullptr, nullptr, nullptr, nullptr, nullptr, nullptr, nullptr, (LAS float*)lds);
            }
        }
      }
        if (p.coop && ph + 1 < p.ph_hi) { XcdBarrier xb_; xb_.bar = (unsigned*)(WSB + WS_CTL); xb_.x = xb_xcc_id(); xb_.st = xst; xcd_barrier(xb_); }
    }
}

#undef XB
#undef RS
#undef X
#undef Y
#undef YSQ
extern "C" void kernel_launch(void* const* d_in, const int* in_sizes, int n_in, void* d_out, int out_size, void* d_ws, size_t ws_size, hipStream_t stream) {
    static int grid = 0;
    if (grid == 0) {
        if (n_in != 26 || out_size != (int)O_END || ws_size < WS_END) { fprintf(stderr, "kernel_launch: unexpected sizes n_in %d out %d ws %zu (need %zu)\n", n_in, out_size, ws_size, (size_t)WS_END); grid = -1; return; }
        int dev = 0, cus = 0, per_cu = 0;
        (void)hipGetDevice(&dev); (void)hipDeviceGetAttribute(&cus, hipDeviceAttributeMultiprocessorCount, dev);
        if (hipFuncSetAttribute((const void*)mega, hipFuncAttributeMaxDynamicSharedMemorySize, LDS_BYTES) != hipSuccess) { fprintf(stderr, "kernel_launch: hipFuncSetAttribute failed\n"); grid = -1; return; }
        (void)hipOccupancyMaxActiveBlocksPerMultiprocessor(&per_cu, (const void*)mega, 512, LDS_BYTES);
        (void)hipGetLastError();
        if (per_cu < 1) fprintf(stderr, "kernel_launch: occupancy query says %d blocks per CU\n", per_cu);
        grid = cus > 0 ? cus : 256;
    }
    if (grid < 0) return;
    if (hipMemsetAsync((char*)d_ws + WS_CTL, 0, 16384, stream) != hipSuccess) { fprintf(stderr, "kernel_launch: memset failed\n"); return; }
    P p{};
    for (int i = 0; i < 26; ++i) p.in[i] = (const float*)d_in[i];
    p.out = (float*)d_out; p.ws = (unsigned char*)d_ws; p.pad = 0;
#ifndef MK_MULTI
    p.ph_lo = 0; p.ph_hi = NPHASE; p.coop = 1;
    void* args[] = {&p};
    hipError_t e = hipLaunchCooperativeKernel((void*)mega, dim3(grid), dim3(512), args, LDS_BYTES, stream);
    if (e != hipSuccess) fprintf(stderr, "kernel_launch: cooperative launch failed: %s (grid %d)\n", hipGetErrorString(e), grid);
#else
    for (int ph = 0; ph < NPHASE; ++ph) { p.ph_lo = ph; p.ph_hi = ph + 1; p.coop = 0; hipLaunchKernelGGL(mega, dim3(grid), dim3(512), LDS_BYTES, stream, p); }
#endif
}
```
